# Optimizing an MI355X kernel written in HIP

```python
import jax, jax.numpy as jnp
from jax import lax
import numpy as np

D_MODEL = 2048
BATCH = 4
SEQ = 8192
DEPTH = 1

CHUNK = 64
PLE_DIM = 256
EPS = 1e-6
H_A = 8
DK_A = 128
DV_A = 128
H_B = 4
DQK_B = 128
DV_B = 256
CONV_W = 4
M_INIT = -1e30
N_EXPERTS = 32
TOP_K = 4
D_FF = 2048
SWIGLU_LIMIT = 7.0
SWIGLU_ALPHA = 1.702
EXPERT_BLOCK = 256
IN_SPLIT_SIZES = (H_A * DK_A, H_A * DK_A, H_A * DV_A, H_A * DV_A,
                  2 * H_B * DQK_B, H_B * DV_B, H_B, H_B, H_B * DV_B,
                  D_MODEL, D_MODEL)
IN_COLS = sum(IN_SPLIT_SIZES)

kernel_name = 'hybrid_hgrn2_mlstm_moe_block'


def rmsnorm(x, g):
    xf = x.astype(jnp.float32)
    y = xf * lax.rsqrt(jnp.mean(xf * xf, axis=-1, keepdims=True) + EPS)
    return (y * g.astype(jnp.float32)).astype(x.dtype)


def head_rmsnorm(y, g, n_heads):
    b, s, w = y.shape
    yf = y.astype(jnp.float32).reshape(b, s, n_heads, w // n_heads)
    yf = yf * lax.rsqrt(jnp.mean(yf * yf, axis=-1, keepdims=True) + EPS)
    return (yf.reshape(b, s, w) * g.astype(jnp.float32)).astype(y.dtype)


def _split_cols(z):
    idx = [int(c) for c in np.cumsum(IN_SPLIT_SIZES)[:-1]]
    return jnp.split(z, idx, axis=-1)


def _causal_mask():
    return jnp.tril(jnp.ones((CHUNK, CHUNK), dtype=bool))


def _to_chunks(t):
    b, s, h, d = t.shape
    return t.reshape(b, s // CHUNK, CHUNK, h, d).transpose(0, 3, 1, 2, 4)


def _gate_chunks(t):
    b, s, h = t.shape
    return t.reshape(b, s // CHUNK, CHUNK, h).transpose(0, 3, 1, 2)


def _from_chunks(t):
    b, h, n, l, d = t.shape
    return t.transpose(0, 2, 3, 1, 4).reshape(b, n * l, h * d)


def causal_conv(u, w, b):
    s = u.shape[1]
    up = jnp.pad(u, ((0, 0), (CONV_W - 1, 0), (0, 0)))
    out = b
    for j in range(CONV_W):
        out = out + up[:, j:j + s] * w[j]
    return out


def hgrn2_mixer(q, f_logit, v, lb):
    dt = q.dtype
    b_, s_, _ = q.shape
    f32 = jnp.float32
    lbh = lb.astype(f32).reshape(H_A, DK_A)
    fl = f_logit.astype(f32).reshape(b_, s_, H_A, DK_A)
    log_f = jnp.log(lbh + (1.0 - lbh) * jax.nn.sigmoid(fl))
    k = (1.0 - lbh) * jax.nn.sigmoid(-fl)
    qf = jax.nn.silu(q.astype(f32)).reshape(b_, s_, H_A, DK_A)
    vf = v.astype(f32).reshape(b_, s_, H_A, DV_A)
    qf, k, vf, log_f = (_to_chunks(t) for t in (qf, k, vf, log_f))
    bc = jnp.cumsum(log_f, axis=3)
    b_ref = bc[:, :, :, CHUNK // 2:CHUNK // 2 + 1]
    b_end = bc[:, :, :, -1:]
    scores = jnp.einsum('bhnld,bhnmd->bhnlm', qf * jnp.exp(bc - b_ref), k * jnp.exp(b_ref - bc))
    scores = jnp.where(_causal_mask(), scores, 0.0)
    o = jnp.einsum('bhnlm,bhnme->bhnle', scores, vf)
    u = jnp.einsum('bhnld,bhnle->nbhde', k * jnp.exp(b_end - bc), vf)
    decay = jnp.exp(b_end[:, :, :, 0]).transpose(2, 0, 1, 3)

    def step(state, inp):
        a, du = inp
        return a[..., None] * state + du, state

    s0 = jnp.zeros((b_, H_A, DK_A, DV_A), f32)
    _, s_start = lax.scan(step, s0, (decay, u))
    o = o + jnp.einsum('bhnld,nbhde->bhnle', qf * jnp.exp(bc), s_start)
    return _from_chunks(o).astype(dt)


def mlstm_mixer(q, k, v, i_pre, f_pre):
    dt = v.dtype
    b_, s_, _ = q.shape
    f32 = jnp.float32
    qf = _to_chunks(q.astype(f32).reshape(b_, s_, H_B, DQK_B))
    kf = _to_chunks(k.astype(f32).reshape(b_, s_, H_B, DQK_B)) * (DQK_B ** -0.5)
    vf = _to_chunks(v.astype(f32).reshape(b_, s_, H_B, DV_B))
    ig = _gate_chunks(i_pre.astype(f32))
    fcum = jnp.cumsum(jax.nn.log_sigmoid(_gate_chunks(f_pre.astype(f32))), axis=-1)
    g_tot = fcum[..., -1]
    a_end = g_tot[..., None] - fcum + ig
    m_loc = a_end.max(axis=-1)
    w_end = jnp.exp(a_end - m_loc[..., None])
    c_loc = jnp.einsum('bhnl,bhnld,bhnle->nbhde', w_end, kf, vf)
    n_loc = jnp.einsum('bhnl,bhnld->nbhd', w_end, kf)

    def step(carry, inp):
        c, nv, m = carry
        g_n, m_l, c_l, n_l = inp
        m_new = jnp.maximum(g_n + m, m_l)
        s_prev = jnp.exp(g_n + m - m_new)
        s_loc = jnp.exp(m_l - m_new)
        c_new = s_prev[..., None, None] * c + s_loc[..., None, None] * c_l
        n_new = s_prev[..., None] * nv + s_loc[..., None] * n_l
        return (c_new, n_new, m_new), (c, nv, m)

    init = (jnp.zeros((b_, H_B, DQK_B, DV_B), f32), jnp.zeros((b_, H_B, DQK_B), f32),
            jnp.full((b_, H_B), M_INIT, f32))
    _, (c_st, n_st, m_st) = lax.scan(
        step, init, (g_tot.transpose(2, 0, 1), m_loc.transpose(2, 0, 1), c_loc, n_loc))
    d_log = fcum[..., :, None] - fcum[..., None, :] + ig[..., None, :]
    d_log = jnp.where(_causal_mask(), d_log, -jnp.inf)
    a_int = fcum + m_st.transpose(1, 2, 0)[..., None]
    m_t = jnp.maximum(d_log.max(axis=-1), a_int)
    w_in_chunk = jnp.exp(d_log - m_t[..., None])
    w_state = jnp.exp(a_int - m_t)
    qk = jnp.einsum('bhnld,bhnmd->bhnlm', qf, kf) * w_in_chunk
    num = (jnp.einsum('bhnlm,bhnme->bhnle', qk, vf)
           + w_state[..., None] * jnp.einsum('bhnld,nbhde->bhnle', qf, c_st))
    den = qk.sum(axis=-1) + w_state * jnp.einsum('bhnld,nbhd->bhnl', qf, n_st)
    h = num / jnp.maximum(jnp.abs(den), jnp.exp(-m_t))[..., None]
    return _from_chunks(h).astype(dt)


def moe(h, router_w, router_b, w_gu, b_gu, w_dn, b_dn):
    bsz, s, d = h.shape
    hf = h.reshape(-1, d)
    t = hf.shape[0]
    logits = hf.astype(jnp.float32) @ router_w.astype(jnp.float32) + router_b.astype(jnp.float32)
    top_val, top_idx = lax.top_k(logits, TOP_K)
    gates = jax.nn.softmax(top_val, axis=-1).astype(h.dtype)
    flat_e = top_idx.reshape(-1)
    flat_tok = jnp.repeat(jnp.arange(t, dtype=jnp.int32), TOP_K)
    order = jnp.argsort(flat_e)
    e_sorted = flat_e[order]
    counts = jnp.bincount(flat_e, length=N_EXPERTS)
    padded = (counts + EXPERT_BLOCK - 1) // EXPERT_BLOCK * EXPERT_BLOCK
    start = jnp.cumsum(counts) - counts
    pad_end = jnp.cumsum(padded)
    pad_start = pad_end - padded
    dest = pad_start[e_sorted] + jnp.arange(t * TOP_K, dtype=jnp.int32) - start[e_sorted]
    n_rows = t * TOP_K + N_EXPERTS * EXPERT_BLOCK
    n_blocks = n_rows // EXPERT_BLOCK
    row_tok = jnp.zeros((n_rows,), jnp.int32).at[dest].set(flat_tok[order])
    row_gate = jnp.zeros((n_rows,), h.dtype).at[dest].set(gates.reshape(-1)[order])
    block_expert = jnp.minimum(
        jnp.searchsorted(pad_end, jnp.arange(n_blocks, dtype=jnp.int32) * EXPERT_BLOCK, side='right'),
        N_EXPERTS - 1)

    def expert_block(args):
        e, tok, g = args
        xb = hf[tok]
        gu = xb @ w_gu[e] + b_gu[e]
        a, u = jnp.split(gu, 2, axis=-1)
        a = jnp.minimum(a, SWIGLU_LIMIT)
        u = jnp.clip(u, -SWIGLU_LIMIT, SWIGLU_LIMIT)
        y = ((u + 1.0) * a * jax.nn.sigmoid(SWIGLU_ALPHA * a)) @ w_dn[e] + b_dn[e]
        return y * g[:, None]

    y_rows = lax.map(expert_block, (block_expert,
                                    row_tok.reshape(n_blocks, EXPERT_BLOCK),
                                    row_gate.reshape(n_blocks, EXPERT_BLOCK)))
    out = jnp.zeros_like(hf).at[row_tok].add(y_rows.reshape(n_rows, d))
    return out.reshape(bsz, s, d)


def setup_inputs(seed: int = 0) -> dict:
    key = jax.random.key(seed)
    ks = jax.random.split(key, 26)
    f32 = jnp.float32

    def nrm(k, shape, scale):
        return jax.random.normal(k, shape, f32) * scale

    def gain(k, shape):
        return 1.0 + 0.02 * jax.random.normal(k, shape, f32)

    L = DEPTH
    return {
        'x': nrm(ks[0], (BATCH, SEQ, D_MODEL), 1.0),
        'p': nrm(ks[1], (DEPTH, BATCH, SEQ, PLE_DIM), 1.0),
        'norm_mix': gain(ks[2], (L, D_MODEL)),
        'w_in': nrm(ks[3], (L, D_MODEL, IN_COLS), D_MODEL ** -0.5),
        'hgrn_lb': nrm(ks[4], (DEPTH + 1, H_A * DK_A), 0.3),
        'hgrn_norm': gain(ks[5], (L, H_A * DV_A)),
        'mlstm_conv_w': nrm(ks[6], (L, CONV_W, 2 * H_B * DQK_B), CONV_W ** -0.5),
        'mlstm_conv_b': nrm(ks[7], (L, 2 * H_B * DQK_B), 0.02),
        'mlstm_b_i': nrm(ks[8], (L, H_B), 0.1),
        'mlstm_b_f': 3.0 + nrm(ks[9], (L, H_B), 0.1),
        'mlstm_norm': gain(ks[10], (L, H_B * DV_B)),
        'w_branch_a': nrm(ks[11], (L, H_A * DV_A, D_MODEL), (H_A * DV_A) ** -0.5),
        'w_branch_b': nrm(ks[12], (L, H_B * DV_B, D_MODEL), (H_B * DV_B) ** -0.5),
        'w_out': nrm(ks[13], (L, D_MODEL, D_MODEL), D_MODEL ** -0.5),
        'norm_moe': gain(ks[14], (L, D_MODEL)),
        'router_w': nrm(ks[15], (L, D_MODEL, N_EXPERTS), D_MODEL ** -0.5),
        'router_b': nrm(ks[16], (L, N_EXPERTS), 0.01),
        'exp_w_gu': nrm(ks[17], (L, N_EXPERTS, D_MODEL, 2 * D_FF), D_MODEL ** -0.5),
        'exp_b_gu': nrm(ks[18], (L, N_EXPERTS, 2 * D_FF), 0.01),
        'exp_w_dn': nrm(ks[19], (L, N_EXPERTS, D_FF, D_MODEL), D_FF ** -0.5),
        'exp_b_dn': nrm(ks[20], (L, N_EXPERTS, D_MODEL), 0.01),
        'norm_ple': gain(ks[21], (L, D_MODEL)),
        'w_ple': nrm(ks[22], (L, PLE_DIM, D_MODEL), PLE_DIM ** -0.5),
        'w_ple_gate': nrm(ks[23], (L, D_MODEL, D_MODEL), D_MODEL ** -0.5),
        'norm_final': gain(ks[24], (D_MODEL,)),
    }


def reference(x, p, norm_mix, w_in, hgrn_lb, hgrn_norm, mlstm_conv_w, mlstm_conv_b,
              mlstm_b_i, mlstm_b_f, mlstm_norm, w_branch_a, w_branch_b, w_out, norm_moe,
              router_w, router_b, exp_w_gu, exp_b_gu, exp_w_dn, exp_b_dn, norm_ple,
              w_ple, w_ple_gate, norm_final):
    lower_bounds = jnp.cumsum(jax.nn.softmax(hgrn_lb.astype(jnp.float32), axis=0), axis=0)
    for i in range(DEPTH):
        h = rmsnorm(x, norm_mix[i])
        (a_q, a_f, a_v, a_g, b_qk, b_v, b_i, b_f, b_o, r_a, r_b) = _split_cols(h @ w_in[i])
        y_a = hgrn2_mixer(a_q, a_f, a_v, lower_bounds[i])
        y_a = head_rmsnorm(y_a, hgrn_norm[i], H_A) * jax.nn.silu(a_g)
        qk = jax.nn.silu(causal_conv(b_qk, mlstm_conv_w[i], mlstm_conv_b[i]))
        b_q, b_k = jnp.split(qk, 2, axis=-1)
        y_b = mlstm_mixer(b_q, b_k, b_v, b_i + mlstm_b_i[i], b_f + mlstm_b_f[i])
        y_b = head_rmsnorm(y_b, mlstm_norm[i], H_B) * jax.nn.sigmoid(b_o)
        mix = (jax.nn.sigmoid(r_a) * (y_a @ w_branch_a[i])
               + jax.nn.sigmoid(r_b) * (y_b @ w_branch_b[i]))
        x = x + mix @ w_out[i]
        x = x + moe(rmsnorm(x, norm_moe[i]), router_w[i], router_b[i],
                    exp_w_gu[i], exp_b_gu[i], exp_w_dn[i], exp_b_dn[i])
        x = x + (p[i] @ w_ple[i]) * jax.nn.sigmoid(rmsnorm(x, norm_ple[i]) @ w_ple_gate[i])
    return rmsnorm(x, norm_final)
```

```cpp
#include <hip/hip_runtime.h>
#include <cstdio>
#include <cstdint>
#include <cstring>

#define DI __device__ __forceinline__
#define LAS __attribute__((address_space(3)))

typedef unsigned short bf16;
typedef short bf16x8 __attribute__((ext_vector_type(8)));
typedef float f32x4 __attribute__((ext_vector_type(4)));
typedef float f32x16 __attribute__((ext_vector_type(16)));
typedef unsigned u32x4 __attribute__((ext_vector_type(4)));
typedef unsigned u32x2 __attribute__((ext_vector_type(2)));

#ifndef NAIVE_GEMM_MASK
#define NAIVE_GEMM_MASK 0x0
#endif
#ifndef NAIVE_MIXERS
#define NAIVE_MIXERS 0
#endif
#ifndef ONE_LAUNCH
#define ONE_LAUNCH 1
#endif

constexpr int T = 32768, D = 2048, SEQ = 8192;
constexpr int NZ = 11264, INCOLS = 11272;
constexpr int ZQA = 0, ZKA = 1024, ZVA = 2048, ZGA = 3072, ZQK = 4096, ZVB = 5120, ZOB = 6144, ZRA = 7168, ZRB = 9216;
constexpr int NE = 32, DFF = 2048, PLE = 256;
constexpr int NRMAX = T * 4 + NE * 256;
constexpr int NBMAX = NRMAX / 256;
constexpr float EPS = 1e-6f;
constexpr int NCHUNK = 128;
constexpr int NITEM_A = 4 * NCHUNK * 8;
constexpr int NITEM_B = 4 * NCHUNK * 4;

constexpr size_t al4k(size_t x) { return (x + 4095) & ~(size_t)4095; }
constexpr size_t MiB = (size_t)1 << 20;
constexpr size_t O_CTL = 0;
constexpr size_t O_RS0 = 1 * MiB;
constexpr size_t O_RS1 = O_RS0 + al4k((size_t)T * 4);
constexpr size_t O_RS2 = O_RS1 + al4k((size_t)T * 4);
constexpr size_t O_GATES = O_RS2 + al4k((size_t)T * 4);
constexpr size_t O_RWG = O_GATES + al4k((size_t)T * 8 * 4);
constexpr size_t O_DEC = O_RWG + al4k((size_t)D * NE * 4);
constexpr size_t O_NL = O_DEC + al4k((size_t)NITEM_A * 128 * 4);
constexpr size_t O_MLOC = O_NL + al4k((size_t)NITEM_B * 128 * 4);
constexpr size_t O_GTOT = O_MLOC + al4k((size_t)NITEM_B * 4);
constexpr size_t O_MST = O_GTOT + al4k((size_t)NITEM_B * 4);
constexpr size_t O_TOPE = O_MST + al4k((size_t)NITEM_B * 4);
constexpr size_t O_TOPG = O_TOPE + al4k((size_t)T * 4 * 4);
constexpr size_t O_SLOT = O_TOPG + al4k((size_t)T * 4 * 4);
constexpr size_t O_HIST = O_SLOT + al4k((size_t)T * 4 * 4);
constexpr size_t O_ROWTOK = O_HIST + al4k((size_t)256 * 32 * 4);
constexpr size_t O_ROWG = O_ROWTOK + al4k((size_t)NRMAX * 4);
constexpr size_t O_ROWRS = O_ROWG + al4k((size_t)NRMAX * 4);
constexpr size_t O_BLKE = O_ROWRS + al4k((size_t)NRMAX * 4);
constexpr size_t O_SS1 = O_BLKE + al4k((size_t)(NBMAX + 16) * 4);
constexpr size_t O_SS3 = O_SS1 + al4k((size_t)T * 32 * 4);
constexpr size_t O_SMALL_END = O_SS3 + al4k((size_t)T * 32 * 4);
static_assert(O_SMALL_END <= 32 * MiB, "small region");
constexpr size_t O_WIN = 32 * MiB;
constexpr size_t O_WA = O_WIN + (size_t)NZ * D * 2;
constexpr size_t O_WB = O_WA + (size_t)D * 1024 * 2;
constexpr size_t O_WOUT = O_WB + (size_t)D * 1024 * 2;
constexpr size_t O_WPG = O_WOUT + (size_t)D * D * 2;
constexpr size_t O_WPLE = O_WPG + (size_t)D * D * 2;
constexpr size_t O_WGU = O_WPLE + (size_t)D * PLE * 2;
constexpr size_t O_WDN = O_WGU + (size_t)NE * 4096 * D * 2;
constexpr size_t O_XB = O_WDN + (size_t)NE * D * DFF * 2;
constexpr size_t O_PB = O_XB + (size_t)T * D * 2;
constexpr size_t O_Z = O_PB + (size_t)T * PLE * 2;
constexpr size_t O_M = O_Z + (size_t)T * NZ * 2;
constexpr size_t O_LF = O_M;
constexpr size_t O_UST = O_LF + (size_t)T * 1024 * 4;
constexpr size_t O_CT = O_UST + (size_t)NITEM_A * 128 * 128 * 2;
constexpr size_t O_YA = O_CT + (size_t)NITEM_B * 256 * 128 * 2;
constexpr size_t O_YB = O_YA + (size_t)T * 1024 * 2;
constexpr size_t O_MIX = O_YB + (size_t)T * 1024 * 2;
constexpr size_t O_M_END = O_MIX + (size_t)T * D * 2;
static_assert(O_M_END - O_M >= (size_t)NRMAX * D * 2, "YBUF alias");
static_assert((size_t)T * NZ * 2 >= (size_t)NRMAX * D * 2, "ACT alias");
constexpr size_t O_MIXT = O_M_END;
constexpr size_t O_X1 = O_MIXT + (size_t)T * D * 4;
constexpr size_t O_X1B = O_X1 + (size_t)T * D * 4;
constexpr size_t WS_END = O_X1B + (size_t)T * D * 2;
constexpr size_t O_ACT = O_Z, O_YBUF = O_M, O_X2 = O_MIXT, O_X2B = O_XB, O_PW = O_X1B;

constexpr int CW_BAR = 4096;

DI int lane_id() { int l; asm volatile("v_mbcnt_lo_u32_b32 %0, -1, 0\n\tv_mbcnt_hi_u32_b32 %0, -1, %0" : "=v"(l)); return l; }
DI unsigned f2bf(float f) { unsigned u = __float_as_uint(f); return (u + 0x7fffu + ((u >> 16) & 1u)) >> 16; }
DI float bf2f(unsigned h) { return __uint_as_float(h << 16); }
DI unsigned pk2(float lo, float hi) { unsigned r; asm volatile("v_cvt_pk_bf16_f32 %0, %1, %2" : "=v"(r) : "v"(lo), "v"(hi)); return r; }
typedef float f32x2 __attribute__((ext_vector_type(2)));
typedef __bf16 bf16x2_t __attribute__((ext_vector_type(2)));
DI unsigned pk2c(float lo, float hi) { const f32x2 v = {lo, hi}; return __builtin_bit_cast(unsigned, __builtin_convertvector(v, bf16x2_t)); }
DI float sigm(float x) { return __builtin_amdgcn_rcpf(1.f + __expf(-x)); }
DI float wave_sum(float v) {
#pragma unroll
    for (int o = 1; o < 64; o <<= 1) v += __shfl_xor(v, o);
    return v;
}
DI float wave_max(float v) {
#pragma unroll
    for (int o = 1; o < 64; o <<= 1) v = fmaxf(v, __shfl_xor(v, o));
    return v;
}
DI void unpack8(const u32x4 w, float (&o)[8]) {
    o[0] = bf2f(w.x & 0xffffu); o[1] = bf2f(w.x >> 16); o[2] = bf2f(w.y & 0xffffu); o[3] = bf2f(w.y >> 16);
    o[4] = bf2f(w.z & 0xffffu); o[5] = bf2f(w.z >> 16); o[6] = bf2f(w.w & 0xffffu); o[7] = bf2f(w.w >> 16);
}
DI u32x4 pack8(const float (&v)[8]) { u32x4 w; w.x = pk2(v[0], v[1]); w.y = pk2(v[2], v[3]); w.z = pk2(v[4], v[5]); w.w = pk2(v[6], v[7]); return w; }
DI u32x4 pack8c(const float (&v)[8]) { u32x4 w; w.x = pk2c(v[0], v[1]); w.y = pk2c(v[2], v[3]); w.z = pk2c(v[4], v[5]); w.w = pk2c(v[6], v[7]); return w; }
DI float log_sigmoid(float x) { return fminf(x, 0.f) - __logf(1.f + __expf(-fabsf(x))); }

#define XB_TMO      128
#define XB_XCNT(j)  (256  + 64 * (j))
#define XB_XSUB(j)  (1280 + 64 * (j))
#define XB_XGEN(j)  (2304 + 64 * (j))
#define XB_TOP      3328
#define XB_TOPGEN   3392
#define XCD_BAR_WORDS 3456
#define XB_SPIN_CAP (1u << 18)
__device__ __forceinline__ unsigned xb_ld(unsigned* p)              { return __hip_atomic_load(p, __ATOMIC_RELAXED, __HIP_MEMORY_SCOPE_AGENT); }
__device__ __forceinline__ unsigned xb_add(unsigned* p, unsigned v) { return __hip_atomic_fetch_add(p, v, __ATOMIC_RELAXED, __HIP_MEMORY_SCOPE_AGENT); }
__device__ __forceinline__ unsigned xb_xcc_id() { return (unsigned)__builtin_amdgcn_s_getreg((3 << 11) | 20) & 0xFu; }
#define XB_SPIN(cond, bar) do { unsigned _sp = 0; while (cond) { __builtin_amdgcn_s_sleep(1); \
    if ((++_sp & 255u) == 0u) { if (xb_ld(&(bar)[XB_TMO])) break; if (_sp > XB_SPIN_CAP) { atomicAdd(&(bar)[XB_TMO], 1u); break; } } } } while (0)
struct XcdBarrier { unsigned* bar; unsigned x; volatile LAS unsigned* st; };
__device__ __forceinline__ XcdBarrier xcd_barrier_post(unsigned* bar, volatile LAS unsigned* st, bool leader) {
    XcdBarrier b; b.bar = bar; b.x = xb_xcc_id(); b.st = st;
    if (leader) (void)xb_add(&bar[XB_XCNT(b.x)], 1u);
    return b;
}
__device__ __forceinline__ void xcd_barrier_complete(unsigned* bar, unsigned x, unsigned& nloc, unsigned& nx) {
    const unsigned G = gridDim.x * gridDim.y * gridDim.z;
    unsigned sum, cnt, mine, sp = 0u;
    for (;;) {
        sum = 0u; cnt = 0u; mine = 0u;
#pragma unroll
        for (unsigned j = 0; j < 16; ++j) { const unsigned c = xb_ld(&bar[XB_XCNT(j)]); sum += c; cnt += (c > 0u) ? 1u : 0u; mine = (j == x) ? c : mine; }
        if (sum == G) break;
        __builtin_amdgcn_s_sleep(1);
        if ((++sp & 255u) == 0u) { if (xb_ld(&bar[XB_TMO])) break; if (sp > XB_SPIN_CAP) { atomicAdd(&bar[XB_TMO], 1u); break; } }
    }
    nloc = mine > 0u ? mine : 1u; nx = cnt > 0u ? cnt : 1u;
}
__device__ __forceinline__ void xcd_barrier(const XcdBarrier& b, bool leader) {
    asm volatile("s_waitcnt vmcnt(0)" ::: "memory");
    __syncthreads();
    if (leader) {
        unsigned* bar = b.bar;
        __builtin_amdgcn_s_waitcnt(0);
        unsigned nloc = b.st[0], nx = b.st[1];
        if (nloc == 0u) { xcd_barrier_complete(bar, b.x, nloc, nx); b.st[0] = nloc; b.st[1] = nx; }
        const unsigned old = xb_add(&bar[XB_XSUB(b.x)], 1u);
        const unsigned gen = old / nloc;
        if (old + 1u == (gen + 1u) * nloc) {
            __builtin_amdgcn_fence(__ATOMIC_RELEASE, "agent");
            asm volatile("s_waitcnt vmcnt(0)" ::: "memory");
            const unsigned og = xb_add(&bar[XB_TOP], 1u);
            const unsigned tg = og / nx;
            if (og + 1u == (tg + 1u) * nx) xb_add(&bar[XB_TOPGEN], 1u);
            else XB_SPIN(xb_ld(&bar[XB_TOPGEN]) == tg, bar);
            __builtin_amdgcn_fence(__ATOMIC_ACQUIRE, "agent");
            xb_add(&bar[XB_XGEN(b.x)], 1u);
            asm volatile("s_waitcnt vmcnt(0)" ::: "memory");
        } else {
            XB_SPIN(xb_ld(&bar[XB_XGEN(b.x)]) == gen, bar);
            __builtin_amdgcn_fence(__ATOMIC_ACQUIRE, "agent");
            asm volatile("s_waitcnt vmcnt(0)" ::: "memory");
        }
    }
    __syncthreads();
}

namespace pg8 {
constexpr int BM = 256, BK = 64, HALF = 128, HTB = HALF * BK * 2, STAGE_BYTES = 8 * HTB, NXCD = 8, WGM = 8;
__host__ __device__ __forceinline__ int lds_byte(int r, int c) { const int st = (r >> 4) * 2 + (c >> 5), rr = r & 15, cc = c & 31, ob = rr * 64 + cc * 2; return st * 1024 + (ob ^ (((ob >> 9) & 1) << 5)); }
__host__ __device__ __forceinline__ void stage_rc(int b, int& R, int& C) { const int st = b / 1024, sb = b % 1024, swz = sb ^ (((sb >> 9) & 1) << 5); R = (st >> 1) * 16 + swz / 64; C = (st & 1) * 32 + (swz % 64) / 2; }
__host__ __device__ __forceinline__ int perm32(int rho) { const int n = rho >> 4, i = rho & 15; return 8 * (i >> 2) + 4 * n + (i & 3); }

struct Unit { int pm, pn, e; };

struct OrderBase {
    int nM, nN, nwg, G, c;
    DI void init_order(int nM_, int nN_, int G_, int c_) { nM = nM_; nN = nN_; nwg = nM * nN; G = G_; c = c_; }
    DI bool next_mn(int i, Unit& u) const {
        const long L = (long)i * G + c; if (L >= nwg) return false;
        int wgid = (int)L; { const int q = nwg / NXCD, r = nwg % NXCD, xcd = wgid % NXCD, off = wgid / NXCD; wgid = (xcd < r ? xcd * (q + 1) : r * (q + 1) + (xcd - r) * q) + off; }
        const int nig = WGM * nN, gid = wgid / nig, fm = gid * WGM, gsz = (nM - fm) < WGM ? (nM - fm) : WGM;
        u.pm = fm + ((wgid % nig) % gsz); u.pn = (wgid % nig) / gsz; return true;
    }
};
struct SchedPlain : OrderBase {
    static constexpr bool GATHER = false;
    const char* Bt; int K;
    DI void init(int M, int N, int K_, const void* Bt_, int G_, int c_) { init_order(M / BM, N / BM, G_, c_); Bt = (const char*)Bt_; K = K_; }
    DI bool next(int i, Unit& u) const { u.e = 0; return next_mn(i, u); }
    DI bool unit_of(int L, Unit& u) const { u.e = 0; u.pm = L / nN; u.pn = L % nN; return u.pm < nM; }
    DI unsigned a_row_off(const Unit& u, int r) const { return (unsigned)(u.pm * BM + r) * (unsigned)(K * 2); }
    DI const char* b_ptr(const Unit& u) const { return Bt + (size_t)u.pn * BM * K * 2; }
};
template <bool GATHER_> struct SchedMoE : OrderBase {
    static constexpr bool GATHER = GATHER_;
    const char* Bt; int K; const int* blke; const int* rowtok; size_t estride;
    DI void init(int nblk, int N, int K_, const void* Bt_, size_t estride_, const int* blke_, const int* rowtok_, int G_, int c_) { init_order(nblk, N / BM, G_, c_); Bt = (const char*)Bt_; K = K_; blke = blke_; rowtok = rowtok_; estride = estride_; }
    DI bool next(int i, Unit& u) const { if (!next_mn(i, u)) return false; u.e = __builtin_amdgcn_readfirstlane(blke[u.pm]); return true; }
    DI bool unit_of(int L, Unit& u) const { u.pm = L / nN; u.pn = L % nN; if (u.pm >= nM) return false; u.e = blke[u.pm]; return true; }
    DI unsigned a_row_off(const Unit& u, int r) const { const int row = u.pm * BM + r; return (unsigned)(GATHER ? rowtok[row] : row) * (unsigned)(K * 2); }
    DI const char* b_ptr(const Unit& u) const { return Bt + (size_t)u.e * estride + (size_t)u.pn * BM * K * 2; }
};

template <class E> struct EpiWrap {
    static constexpr bool PERM = true, AFTER_DRAIN = false;
    E e;
    DI void operator()(const f32x4 (&acc)[2][2][4][2], const Unit& u, int wr, int wc, int fr, int fq) const {
#pragma unroll
        for (int ai = 0; ai < 2; ++ai)
#pragma unroll
            for (int m = 0; m < 4; ++m) {
                const int row = u.pm * BM + ai * HALF + wr * 64 + m * 16 + fr, lc = wc * 32 + 8 * fq;
                float v0[8], v1[8];
#pragma unroll
                for (int j = 0; j < 4; ++j) { v0[j] = acc[ai][0][m][0][j]; v0[4 + j] = acc[ai][0][m][1][j]; v1[j] = acc[ai][1][m][0][j]; v1[4 + j] = acc[ai][1][m][1][j]; }
                e.store(u, row, lc, v0, v1);
            }
    }
};

template <class Epi, class Sched, bool ALIGN_EPI = true, bool SP2 = true>
__device__ __forceinline__ void gemm_phase(LAS unsigned char* lds, const int wave_, const char* Abase, const int K, const Sched& S, const Epi& E) {
    const int lane = lane_id(), wid = wave_, tid = wid * 64 + lane, wr = wid >> 2, wc = wid & 3, fr = lane & 15, fq = lane >> 4;
    const int nt = K / BK;
    int Rr[2], Cc[2]; unsigned voffB[2], voffA[2];
#pragma unroll
    for (int i = 0; i < 2; ++i) { stage_rc(tid * 16 + i * 8192, Rr[i], Cc[i]); const int Rb = Epi::PERM ? ((Rr[i] & ~31) + perm32(Rr[i] & 31)) : Rr[i]; voffB[i] = (unsigned)(Rb * K + Cc[i]) * 2u; voffA[i] = (unsigned)(Rr[i] * K + Cc[i]) * 2u; }
    const size_t kstep = (size_t)(BK * 2);
    const size_t hstep = (size_t)HALF * K * 2;
    const unsigned ldsw = (unsigned)wid * 1024u;
    const int aoff = lds_byte(wr * 64 + fr, fq * 8), boff = lds_byte(wc * 32 + fr, fq * 8);
#define PG8_SA(b, h) (((b) * 2 + (h)) * HTB)
#define PG8_SB(b, h) ((4 + (b) * 2 + (h)) * HTB)
#define PG8_STAGE(bufoff, gbase, v0_, v1_) do { \
        __builtin_amdgcn_global_load_lds((const unsigned*)((const char*)(gbase) + (v0_)), (LAS unsigned*)(lds + (bufoff) + ldsw), 16, 0, 0); \
        __builtin_amdgcn_global_load_lds((const unsigned*)((const char*)(gbase) + (v1_)), (LAS unsigned*)(lds + (bufoff) + ldsw + 8192), 16, 0, 0); } while (0)
#define PG8_STAGEB(bufoff, gbase) PG8_STAGE(bufoff, gbase, voffB[0], voffB[1])
#define PG8_STAGEA(bufoff, h, uptr, kb, useNext) do { if constexpr (Sched::GATHER) { const unsigned o0_ = (useNext) ? nvA[h][0] : vA[h][0], o1_ = (useNext) ? nvA[h][1] : vA[h][1]; PG8_STAGE(bufoff, Abase + (kb), o0_, o1_); } \
        else { PG8_STAGE(bufoff, (uptr) + (h) * hstep, voffA[0], voffA[1]); } } while (0)
#define PG8_LDA(dst, b, h) do { _Pragma("unroll") for (int m = 0; m < 4; ++m) _Pragma("unroll") for (int k = 0; k < 2; ++k) dst[m][k] = *(const LAS bf16x8*)(lds + PG8_SA(b, h) + aoff + m * 2048 + k * 1024); } while (0)
#define PG8_LDB(dst, b, h) do { _Pragma("unroll") for (int n = 0; n < 2; ++n) _Pragma("unroll") for (int k = 0; k < 2; ++k) dst[n][k] = *(const LAS bf16x8*)(lds + PG8_SB(b, h) + boff + n * 2048 + k * 1024); } while (0)
#define PG8_MMA(ai, bj, At, Bt) do { __builtin_amdgcn_s_setprio(1); _Pragma("unroll") for (int m = 0; m < 4; ++m) _Pragma("unroll") for (int n = 0; n < 2; ++n) _Pragma("unroll") for (int k = 0; k < 2; ++k) \
        acc[ai][bj][m][n] = __builtin_amdgcn_mfma_f32_16x16x32_bf16(Bt[n][k], At[m][k], acc[ai][bj][m][n], 0, 0, 0); __builtin_amdgcn_s_setprio(0); } while (0)
#define PG8_WAIT_V(n) asm volatile("s_waitcnt vmcnt(" #n ")" ::: "memory")
#define PG8_WAIT_L(n) asm volatile("s_waitcnt lgkmcnt(" #n ")" ::: "memory")
#define PG8_BAR __builtin_amdgcn_s_barrier()
#define PG8_SCHED __builtin_amdgcn_sched_barrier(0)
    Unit cur, nxt; int ui = 0;
    if (!S.next(0, cur)) return;
    f32x4 acc[2][2][4][2];
#pragma unroll
    for (int a = 0; a < 2; ++a)
#pragma unroll
        for (int b = 0; b < 2; ++b)
#pragma unroll
            for (int m = 0; m < 4; ++m)
#pragma unroll
                for (int n = 0; n < 2; ++n) acc[a][b][m][n] = (f32x4){0.f, 0.f, 0.f, 0.f};
    bf16x8 At[4][2], B0[2][2], B1[2][2];
    unsigned vA[2][2] = {{0u, 0u}, {0u, 0u}}, nvA[2][2] = {{0u, 0u}, {0u, 0u}};
    const char* cA = Abase; const char* nA = Abase;
    if constexpr (Sched::GATHER) {
#pragma unroll
        for (int h = 0; h < 2; ++h)
#pragma unroll
            for (int i = 0; i < 2; ++i) vA[h][i] = S.a_row_off(cur, h * HALF + Rr[i]) + (unsigned)Cc[i] * 2u;
    } else cA = Abase + (size_t)S.a_row_off(cur, 0);
    const char* cB = S.b_ptr(cur);
    if constexpr (SP2) {
        PG8_STAGEB(PG8_SB(0, 0), cB); PG8_STAGEB(PG8_SB(0, 1), cB + hstep); PG8_STAGEA(PG8_SA(0, 0), 0, cA, 0, false); PG8_STAGEA(PG8_SA(0, 1), 1, cA, 0, false);
        if (wr == 1) PG8_BAR;
        PG8_WAIT_V(2); PG8_BAR;
        PG8_STAGEB(PG8_SB(1, 0), cB + kstep); PG8_STAGEA(PG8_SA(1, 0), 0, cA + kstep, kstep, false); PG8_STAGEB(PG8_SB(1, 1), cB + hstep + kstep);
        PG8_WAIT_V(6); PG8_BAR;
    } else {
        PG8_STAGEB(PG8_SB(0, 0), cB); PG8_STAGEA(PG8_SA(0, 0), 0, cA, 0, false); PG8_STAGEB(PG8_SB(0, 1), cB + hstep); PG8_STAGEA(PG8_SA(0, 1), 1, cA, 0, false);
        if (wr == 1) PG8_BAR;
        PG8_WAIT_V(4); PG8_BAR;
        PG8_STAGEB(PG8_SB(1, 0), cB + kstep); PG8_STAGEA(PG8_SA(1, 0), 0, cA + kstep, kstep, false); PG8_STAGEB(PG8_SB(1, 1), cB + hstep + kstep);
        PG8_WAIT_V(6); PG8_BAR;
    }
    for (;;) {
        const bool has_next = S.next(ui + 1, nxt);
        const char* nB = cB; nA = cA;
        if (has_next) {
            nB = S.b_ptr(nxt);
            if constexpr (Sched::GATHER) {
#pragma unroll
                for (int h = 0; h < 2; ++h)
#pragma unroll
                    for (int i = 0; i < 2; ++i) nvA[h][i] = S.a_row_off(nxt, h * HALF + Rr[i]) + (unsigned)Cc[i] * 2u;
            } else nA = Abase + (size_t)S.a_row_off(nxt, 0);
        } else if constexpr (Sched::GATHER) {
#pragma unroll
            for (int h = 0; h < 2; ++h)
#pragma unroll
                for (int i = 0; i < 2; ++i) nvA[h][i] = vA[h][i];
        }
#pragma unroll 1
        for (int t = 0; t < nt; t += 2) {
            const bool last = (t == nt - 2);
            const char* a1 = cA + (size_t)(t + 1) * kstep; const size_t k1 = (size_t)(t + 1) * kstep;
            const char* a2 = last ? nA : cA + (size_t)(t + 2) * kstep; const char* b2 = last ? nB : cB + (size_t)(t + 2) * kstep; const size_t k2 = last ? (size_t)0 : (size_t)(t + 2) * kstep;
            const char* a3 = a2 + kstep; const char* b3 = b2 + kstep; const size_t k3 = k2 + kstep;
            if constexpr (SP2) {
            PG8_LDB(B0, 0, 0); PG8_LDB(B1, 0, 1); PG8_SCHED; PG8_LDA(At, 0, 0); PG8_STAGEA(PG8_SA(1, 1), 1, a1, k1, false);
            PG8_WAIT_V(8); PG8_WAIT_L(0); PG8_BAR; PG8_MMA(0, 0, At, B0); PG8_MMA(0, 1, At, B1); PG8_BAR; PG8_SCHED;
            PG8_LDA(At, 0, 1); PG8_STAGEB(PG8_SB(0, 0), b2); PG8_STAGEB(PG8_SB(0, 1), b2 + hstep); PG8_STAGEA(PG8_SA(0, 0), 0, a2, k2, last);
            PG8_WAIT_V(8); PG8_WAIT_L(0); PG8_BAR; PG8_MMA(1, 0, At, B0); PG8_MMA(1, 1, At, B1); PG8_BAR; PG8_SCHED;
            PG8_LDB(B0, 1, 0); PG8_LDB(B1, 1, 1); PG8_SCHED; PG8_LDA(At, 1, 0); PG8_STAGEA(PG8_SA(0, 1), 1, a2, k2, last);
            PG8_WAIT_V(8); PG8_WAIT_L(0); PG8_BAR; PG8_MMA(0, 0, At, B0); PG8_MMA(0, 1, At, B1); PG8_BAR; PG8_SCHED;
            PG8_LDA(At, 1, 1); PG8_STAGEB(PG8_SB(1, 0), b3); PG8_STAGEB(PG8_SB(1, 1), b3 + hstep); PG8_STAGEA(PG8_SA(1, 0), 0, a3, k3, last);
            PG8_WAIT_V(8); PG8_WAIT_L(0); PG8_BAR; PG8_MMA(1, 0, At, B0); PG8_MMA(1, 1, At, B1); PG8_BAR; PG8_SCHED;
            } else {
            PG8_LDB(B0, 0, 0); PG8_SCHED; PG8_LDA(At, 0, 0); PG8_STAGEA(PG8_SA(1, 1), 1, a1, k1, false);
            PG8_WAIT_L(8); PG8_BAR; PG8_WAIT_L(0); PG8_MMA(0, 0, At, B0); PG8_BAR; PG8_SCHED;
            PG8_LDB(B1, 0, 1); PG8_STAGEB(PG8_SB(0, 0), b2);
            PG8_BAR; PG8_WAIT_L(0); PG8_MMA(0, 1, At, B1); PG8_BAR;
            PG8_LDA(At, 0, 1); PG8_STAGEA(PG8_SA(0, 0), 0, a2, k2, last);
            PG8_BAR; PG8_WAIT_L(0); PG8_MMA(1, 0, At, B0); PG8_BAR; PG8_SCHED;
            PG8_STAGEB(PG8_SB(0, 1), b2 + hstep);
            PG8_WAIT_V(6); PG8_BAR; PG8_MMA(1, 1, At, B1); PG8_BAR;
            PG8_LDB(B0, 1, 0); PG8_SCHED; PG8_LDA(At, 1, 0); PG8_STAGEA(PG8_SA(0, 1), 1, a2, k2, last);
            PG8_WAIT_L(8); PG8_BAR; PG8_WAIT_L(0); PG8_MMA(0, 0, At, B0); PG8_BAR; PG8_SCHED;
            PG8_LDB(B1, 1, 1); PG8_STAGEB(PG8_SB(1, 0), b3);
            PG8_BAR; PG8_WAIT_L(0); PG8_MMA(0, 1, At, B1); PG8_BAR;
            PG8_LDA(At, 1, 1); PG8_STAGEA(PG8_SA(1, 0), 0, a3, k3, last);
            PG8_BAR; PG8_WAIT_L(0); PG8_MMA(1, 0, At, B0); PG8_BAR; PG8_SCHED;
            PG8_STAGEB(PG8_SB(1, 1), b3 + hstep);
            PG8_WAIT_V(6); PG8_BAR; PG8_MMA(1, 1, At, B1); PG8_BAR;
            }
        }
        if constexpr (ALIGN_EPI) { if (wr == 0) PG8_BAR; }
        E(acc, cur, wr, wc, fr, fq);
        if (!has_next) break;
#pragma unroll
        for (int a = 0; a < 2; ++a)
#pragma unroll
            for (int b = 0; b < 2; ++b)
#pragma unroll
                for (int m = 0; m < 4; ++m)
#pragma unroll
                    for (int n = 0; n < 2; ++n) acc[a][b][m][n] = (f32x4){0.f, 0.f, 0.f, 0.f};
        cur = nxt; cB = nB; cA = nA; ++ui;
        if constexpr (Sched::GATHER) {
#pragma unroll
            for (int h = 0; h < 2; ++h)
#pragma unroll
                for (int i = 0; i < 2; ++i) vA[h][i] = nvA[h][i];
        }
        if constexpr (ALIGN_EPI) { if (wr == 1) PG8_BAR; }
    }
    PG8_WAIT_V(0);
    if constexpr (!ALIGN_EPI) { if (wr == 0) PG8_BAR; }
    PG8_BAR;
#undef PG8_SA
#undef PG8_SB
#undef PG8_STAGE
#undef PG8_STAGEB
#undef PG8_STAGEA
#undef PG8_LDA
#undef PG8_LDB
#undef PG8_MMA
#undef PG8_WAIT_V
#undef PG8_WAIT_L
#undef PG8_BAR
#undef PG8_SCHED
}
}
using pg8::Unit;

struct EInproj {
    bf16* Z; float* LF; const float* rs0; const float* hlb;
    DI void store(const Unit& u, int row, int lc, const float (&v0)[8], const float (&v1)[8]) const {
        const float rs = rs0[row];
        const int kind = u.pn >> 2;
#pragma unroll
        for (int bj = 0; bj < 2; ++bj) {
            const int col = u.pn * 256 + bj * 128 + lc;
            float o[8];
            if (kind == 2 || kind == 4 || kind == 5) {
#pragma unroll
                for (int i = 0; i < 8; ++i) o[i] = rs * (bj ? v1[i] : v0[i]);
            } else if (kind == 1) {
                const int c = col - 1024;
                float lf[8];
#pragma unroll
                for (int i = 0; i < 8; ++i) {
                    const float lbv = sigm(hlb[c + i] - hlb[1024 + c + i]);
                    float z = rs * (bj ? v1[i] : v0[i]); z = fminf(fmaxf(z, -80.f), 80.f);
                    const float e = __expf(-z), s = __builtin_amdgcn_rcpf(1.f + e), sn = e * s;
                    lf[i] = __logf(lbv + (1.f - lbv) * s);
                    o[i] = (1.f - lbv) * sn;
                }
                float* lp = LF + (size_t)row * 1024 + c;
                *(f32x4*)lp = (f32x4){lf[0], lf[1], lf[2], lf[3]}; *(f32x4*)(lp + 4) = (f32x4){lf[4], lf[5], lf[6], lf[7]};
            } else {
                const bool silu = (kind == 0 || kind == 3);
#pragma unroll
                for (int i = 0; i < 8; ++i) { const float z = rs * (bj ? v1[i] : v0[i]); const float s = sigm(z); o[i] = silu ? z * s : s; }
            }
            *(u32x4*)(Z + (size_t)row * NZ + col) = pack8(o);
        }
    }
};
struct EMixA {
    float* MIXT; const bf16* Z;
    DI void store(const Unit& u, int row, int lc, const float (&v0)[8], const float (&v1)[8]) const {
#pragma unroll
        for (int bj = 0; bj < 2; ++bj) {
            const int col = u.pn * 256 + bj * 128 + lc; float g[8];
            unpack8(*(const u32x4*)(Z + (size_t)row * NZ + ZRA + col), g);
            float* p = MIXT + (size_t)row * D + col;
            f32x4 a, b;
#pragma unroll
            for (int i = 0; i < 4; ++i) { a[i] = g[i] * (bj ? v1[i] : v0[i]); b[i] = g[4 + i] * (bj ? v1[4 + i] : v0[4 + i]); }
            *(f32x4*)p = a; *(f32x4*)(p + 4) = b;
        }
    }
};
struct EMixB {
    const float* MIXT; const bf16* Z; bf16* MIX;
    DI void store(const Unit& u, int row, int lc, const float (&v0)[8], const float (&v1)[8]) const {
#pragma unroll
        for (int bj = 0; bj < 2; ++bj) {
            const int col = u.pn * 256 + bj * 128 + lc; float g[8], o[8];
            unpack8(*(const u32x4*)(Z + (size_t)row * NZ + ZRB + col), g);
            const float* p = MIXT + (size_t)row * D + col;
            const f32x4 a = *(const f32x4*)p, b = *(const f32x4*)(p + 4);
#pragma unroll
            for (int i = 0; i < 4; ++i) { o[i] = a[i] + g[i] * (bj ? v1[i] : v0[i]); o[4 + i] = b[i] + g[4 + i] * (bj ? v1[4 + i] : v0[4 + i]); }
            *(u32x4*)(MIX + (size_t)row * D + col) = pack8(o);
        }
    }
};
struct EX1 {
    const float* x; float* X1; bf16* X1B; float* SS1;
    DI void store(const Unit& u, int row, int lc, const float (&v0)[8], const float (&v1)[8]) const {
        float ss = 0.f;
#pragma unroll
        for (int bj = 0; bj < 2; ++bj) {
            const int col = u.pn * 256 + bj * 128 + lc; float o[8];
            const float* p = x + (size_t)row * D + col;
            const f32x4 a = *(const f32x4*)p, b = *(const f32x4*)(p + 4);
#pragma unroll
            for (int i = 0; i < 4; ++i) { o[i] = a[i] + (bj ? v1[i] : v0[i]); o[4 + i] = b[i] + (bj ? v1[4 + i] : v0[4 + i]); }
#pragma unroll
            for (int i = 0; i < 8; ++i) ss += o[i] * o[i];
            float* q = X1 + (size_t)row * D + col;
            *(f32x4*)q = (f32x4){o[0], o[1], o[2], o[3]}; *(f32x4*)(q + 4) = (f32x4){o[4], o[5], o[6], o[7]};
            *(u32x4*)(X1B + (size_t)row * D + col) = pack8(o);
        }
        ss += __shfl_xor(ss, 16); ss += __shfl_xor(ss, 32);
        if ((lane_id() >> 4) == 0) SS1[(size_t)row * 32 + u.pn * 4 + (lc >> 5)] = ss;
    }
};
struct ESwiglu {
    bf16* ACT; const float* rowrs; const float* bgu;
    DI void store(const Unit& u, int row, int lc, const float (&v0)[8], const float (&v1)[8]) const {
        const float rs = rowrs[row];
        const int j = u.pn * 128 + lc; float o[8];
        const float* ba = bgu + (size_t)u.e * 4096 + j; const float* bu = ba + 2048;
#pragma unroll
        for (int i = 0; i < 8; ++i) {
            float a = rs * v0[i] + ba[i], uu = rs * v1[i] + bu[i];
            a = fminf(a, 7.f); uu = fminf(fmaxf(uu, -7.f), 7.f);
            o[i] = (uu + 1.f) * a * sigm(1.702f * a);
        }
        *(u32x4*)(ACT + (size_t)row * DFF + j) = pack8(o);
    }
};
struct EDown {
    bf16* YB; const float* rowg; const float* bdn;
    DI void store(const Unit& u, int row, int lc, const float (&v0)[8], const float (&v1)[8]) const {
        const float g = rowg[row];
#pragma unroll
        for (int bj = 0; bj < 2; ++bj) {
            const int col = u.pn * 256 + bj * 128 + lc; float o[8];
            const float* b = bdn + (size_t)u.e * D + col;
#pragma unroll
            for (int i = 0; i < 8; ++i) o[i] = ((bj ? v1[i] : v0[i]) + b[i]) * g;
            *(u32x4*)(YB + (size_t)row * D + col) = pack8(o);
        }
    }
};
struct EPw {
    bf16* PW;
    DI void store(const Unit& u, int row, int lc, const float (&v0)[8], const float (&v1)[8]) const {
        *(u32x4*)(PW + (size_t)row * D + u.pn * 256 + lc) = pack8(v0);
        *(u32x4*)(PW + (size_t)row * D + u.pn * 256 + 128 + lc) = pack8(v1);
    }
};
struct EGate {
    const float* X2; const bf16* PW; const float* rs2; float* out; float* SS3;
    DI void store(const Unit& u, int row, int lc, const float (&v0)[8], const float (&v1)[8]) const {
        const float rs = rs2[row]; float ss = 0.f;
#pragma unroll
        for (int bj = 0; bj < 2; ++bj) {
            const int col = u.pn * 256 + bj * 128 + lc; float pw[8], o[8];
            unpack8(*(const u32x4*)(PW + (size_t)row * D + col), pw);
            const float* p = X2 + (size_t)row * D + col;
            const f32x4 a = *(const f32x4*)p, b = *(const f32x4*)(p + 4);
#pragma unroll
            for (int i = 0; i < 4; ++i) { o[i] = a[i] + pw[i] * sigm(rs * (bj ? v1[i] : v0[i])); o[4 + i] = b[i] + pw[4 + i] * sigm(rs * (bj ? v1[4 + i] : v0[4 + i])); }
#pragma unroll
            for (int i = 0; i < 8; ++i) ss += o[i] * o[i];
            float* q = out + (size_t)row * D + col;
            *(f32x4*)q = (f32x4){o[0], o[1], o[2], o[3]}; *(f32x4*)(q + 4) = (f32x4){o[4], o[5], o[6], o[7]};
        }
        ss += __shfl_xor(ss, 16); ss += __shfl_xor(ss, 32);
        if ((lane_id() >> 4) == 0) SS3[(size_t)row * 32 + u.pn * 4 + (lc >> 5)] = ss;
    }
};

struct Args {
    const float* in[25]; float* out; unsigned char* ws; int ph_lo, ph_hi;
};
enum { I_X = 0, I_P, I_NORM_MIX, I_W_IN, I_HGRN_LB, I_HGRN_NORM, I_CONV_W, I_CONV_B, I_B_I, I_B_F, I_MLSTM_NORM, I_W_BRA, I_W_BRB, I_W_OUT, I_NORM_MOE,
       I_ROUTER_W, I_ROUTER_B, I_W_GU, I_B_GU, I_W_DN, I_B_DN, I_NORM_PLE, I_W_PLE, I_W_PLE_GATE, I_NORM_FINAL };

struct Frame {
    LAS unsigned char* lds; int wave, G, bid;
    const float* const* in; float* out; unsigned char* ws;
    template <class Tp> DI Tp* p(size_t off) const { return (Tp*)(ws + off); }
};

constexpr int LDS_BYTES = 147456;
constexpr int LDS_MISC = 131072;

DI void tr_tile(const float* __restrict__ W, size_t ldw, int k0, int sc0, const float* __restrict__ kscale, bf16* __restrict__ dst, size_t drow0, int ldd, LAS unsigned* scr, int lane) {
    const int a = lane & 15, b = lane >> 4;
    f32x4 v[16];
#pragma unroll
    for (int i = 0; i < 8; ++i) {
        const int k = k0 + 8 * i + 2 * b;
        v[2 * i] = *(const f32x4*)(W + (size_t)k * ldw + sc0 + 4 * a);
        v[2 * i + 1] = *(const f32x4*)(W + (size_t)(k + 1) * ldw + sc0 + 4 * a);
    }
#pragma unroll
    for (int i = 0; i < 8; ++i) {
        const int k = k0 + 8 * i + 2 * b;
        float s0 = 1.f, s1 = 1.f; if (kscale) { s0 = kscale[k]; s1 = kscale[k + 1]; }
#pragma unroll
        for (int c = 0; c < 4; ++c) scr[(4 * a + c) * 33 + 4 * i + b] = pk2(v[2 * i][c] * s0, v[2 * i + 1][c] * s1);
    }
    asm volatile("s_waitcnt lgkmcnt(0)" ::: "memory");
#pragma unroll
    for (int j = 0; j < 8; ++j) {
        const int n = (lane >> 3) + 8 * j, kc = lane & 7;
        u32x4 o; o.x = scr[n * 33 + 4 * kc]; o.y = scr[n * 33 + 4 * kc + 1]; o.z = scr[n * 33 + 4 * kc + 2]; o.w = scr[n * 33 + 4 * kc + 3];
        *(u32x4*)(dst + (drow0 + n) * (size_t)ldd + k0 + 8 * kc) = o;
    }
    asm volatile("s_waitcnt lgkmcnt(0)" ::: "memory");
}

DI void p0_prologue(const Frame& F) {
    const int lane = lane_id(), wave = F.wave, tid = wave * 64 + lane;
    const int gw = F.bid * 8 + wave, NGW = F.G * 8;
    {
        LAS unsigned* scr = (LAS unsigned*)(F.lds + wave * 8704);
        constexpr int TI_WIN = 32 * 176, TI_WA = 16 * 32, TI_WB = 16 * 32, TI_WOUT = 32 * 32, TI_WPG = 32 * 32, TI_WPLE = 4 * 32, TI_WGU = 32 * 2048, TI_WDN = 32 * 1024;
        constexpr int NTI = TI_WIN + TI_WA + TI_WB + TI_WOUT + TI_WPG + TI_WPLE + TI_WGU + TI_WDN;
        for (int it = gw; it < NTI; it += NGW) {
            int r = it;
            if (r < TI_WIN) { const int kb = r / 176, nb = r % 176, n0 = 64 * nb, sc0 = n0 < 6144 ? n0 : n0 + 8;
                tr_tile(F.in[I_W_IN], INCOLS, 64 * kb, sc0, F.in[I_NORM_MIX], F.p<bf16>(O_WIN), n0, D, scr, lane); continue; } r -= TI_WIN;
            if (r < TI_WA) { const int kb = r / 32, nb = r % 32; tr_tile(F.in[I_W_BRA], D, 64 * kb, 64 * nb, nullptr, F.p<bf16>(O_WA), 64 * nb, 1024, scr, lane); continue; } r -= TI_WA;
            if (r < TI_WB) { const int kb = r / 32, nb = r % 32; tr_tile(F.in[I_W_BRB], D, 64 * kb, 64 * nb, nullptr, F.p<bf16>(O_WB), 64 * nb, 1024, scr, lane); continue; } r -= TI_WB;
            if (r < TI_WOUT) { const int kb = r / 32, nb = r % 32; tr_tile(F.in[I_W_OUT], D, 64 * kb, 64 * nb, nullptr, F.p<bf16>(O_WOUT), 64 * nb, D, scr, lane); continue; } r -= TI_WOUT;
            if (r < TI_WPG) { const int kb = r / 32, nb = r % 32; tr_tile(F.in[I_W_PLE_GATE], D, 64 * kb, 64 * nb, F.in[I_NORM_PLE], F.p<bf16>(O_WPG), 64 * nb, D, scr, lane); continue; } r -= TI_WPG;
            if (r < TI_WPLE) { const int kb = r / 32, nb = r % 32; tr_tile(F.in[I_W_PLE], D, 64 * kb, 64 * nb, nullptr, F.p<bf16>(O_WPLE), 64 * nb, PLE, scr, lane); continue; } r -= TI_WPLE;
            if (r < TI_WGU) { const int e = r / 2048, rr = r % 2048, kb = rr / 64, nb = rr % 64, c0 = 64 * nb, j0 = c0 & 2047, part = c0 >> 11;
                tr_tile(F.in[I_W_GU] + (size_t)e * D * 4096, 4096, 64 * kb, c0, F.in[I_NORM_MOE], F.p<bf16>(O_WGU), (size_t)e * 4096 + (j0 >> 7) * 256 + part * 128 + (j0 & 127), D, scr, lane); continue; } r -= TI_WGU;
            { const int e = r / 1024, rr = r % 1024, kb = rr / 32, nb = rr % 32;
                tr_tile(F.in[I_W_DN] + (size_t)e * DFF * D, D, 64 * kb, 64 * nb, nullptr, F.p<bf16>(O_WDN), (size_t)e * D + 64 * nb, DFF, scr, lane); }
        }
    }
    __syncthreads();
    LAS float* W8 = (LAS float*)F.lds;
    for (int idx = tid; idx < 8 * D; idx += 512) { const int k = idx >> 3, j = idx & 7; W8[j * D + k] = F.in[I_W_IN][(size_t)k * INCOLS + 6144 + j] * F.in[I_NORM_MIX][k]; }
    __syncthreads();
    {
        const float* x = F.in[I_X]; bf16* XB = F.p<bf16>(O_XB); float* RS0 = F.p<float>(O_RS0); float* GT = F.p<float>(O_GATES);
        for (int m = gw; m < T; m += NGW) {
            const f32x4* xr = (const f32x4*)(x + (size_t)m * D) + lane;
            f32x4 v[8]; float ss = 0.f;
#pragma unroll
            for (int j = 0; j < 8; ++j) { v[j] = xr[64 * j]; ss += (v[j].x * v[j].x + v[j].y * v[j].y) + (v[j].z * v[j].z + v[j].w * v[j].w); }
            ss = wave_sum(ss);
            const float rstd = rsqrtf(ss * (1.f / D) + EPS);
            u32x2* o = (u32x2*)(XB + (size_t)m * D) + lane;
#pragma unroll
            for (int j = 0; j < 8; ++j) { u32x2 w; w.x = pk2(v[j].x, v[j].y); w.y = pk2(v[j].z, v[j].w); o[64 * j] = w; }
            float g[8];
#pragma unroll
            for (int jj = 0; jj < 8; ++jj) { float a = 0.f;
#pragma unroll
                for (int j = 0; j < 8; ++j) { const f32x4 w = *(const LAS f32x4*)(W8 + jj * D + 4 * (lane + 64 * j)); a += (v[j].x * w.x + v[j].y * w.y) + (v[j].z * w.z + v[j].w * w.w); }
                g[jj] = wave_sum(a); }
            if (lane == 0) { RS0[m] = rstd;
#pragma unroll
                for (int jj = 0; jj < 8; ++jj) GT[(size_t)m * 8 + jj] = rstd * g[jj] + (jj < 4 ? F.in[I_B_I][jj] : F.in[I_B_F][jj - 4]); }
        }
    }
    {
        const f32x4* p4 = (const f32x4*)F.in[I_P]; u32x2* o = (u32x2*)F.p<bf16>(O_PB);
        for (size_t i = (size_t)F.bid * 512 + tid; i < (size_t)T * PLE / 4; i += (size_t)F.G * 512) { const f32x4 v = p4[i]; u32x2 w; w.x = pk2(v.x, v.y); w.y = pk2(v.z, v.w); o[i] = w; }
    }
    {
        float* RWG = F.p<float>(O_RWG);
        for (int i = F.bid * 512 + tid; i < D * NE; i += F.G * 512) RWG[i] = F.in[I_ROUTER_W][i] * F.in[I_NORM_MOE][i >> 5];
    }
    __syncthreads();
}

DI void p7_route(const Frame& F) {
    LAS float* LG = (LAS float*)F.lds;
    LAS float* RSL = (LAS float*)(F.lds + 2 * 128 * 33 * 4);
    LAS int* HL = (LAS int*)(F.lds + 2 * 128 * 33 * 4 + 512);
    const float* X1 = F.p<float>(O_X1); const float* SS1 = F.p<float>(O_SS1); const float* RWG = F.p<float>(O_RWG);
    float* RS1 = F.p<float>(O_RS1); int* TOPE = F.p<int>(O_TOPE); float* TOPG = F.p<float>(O_TOPG); int* HIST = F.p<int>(O_HIST);
    const int lane = lane_id(), w = F.wave, tid = w * 64 + lane;
    for (int tg = F.bid; tg < T / 128; tg += F.G) {
        const int t0 = tg * 128;
        if (tid < 128) { const f32x4* s = (const f32x4*)(SS1 + (size_t)(t0 + tid) * 32); float a = 0.f;
#pragma unroll
            for (int j = 0; j < 8; ++j) { const f32x4 q = s[j]; a += q.x; a += q.y; a += q.z; a += q.w; }
            const float rs = rsqrtf(a * (1.f / D) + EPS); RSL[tid] = rs; RS1[t0 + tid] = rs; }
        if (tid < 32) HL[tid] = 0;
        {
            const int g = w & 3, kh = w >> 2, m = lane & 31, hh = lane >> 5;
            const float* arow = X1 + (size_t)(t0 + 32 * g + m) * D + kh * 1024 + 4 * hh;
            const float* brow = RWG + (size_t)(kh * 1024 + 4 * hh) * 32 + m;
            f32x16 acc;
#pragma unroll
            for (int i = 0; i < 16; ++i) acc[i] = 0.f;
#pragma unroll 4
            for (int j = 0; j < 128; ++j) {
                const f32x4 a = *(const f32x4*)(arow + 8 * j);
                const float b0 = brow[(8 * j + 0) * 32], b1 = brow[(8 * j + 1) * 32], b2 = brow[(8 * j + 2) * 32], b3 = brow[(8 * j + 3) * 32];
                acc = __builtin_amdgcn_mfma_f32_32x32x2f32(a.x, b0, acc, 0, 0, 0);
                acc = __builtin_amdgcn_mfma_f32_32x32x2f32(a.y, b1, acc, 0, 0, 0);
                acc = __builtin_amdgcn_mfma_f32_32x32x2f32(a.z, b2, acc, 0, 0, 0);
                acc = __builtin_amdgcn_mfma_f32_32x32x2f32(a.w, b3, acc, 0, 0, 0);
            }
#pragma unroll
            for (int i = 0; i < 16; ++i) { const int tok = 32 * g + (i & 3) + 8 * (i >> 2) + 4 * hh; LG[(kh * 128 + tok) * 33 + m] = acc[i]; }
        }
        __syncthreads();
        if (tid < 128) {
            const int tt = tid; const float rs = RSL[tt];
            LAS float* l0 = LG + tt * 33; const LAS float* l1 = LG + (128 + tt) * 33;
            for (int e = 0; e < 32; ++e) l0[e] = rs * (l0[e] + l1[e]) + F.in[I_ROUTER_B][e];
            float tv[4]; int te[4];
#pragma unroll
            for (int k = 0; k < 4; ++k) { float bv = -3.0e38f; int be = 0;
                for (int e = 0; e < 32; ++e) { const float v = l0[e]; if (v > bv) { bv = v; be = e; } }
                tv[k] = bv; te[k] = be; l0[be] = -3.3e38f; }
            float ex[4], sum = 0.f;
#pragma unroll
            for (int k = 0; k < 4; ++k) { ex[k] = __expf(tv[k] - tv[0]); sum += ex[k]; }
            const float inv = 1.f / sum;
#pragma unroll
            for (int k = 0; k < 4; ++k) { TOPE[(size_t)(t0 + tt) * 4 + k] = te[k]; TOPG[(size_t)(t0 + tt) * 4 + k] = ex[k] * inv; __hip_atomic_fetch_add(&HL[te[k]], 1, __ATOMIC_RELAXED, __HIP_MEMORY_SCOPE_WORKGROUP); }
        }
        __syncthreads();
        if (tid < 32) HIST[tg * 32 + tid] = HL[tid];
        __syncthreads();
    }
}

DI void p8_rows(const Frame& F) {
    LAS int* PT = (LAS int*)F.lds;
    LAS int* PB = PT + 512;
    LAS int* TOT = PB + 512;
    LAS int* BASE = TOT + 32;
    LAS int* PST = BASE + 32;
    LAS int* WCNT = PST + 40;
    const int* HIST = F.p<int>(O_HIST); const int* TOPE = F.p<int>(O_TOPE); const float* TOPG = F.p<float>(O_TOPG); const float* RS1 = F.p<float>(O_RS1);
    int* ROWTOK = F.p<int>(O_ROWTOK); float* ROWG = F.p<float>(O_ROWG); float* ROWRS = F.p<float>(O_ROWRS); int* SLOT = F.p<int>(O_SLOT); int* BLKE = F.p<int>(O_BLKE);
    const int lane = lane_id(), w = F.wave, tid = w * 64 + lane;
    for (int tg = F.bid; tg < T / 128; tg += F.G) {
        const int t0 = tg * 128;
        { const int e = tid & 31, part = tid >> 5; int pt = 0, pb = 0;
          for (int ww = part * 16; ww < part * 16 + 16; ++ww) { const int h = HIST[ww * 32 + e]; pt += h; if (ww < tg) pb += h; }
          PT[part * 32 + e] = pt; PB[part * 32 + e] = pb; }
        __syncthreads();
        if (tid < 32) { int a = 0, b = 0; for (int q = 0; q < 16; ++q) { a += PT[q * 32 + tid]; b += PB[q * 32 + tid]; } TOT[tid] = a; BASE[tid] = b; }
        __syncthreads();
        if (tid == 0) { int s = 0; for (int e = 0; e < 32; ++e) { PST[e] = s; s += (TOT[e] + 255) & ~255; } PST[32] = s; }
        __syncthreads();
        const int i = tid, t = t0 + (i >> 2), k = i & 3;
        const int ei = TOPE[(size_t)t * 4 + k];
        int lrank = 0, mycnt = 0;
        for (int e = 0; e < 32; ++e) { const unsigned long long mk = __ballot(ei == e); if (ei == e) lrank = __popcll(mk & ((1ull << lane) - 1ull)); if (lane == e) mycnt = __popcll(mk); }
        if (lane < 32) WCNT[w * 32 + lane] = mycnt;
        __syncthreads();
        int woff = 0; for (int ww = 0; ww < w; ++ww) woff += WCNT[ww * 32 + ei];
        const int row = PST[ei] + BASE[ei] + woff + lrank;
        ROWTOK[row] = t; ROWG[row] = TOPG[(size_t)t * 4 + k]; ROWRS[row] = RS1[t]; SLOT[(size_t)t * 4 + k] = row;
        if (tg < 32) { const int e = tg, padded = (TOT[e] + 255) & ~255; for (int r = TOT[e] + tid; r < padded; r += 512) { ROWTOK[PST[e] + r] = 0; ROWG[PST[e] + r] = 0.f; ROWRS[PST[e] + r] = 0.f; } }
        if (tg == 0) { for (int j = tid; j < NBMAX; j += 512) { int e = 31; for (int q = 0; q < 32; ++q) if (j * 256 >= PST[q] && j * 256 < PST[q + 1]) e = q; BLKE[j] = e; }
            if (tid == 0) BLKE[NBMAX] = PST[32] >> 8; }
        __syncthreads();
    }
}

DI void p11_combine(const Frame& F) {
    const float* X1 = F.p<float>(O_X1); const bf16* YB = F.p<bf16>(O_YBUF); const int* SLOT = F.p<int>(O_SLOT);
    float* X2 = F.p<float>(O_X2); bf16* X2B = F.p<bf16>(O_X2B); float* RS2 = F.p<float>(O_RS2);
    const int lane = lane_id(), gw = F.bid * 8 + F.wave, NGW = F.G * 8;
    for (int t = gw; t < T; t += NGW) {
        const int r0 = SLOT[(size_t)t * 4], r1 = SLOT[(size_t)t * 4 + 1], r2 = SLOT[(size_t)t * 4 + 2], r3 = SLOT[(size_t)t * 4 + 3];
        const f32x4* xr = (const f32x4*)(X1 + (size_t)t * D) + lane;
        const u32x2* y0 = (const u32x2*)(YB + (size_t)r0 * D) + lane; const u32x2* y1 = (const u32x2*)(YB + (size_t)r1 * D) + lane;
        const u32x2* y2 = (const u32x2*)(YB + (size_t)r2 * D) + lane; const u32x2* y3 = (const u32x2*)(YB + (size_t)r3 * D) + lane;
        f32x4* xo = (f32x4*)(X2 + (size_t)t * D) + lane; u32x2* bo = (u32x2*)(X2B + (size_t)t * D) + lane;
        float ss = 0.f;
#pragma unroll
        for (int j = 0; j < 8; ++j) {
            f32x4 v = xr[64 * j];
            const u32x2 a = y0[64 * j], b = y1[64 * j], c = y2[64 * j], d = y3[64 * j];
            f32x4 s;
            s.x = ((bf2f(a.x & 0xffffu) + bf2f(b.x & 0xffffu)) + bf2f(c.x & 0xffffu)) + bf2f(d.x & 0xffffu);
            s.y = ((bf2f(a.x >> 16) + bf2f(b.x >> 16)) + bf2f(c.x >> 16)) + bf2f(d.x >> 16);
            s.z = ((bf2f(a.y & 0xffffu) + bf2f(b.y & 0xffffu)) + bf2f(c.y & 0xffffu)) + bf2f(d.y & 0xffffu);
            s.w = ((bf2f(a.y >> 16) + bf2f(b.y >> 16)) + bf2f(c.y >> 16)) + bf2f(d.y >> 16);
            v = v + s;
            ss += (v.x * v.x + v.y * v.y) + (v.z * v.z + v.w * v.w);
            xo[64 * j] = v; u32x2 wv; wv.x = pk2(v.x, v.y); wv.y = pk2(v.z, v.w); bo[64 * j] = wv;
        }
        ss = wave_sum(ss);
        if (lane == 0) RS2[t] = rsqrtf(ss * (1.f / D) + EPS);
    }
}

DI void p13_final(const Frame& F) {
    const float* SS3 = F.p<float>(O_SS3); const float* g = F.in[I_NORM_FINAL];
    const int lane = lane_id(), gw = F.bid * 8 + F.wave, NGW = F.G * 8;
    for (int t = gw; t < T; t += NGW) {
        float a = lane < 32 ? SS3[(size_t)t * 32 + lane] : 0.f; a = wave_sum(a);
        const float rstd = rsqrtf(a * (1.f / D) + EPS);
        f32x4* o = (f32x4*)(F.out + (size_t)t * D) + lane; const f32x4* g4 = (const f32x4*)g + lane;
#pragma unroll
        for (int j = 0; j < 8; ++j) { f32x4 v = o[64 * j]; const f32x4 gg = g4[64 * j]; v.x *= rstd * gg.x; v.y *= rstd * gg.y; v.z *= rstd * gg.z; v.w *= rstd * gg.w; o[64 * j] = v; }
    }
}


DI bf16x8 fragL(const LAS bf16* base, int pitch, int row, int k) { return *(const LAS bf16x8*)(base + row * pitch + k); }
DI bf16x8 fragG(const bf16* base, int pitch, int row, int k) { return *(const bf16x8*)(base + (size_t)row * pitch + k); }
DI int prow(int i, int nf) { return 8 * (i >> 2) + 4 * nf + (i & 3); }
#define MFMA16(b, a, c) __builtin_amdgcn_mfma_f32_16x16x32_bf16((b), (a), (c), 0, 0, 0)
DI float incl_scan_add(float v, int lane) {
#pragma unroll
    for (int o = 1; o < 64; o <<= 1) { const float t = __shfl_up(v, o); if (lane >= o) v += t; }
    return v;
}
DI float incl_scan_max(float v, int lane) {
#pragma unroll
    for (int o = 1; o < 64; o <<= 1) { const float t = __shfl_up(v, o); if (lane >= o) v = fmaxf(v, t); }
    return v;
}
DI void store16bf(LAS bf16* p, const float (&v)[16]) {
    u32x4 a, b; a.x = pk2c(v[0], v[1]); a.y = pk2c(v[2], v[3]); a.z = pk2c(v[4], v[5]); a.w = pk2c(v[6], v[7]);
    b.x = pk2c(v[8], v[9]); b.y = pk2c(v[10], v[11]); b.z = pk2c(v[12], v[13]); b.w = pk2c(v[14], v[15]);
    *(LAS u32x4*)p = a; *(LAS u32x4*)(p + 8) = b;
}
constexpr int PK = 72, PD = 136;

DI void hgrn_a_item(const Frame& F, int it, int lane, int w, int tid) {
    const int h = it & 7; const size_t t0 = (size_t)(it >> 3) * 64;
    LAS bf16* KT = (LAS bf16*)F.lds; LAS bf16* VT = KT + 128 * PK; LAS float* SEGT = (LAS float*)(VT + 128 * PK);
    const bf16* Z = F.p<bf16>(O_Z); const float* LF = F.p<float>(O_LF);
    const int c = tid & 127, seg = tid >> 7;
    float cs[16]; float run = 0.f;
#pragma unroll
    for (int i = 0; i < 16; ++i) { run += LF[(t0 + 16 * seg + i) * 1024 + h * 128 + c]; cs[i] = run; }
    SEGT[seg * 128 + c] = run;
    float kk[16], vv[16];
#pragma unroll
    for (int i = 0; i < 16; ++i) { kk[i] = bf2f(Z[(t0 + 16 * seg + i) * NZ + ZKA + h * 128 + c]); vv[i] = bf2f(Z[(t0 + 16 * seg + i) * NZ + ZVA + h * 128 + c]); }
    __syncthreads();
    float pre = 0.f, tot = 0.f;
#pragma unroll
    for (int q = 0; q < 4; ++q) { const float v = SEGT[q * 128 + c]; tot += v; if (q < seg) pre += v; }
#pragma unroll
    for (int i = 0; i < 16; ++i) kk[i] *= __expf(tot - (pre + cs[i]));
    store16bf(KT + c * PK + 16 * seg, kk); store16bf(VT + c * PK + 16 * seg, vv);
    if (seg == 0) F.p<float>(O_DEC)[(size_t)it * 128 + c] = __expf(tot);
    __syncthreads();
    const int fr = lane & 15, fq = lane >> 4, e0 = 16 * w;
    f32x4 acc[8];
#pragma unroll
    for (int i = 0; i < 8; ++i) acc[i] = (f32x4){0.f, 0.f, 0.f, 0.f};
#pragma unroll
    for (int ks = 0; ks < 2; ++ks) {
        const bf16x8 a = fragL(VT, PK, e0 + fr, 32 * ks + 8 * fq);
#pragma unroll
        for (int p = 0; p < 4; ++p)
#pragma unroll
            for (int nf = 0; nf < 2; ++nf) { const bf16x8 b = fragL(KT, PK, 32 * p + prow(fr, nf), 32 * ks + 8 * fq); acc[2 * p + nf] = MFMA16(b, a, acc[2 * p + nf]); }
    }
    bf16* U = F.p<bf16>(O_UST) + ((size_t)it * 128 + e0 + fr) * 128 + 8 * fq;
#pragma unroll
    for (int p = 0; p < 4; ++p) { const float o[8] = {acc[2 * p][0], acc[2 * p][1], acc[2 * p][2], acc[2 * p][3], acc[2 * p + 1][0], acc[2 * p + 1][1], acc[2 * p + 1][2], acc[2 * p + 1][3]}; *(u32x4*)(U + 32 * p) = pack8c(o); }
    __syncthreads();
}

DI void conv16(const bf16* Z, size_t t0, int s0  , int ch, const float* cw, const float* cb, float (&o)[16]) {
    const float w0 = cw[ch], w1 = cw[1024 + ch], w2 = cw[2048 + ch], w3 = cw[3072 + ch], b = cb[ch];
    float u0 = s0 >= 3 ? bf2f(Z[(t0 - 3) * NZ + ZQK + ch]) : 0.f, u1 = s0 >= 2 ? bf2f(Z[(t0 - 2) * NZ + ZQK + ch]) : 0.f, u2 = s0 >= 1 ? bf2f(Z[(t0 - 1) * NZ + ZQK + ch]) : 0.f;
#pragma unroll
    for (int i = 0; i < 16; ++i) { const float u3 = bf2f(Z[(t0 + i) * NZ + ZQK + ch]); const float cv = b + u0 * w0 + u1 * w1 + u2 * w2 + u3 * w3; o[i] = cv * sigm(cv); u0 = u1; u1 = u2; u2 = u3; }
}

DI void mlstm_a_item(const Frame& F, int it, int lane, int w, int tid) {
    const int h = it & 3, bn = it >> 2, n = bn & 127; const size_t t0 = (size_t)bn * 64;
    LAS bf16* KT = (LAS bf16*)F.lds; LAS bf16* VT = KT + 128 * PK; LAS float* NP = (LAS float*)(VT + 256 * PK); LAS float* WE = NP + 512;
    const bf16* Z = F.p<bf16>(O_Z); const float* GT = F.p<float>(O_GATES);
    {
        const float ip = GT[(t0 + lane) * 8 + h], lf = log_sigmoid(GT[(t0 + lane) * 8 + 4 + h]);
        const float fc = incl_scan_add(lf, lane), gt = __shfl(fc, 63);
        const float ae = gt - fc + ip, ml = wave_max(ae);
        if (w == 0) { WE[lane] = __expf(ae - ml); if (lane == 0) { F.p<float>(O_MLOC)[it] = ml; F.p<float>(O_GTOT)[it] = gt; } }
    }
    const int d = tid & 127, seg = tid >> 7;
    float kk[16];
    conv16(Z, t0 + 16 * seg, n * 64 + 16 * seg, 512 + h * 128 + d, F.in[I_CONV_W], F.in[I_CONV_B], kk);
    const int ev = tid & 255, hv = tid >> 8;
    float v0[16], v1[16];
#pragma unroll
    for (int i = 0; i < 16; ++i) { v0[i] = bf2f(Z[(t0 + 32 * hv + i) * NZ + ZVB + h * 256 + ev]); v1[i] = bf2f(Z[(t0 + 32 * hv + 16 + i) * NZ + ZVB + h * 256 + ev]); }
    __syncthreads();
    float np = 0.f;
#pragma unroll
    for (int i = 0; i < 16; ++i) { kk[i] *= 0.08838834764831845f * WE[16 * seg + i]; np += kk[i]; }
    NP[seg * 128 + d] = np;
    store16bf(KT + d * PK + 16 * seg, kk); store16bf(VT + ev * PK + 32 * hv, v0); store16bf(VT + ev * PK + 32 * hv + 16, v1);
    __syncthreads();
    if (tid < 128) F.p<float>(O_NL)[(size_t)it * 128 + tid] = (NP[tid] + NP[128 + tid]) + (NP[256 + tid] + NP[384 + tid]);
    const int fr = lane & 15, fq = lane >> 4;
    f32x4 acc[2][8];
#pragma unroll
    for (int m = 0; m < 2; ++m)
#pragma unroll
        for (int i = 0; i < 8; ++i) acc[m][i] = (f32x4){0.f, 0.f, 0.f, 0.f};
#pragma unroll
    for (int ks = 0; ks < 2; ++ks) {
        const bf16x8 a0 = fragL(VT, PK, 32 * w + fr, 32 * ks + 8 * fq), a1 = fragL(VT, PK, 32 * w + 16 + fr, 32 * ks + 8 * fq);
#pragma unroll
        for (int p = 0; p < 4; ++p)
#pragma unroll
            for (int nf = 0; nf < 2; ++nf) { const bf16x8 b = fragL(KT, PK, 32 * p + prow(fr, nf), 32 * ks + 8 * fq); acc[0][2 * p + nf] = MFMA16(b, a0, acc[0][2 * p + nf]); acc[1][2 * p + nf] = MFMA16(b, a1, acc[1][2 * p + nf]); }
    }
#pragma unroll
    for (int m = 0; m < 2; ++m) {
        bf16* Cp = F.p<bf16>(O_CT) + ((size_t)it * 256 + 32 * w + 16 * m + fr) * 128 + 8 * fq;
#pragma unroll
        for (int p = 0; p < 4; ++p) { const float o[8] = {acc[m][2 * p][0], acc[m][2 * p][1], acc[m][2 * p][2], acc[m][2 * p][3], acc[m][2 * p + 1][0], acc[m][2 * p + 1][1], acc[m][2 * p + 1][2], acc[m][2 * p + 1][3]}; *(u32x4*)(Cp + 32 * p) = pack8c(o); }
    }
    __syncthreads();
}

DI void scan_phase(const Frame& F) {
    const int lane = lane_id(), tid = F.wave * 64 + lane;
    for (int g = F.bid * 512 + tid; g < 131072; g += F.G * 512) {
        {
            const int c4 = g & 31, e = (g >> 5) & 127, bh = g >> 12, b = bh >> 3, h = bh & 7;
            float S0 = 0.f, S1 = 0.f, S2 = 0.f, S3 = 0.f;
            bf16* U = F.p<bf16>(O_UST); const float* DC = F.p<float>(O_DEC);
#pragma unroll 4
            for (int n = 0; n < 128; ++n) {
                const size_t it = (size_t)(b * 128 + n) * 8 + h;
                u32x2* p = (u32x2*)(U + (it * 128 + e) * 128 + c4 * 4);
                const f32x4 dc = *(const f32x4*)(DC + it * 128 + c4 * 4);
                const u32x2 uu = *p;
                u32x2 o; o.x = pk2c(S0, S1); o.y = pk2c(S2, S3); *p = o;
                S0 = dc.x * S0 + bf2f(uu.x & 0xffffu); S1 = dc.y * S1 + bf2f(uu.x >> 16); S2 = dc.z * S2 + bf2f(uu.y & 0xffffu); S3 = dc.w * S3 + bf2f(uu.y >> 16);
            }
        }
        {
            const int d4 = g & 31, e = (g >> 5) & 255, bh = g >> 13, b = bh >> 2, h = bh & 3;
            float C0 = 0.f, C1 = 0.f, C2 = 0.f, C3 = 0.f, mrun = -1e30f; f32x4 nn = (f32x4){0.f, 0.f, 0.f, 0.f};
            bf16* CT = F.p<bf16>(O_CT); float* NL = F.p<float>(O_NL); const float* GTOT = F.p<float>(O_GTOT); const float* MLOC = F.p<float>(O_MLOC); float* MST = F.p<float>(O_MST);
#pragma unroll 4
            for (int n = 0; n < 128; ++n) {
                const size_t it = (size_t)(b * 128 + n) * 4 + h;
                const float gt = GTOT[it], ml = MLOC[it];
                const float mnew = fmaxf(gt + mrun, ml), sp = __expf(gt + mrun - mnew), sl = __expf(ml - mnew);
                u32x2* p = (u32x2*)(CT + (it * 256 + e) * 128 + d4 * 4);
                const u32x2 cl = *p;
                u32x2 o; o.x = pk2c(C0, C1); o.y = pk2c(C2, C3); *p = o;
                C0 = sp * C0 + sl * bf2f(cl.x & 0xffffu); C1 = sp * C1 + sl * bf2f(cl.x >> 16); C2 = sp * C2 + sl * bf2f(cl.y & 0xffffu); C3 = sp * C3 + sl * bf2f(cl.y >> 16);
                if (e == 0) { f32x4* q = (f32x4*)(NL + it * 128 + d4 * 4); const f32x4 nl = *q; *q = nn; nn = sp * nn + sl * nl; if (d4 == 0) MST[it] = mrun; }
                mrun = mnew;
            }
        }
    }
}

DI void hgrn_c_item(const Frame& F, int it, int lane, int w, int tid) {
    const int h = it & 7; const size_t t0 = (size_t)(it >> 3) * 64;
    LAS bf16* Qs = (LAS bf16*)F.lds; LAS bf16* Ks = Qs + 64 * PD; LAS bf16* Qh = Ks + 64 * PD; LAS bf16* VT = Qh + 64 * PD; LAS bf16* Pm = VT + 128 * PK;
    LAS float* SEGT = (LAS float*)(Pm + 64 * PK); LAS float* BREF = SEGT + 512; LAS float* RED = BREF + 128;
    const bf16* Z = F.p<bf16>(O_Z); const float* LF = F.p<float>(O_LF);
    const int c = tid & 127, seg = tid >> 7;
    float cs[16]; float run = 0.f;
#pragma unroll
    for (int i = 0; i < 16; ++i) { run += LF[(t0 + 16 * seg + i) * 1024 + h * 128 + c]; cs[i] = run; }
    SEGT[seg * 128 + c] = run;
    float qq[16], kk[16], vv[16];
#pragma unroll
    for (int i = 0; i < 16; ++i) { const size_t r = (t0 + 16 * seg + i) * NZ + h * 128 + c; qq[i] = bf2f(Z[r + ZQA]); kk[i] = bf2f(Z[r + ZKA]); vv[i] = bf2f(Z[r + ZVA]); }
    __syncthreads();
    float pre = 0.f;
#pragma unroll
    for (int q = 0; q < 4; ++q) { const float v = SEGT[q * 128 + c]; if (q < seg) pre += v; }
    if (seg == 2) BREF[c] = pre + cs[0];
    __syncthreads();
    const float bref = BREF[c];
#pragma unroll
    for (int i = 0; i < 16; ++i) {
        const float bc = pre + cs[i]; const int l = 16 * seg + i;
        Qs[l * PD + c] = (bf16)f2bf(qq[i] * __expf(bc - bref)); Ks[l * PD + c] = (bf16)f2bf(kk[i] * __expf(bref - bc)); Qh[l * PD + c] = (bf16)f2bf(qq[i] * __expf(bc));
    }
    store16bf(VT + c * PK + 16 * seg, vv);
    __syncthreads();
    const int fr = lane & 15, fq = lane >> 4, mf = w & 3, nh = w >> 2;
    {
        f32x4 sc[2] = {(f32x4){0.f, 0.f, 0.f, 0.f}, (f32x4){0.f, 0.f, 0.f, 0.f}};
#pragma unroll
        for (int ks = 0; ks < 4; ++ks) { const bf16x8 a = fragL(Qs, PD, 16 * mf + fr, 32 * ks + 8 * fq);
#pragma unroll
            for (int nf = 0; nf < 2; ++nf) { const bf16x8 b = fragL(Ks, PD, 32 * nh + prow(fr, nf), 32 * ks + 8 * fq); sc[nf] = MFMA16(b, a, sc[nf]); } }
        const int l = 16 * mf + fr, m0 = 32 * nh + 8 * fq; float o[8];
#pragma unroll
        for (int j = 0; j < 4; ++j) { o[j] = (m0 + j <= l) ? sc[0][j] : 0.f; o[4 + j] = (m0 + 4 + j <= l) ? sc[1][j] : 0.f; }
        *(LAS u32x4*)(Pm + l * PK + m0) = pack8c(o);
    }
    __syncthreads();
    f32x4 acc[4];
#pragma unroll
    for (int i = 0; i < 4; ++i) acc[i] = (f32x4){0.f, 0.f, 0.f, 0.f};
#pragma unroll
    for (int ks = 0; ks < 2; ++ks) { const bf16x8 a = fragL(Pm, PK, 16 * mf + fr, 32 * ks + 8 * fq);
#pragma unroll
        for (int p = 0; p < 2; ++p)
#pragma unroll
            for (int nf = 0; nf < 2; ++nf) { const bf16x8 b = fragL(VT, PK, 64 * nh + 32 * p + prow(fr, nf), 32 * ks + 8 * fq); acc[2 * p + nf] = MFMA16(b, a, acc[2 * p + nf]); } }
    const bf16* ST = F.p<bf16>(O_UST) + (size_t)it * 128 * 128;
#pragma unroll
    for (int ks = 0; ks < 4; ++ks) { const bf16x8 a = fragL(Qh, PD, 16 * mf + fr, 32 * ks + 8 * fq);
#pragma unroll
        for (int p = 0; p < 2; ++p)
#pragma unroll
            for (int nf = 0; nf < 2; ++nf) { const bf16x8 b = fragG(ST, 128, 64 * nh + 32 * p + prow(fr, nf), 32 * ks + 8 * fq); acc[2 * p + nf] = MFMA16(b, a, acc[2 * p + nf]); } }
    float ss = 0.f;
#pragma unroll
    for (int i = 0; i < 4; ++i) ss += (acc[i][0] * acc[i][0] + acc[i][1] * acc[i][1]) + (acc[i][2] * acc[i][2] + acc[i][3] * acc[i][3]);
    ss += __shfl_xor(ss, 16); ss += __shfl_xor(ss, 32);
    const int l = 16 * mf + fr;
    if (fq == 0) RED[nh * 64 + l] = ss;
    __syncthreads();
    const float rstd = rsqrtf((RED[l] + RED[64 + l]) * (1.f / 128.f) + EPS);
    const float* gn = F.in[I_HGRN_NORM] + h * 128;
#pragma unroll
    for (int p = 0; p < 2; ++p) {
        const int e = 64 * nh + 32 * p + 8 * fq; float ga[8], o[8];
        unpack8(*(const u32x4*)(Z + (t0 + l) * NZ + ZGA + h * 128 + e), ga);
#pragma unroll
        for (int j = 0; j < 4; ++j) { o[j] = acc[2 * p][j] * rstd * gn[e + j] * ga[j]; o[4 + j] = acc[2 * p + 1][j] * rstd * gn[e + 4 + j] * ga[4 + j]; }
        *(u32x4*)(F.p<bf16>(O_YA) + (t0 + l) * 1024 + h * 128 + e) = pack8c(o);
    }
    __syncthreads();
}

DI void mlstm_c_item(const Frame& F, int it, int lane, int w, int tid) {
    const int h = it & 3, bn = it >> 2, n = bn & 127; const size_t t0 = (size_t)bn * 64;
    LAS bf16* Qs = (LAS bf16*)F.lds; LAS bf16* Ks = Qs + 64 * PD; LAS bf16* VT = Ks + 64 * PD; LAS bf16* Pm = VT + 272 * PK; LAS bf16* NST = Pm + 64 * PK;
    LAS float* ROWV = (LAS float*)(NST + 16 * PD); LAS float* COLV = ROWV + 64; LAS float* WST = COLV + 64; LAS float* EINV = WST + 64; LAS float* RED = EINV + 64;
    const bf16* Z = F.p<bf16>(O_Z); const float* GT = F.p<float>(O_GATES);
    {
        const float ip = GT[(t0 + lane) * 8 + h], lf = log_sigmoid(GT[(t0 + lane) * 8 + 4 + h]);
        const float fc = incl_scan_add(lf, lane), mst = F.p<float>(O_MST)[it];
        const float cv = ip - fc, aint = fc + mst, dmax = fc + incl_scan_max(cv, lane), mt = fmaxf(dmax, aint);
        if (w == 0) { ROWV[lane] = fc - mt; COLV[lane] = cv; WST[lane] = __expf(aint - mt); EINV[lane] = __expf(-mt); }
    }
    const int d = tid & 127, seg = tid >> 7;
    {
        float qq[16], kk[16];
        conv16(Z, t0 + 16 * seg, n * 64 + 16 * seg, h * 128 + d, F.in[I_CONV_W], F.in[I_CONV_B], qq);
        conv16(Z, t0 + 16 * seg, n * 64 + 16 * seg, 512 + h * 128 + d, F.in[I_CONV_W], F.in[I_CONV_B], kk);
#pragma unroll
        for (int i = 0; i < 16; ++i) { const int l = 16 * seg + i; Qs[l * PD + d] = (bf16)f2bf(qq[i]); Ks[l * PD + d] = (bf16)f2bf(kk[i] * 0.08838834764831845f); }
    }
    {
        const int ev = tid & 255, hv = tid >> 8; float v0[16], v1[16];
#pragma unroll
        for (int i = 0; i < 16; ++i) { v0[i] = bf2f(Z[(t0 + 32 * hv + i) * NZ + ZVB + h * 256 + ev]); v1[i] = bf2f(Z[(t0 + 32 * hv + 16 + i) * NZ + ZVB + h * 256 + ev]); }
        store16bf(VT + ev * PK + 32 * hv, v0); store16bf(VT + ev * PK + 32 * hv + 16, v1);
        for (int i = tid; i < 16 * 64; i += 512) VT[(256 + (i >> 6)) * PK + (i & 63)] = (bf16)((i >> 6) == 0 ? 0x3f80 : 0);
        const float* NLp = F.p<float>(O_NL) + (size_t)it * 128;
        for (int i = tid; i < 16 * 128; i += 512) NST[(i >> 7) * PD + (i & 127)] = (bf16)((i >> 7) == 0 ? f2bf(NLp[i & 127]) : 0u);
    }
    __syncthreads();
    const int fr = lane & 15, fq = lane >> 4, mf = w & 3, nh = w >> 2, l = 16 * mf + fr;
    {
        f32x4 sc[2] = {(f32x4){0.f, 0.f, 0.f, 0.f}, (f32x4){0.f, 0.f, 0.f, 0.f}};
#pragma unroll
        for (int ks = 0; ks < 4; ++ks) { const bf16x8 a = fragL(Qs, PD, l, 32 * ks + 8 * fq);
#pragma unroll
            for (int nf = 0; nf < 2; ++nf) { const bf16x8 b = fragL(Ks, PD, 32 * nh + prow(fr, nf), 32 * ks + 8 * fq); sc[nf] = MFMA16(b, a, sc[nf]); } }
        const int m0 = 32 * nh + 8 * fq; const float rv = ROWV[l]; float o[8];
#pragma unroll
        for (int j = 0; j < 4; ++j) { o[j] = (m0 + j <= l) ? sc[0][j] * __expf(rv + COLV[m0 + j]) : 0.f; o[4 + j] = (m0 + 4 + j <= l) ? sc[1][j] * __expf(rv + COLV[m0 + 4 + j]) : 0.f; }
        *(LAS u32x4*)(Pm + l * PK + m0) = pack8c(o);
    }
    __syncthreads();
    f32x4 a1[8], a2[8], d1 = (f32x4){0.f, 0.f, 0.f, 0.f}, d2 = (f32x4){0.f, 0.f, 0.f, 0.f};
#pragma unroll
    for (int i = 0; i < 8; ++i) { a1[i] = (f32x4){0.f, 0.f, 0.f, 0.f}; a2[i] = (f32x4){0.f, 0.f, 0.f, 0.f}; }
#pragma unroll
    for (int ks = 0; ks < 2; ++ks) { const bf16x8 a = fragL(Pm, PK, l, 32 * ks + 8 * fq);
#pragma unroll
        for (int p = 0; p < 4; ++p)
#pragma unroll
            for (int nf = 0; nf < 2; ++nf) { const bf16x8 b = fragL(VT, PK, 128 * nh + 32 * p + prow(fr, nf), 32 * ks + 8 * fq); a1[2 * p + nf] = MFMA16(b, a, a1[2 * p + nf]); }
        d1 = MFMA16(fragL(VT, PK, 256 + fr, 32 * ks + 8 * fq), a, d1); }
    const bf16* CS = F.p<bf16>(O_CT) + (size_t)it * 256 * 128;
#pragma unroll
    for (int ks = 0; ks < 4; ++ks) { const bf16x8 a = fragL(Qs, PD, l, 32 * ks + 8 * fq);
#pragma unroll
        for (int p = 0; p < 4; ++p)
#pragma unroll
            for (int nf = 0; nf < 2; ++nf) { const bf16x8 b = fragG(CS, 128, 128 * nh + 32 * p + prow(fr, nf), 32 * ks + 8 * fq); a2[2 * p + nf] = MFMA16(b, a, a2[2 * p + nf]); }
        d2 = MFMA16(fragL(NST, PD, fr, 32 * ks + 8 * fq), a, d2); }
    const float ws = WST[l];
    float den = d1[0] + ws * d2[0];
    den = __shfl(den, fr);
    const float inv = 1.f / fmaxf(fabsf(den), EINV[l]);
    float ss = 0.f;
#pragma unroll
    for (int i = 0; i < 8; ++i) { a1[i] = (a1[i] + ws * a2[i]) * inv; ss += (a1[i][0] * a1[i][0] + a1[i][1] * a1[i][1]) + (a1[i][2] * a1[i][2] + a1[i][3] * a1[i][3]); }
    ss += __shfl_xor(ss, 16); ss += __shfl_xor(ss, 32);
    if (fq == 0) RED[nh * 64 + l] = ss;
    __syncthreads();
    const float rstd = rsqrtf((RED[l] + RED[64 + l]) * (1.f / 256.f) + EPS);
    const float* gn = F.in[I_MLSTM_NORM] + h * 256;
#pragma unroll
    for (int p = 0; p < 4; ++p) {
        const int e = 128 * nh + 32 * p + 8 * fq; float og[8], o[8];
        unpack8(*(const u32x4*)(Z + (t0 + l) * NZ + ZOB + h * 256 + e), og);
#pragma unroll
        for (int j = 0; j < 4; ++j) { o[j] = a1[2 * p][j] * rstd * gn[e + j] * og[j]; o[4 + j] = a1[2 * p + 1][j] * rstd * gn[e + 4 + j] * og[4 + j]; }
        *(u32x4*)(F.p<bf16>(O_YB) + (t0 + l) * 1024 + h * 256 + e) = pack8c(o);
    }
    __syncthreads();
}
DI void mix_a_phase(const Frame& F) {
    const int lane = lane_id(), w = F.wave, tid = w * 64 + lane;
    for (int it = F.bid; it < NITEM_A; it += F.G) hgrn_a_item(F, it, lane, w, tid);
    for (int it = F.bid; it < NITEM_B; it += F.G) mlstm_a_item(F, it, lane, w, tid);
}
DI void mix_c_phase(const Frame& F) {
    const int lane = lane_id(), w = F.wave, tid = w * 64 + lane;
    for (int it = F.bid; it < NITEM_A; it += F.G) hgrn_c_item(F, it, lane, w, tid);
    for (int it = F.bid; it < NITEM_B; it += F.G) mlstm_c_item(F, it, lane, w, tid);
}

enum { PH_PROLOGUE = 0, PH_INPROJ, PH_MIXA, PH_SCAN, PH_MIXC, PH_MIXPROJ, PH_WOUT, PH_ROUTE, PH_ROWS, PH_GU, PH_DN, PH_COMBINE, PH_GATE, PH_FINAL, PH_COUNT };

__global__ void __launch_bounds__(512, 2) fwd(Args args) {
    extern __shared__ __attribute__((aligned(16))) unsigned char lds_raw[];
    Frame F;
    F.lds = (LAS unsigned char*)lds_raw;
    F.wave = __builtin_amdgcn_readfirstlane((int)threadIdx.x >> 6); F.G = gridDim.x; F.bid = blockIdx.x;
    F.in = args.in; F.out = args.out; F.ws = args.ws;
    volatile LAS unsigned* misc = (volatile LAS unsigned*)(F.lds + LDS_MISC);
    if (threadIdx.x < 4) misc[threadIdx.x] = 0u;
    __syncthreads();
    const int lo = args.ph_lo, hi = args.ph_hi;
    const bool multi = (hi - lo) > 1;
    XcdBarrier bar; bar.bar = F.p<unsigned>(O_CTL) + CW_BAR; bar.x = 0; bar.st = misc;
    if (multi) bar = xcd_barrier_post(F.p<unsigned>(O_CTL) + CW_BAR, misc, threadIdx.x == 0);
#define IN(k) (lo <= (k) && (k) < hi)
#define SEAM(k) do { if (IN(k) && IN((k) + 1)) xcd_barrier(bar, F.wave == 0 && lane_id() == 0); } while (0)
    LAS unsigned char* ring = F.lds;

    if (IN(PH_PROLOGUE)) { p0_prologue(F); } SEAM(PH_PROLOGUE);

    if (IN(PH_INPROJ)) {
        pg8::SchedPlain S; S.init(T, NZ, D, F.p<bf16>(O_WIN), F.G, F.bid);
        pg8::EpiWrap<EInproj> E{{F.p<bf16>(O_Z), F.p<float>(O_LF), F.p<float>(O_RS0), F.in[I_HGRN_LB]}};
        pg8::gemm_phase(ring, F.wave, (const char*)F.p<bf16>(O_XB), D, S, E);
    } SEAM(PH_INPROJ);

    if (IN(PH_MIXA)) { mix_a_phase(F); } SEAM(PH_MIXA);
    if (IN(PH_SCAN)) { scan_phase(F); } SEAM(PH_SCAN);
    if (IN(PH_MIXC)) { mix_c_phase(F); } SEAM(PH_MIXC);

    if (IN(PH_MIXPROJ)) {
        { pg8::SchedPlain S; S.init(T, D, 1024, F.p<bf16>(O_WA), F.G, F.bid);
          pg8::EpiWrap<EMixA> E{{F.p<float>(O_MIXT), F.p<bf16>(O_Z)}};
          pg8::gemm_phase(ring, F.wave, (const char*)F.p<bf16>(O_YA), 1024, S, E); }
        { pg8::SchedPlain S; S.init(T, D, 1024, F.p<bf16>(O_WB), F.G, F.bid);
          pg8::EpiWrap<EMixB> E{{F.p<float>(O_MIXT), F.p<bf16>(O_Z), F.p<bf16>(O_MIX)}};
          pg8::gemm_phase(ring, F.wave, (const char*)F.p<bf16>(O_YB), 1024, S, E); }
    } SEAM(PH_MIXPROJ);

    if (IN(PH_WOUT)) {
        pg8::SchedPlain S; S.init(T, D, D, F.p<bf16>(O_WOUT), F.G, F.bid);
        pg8::EpiWrap<EX1> E{{F.in[I_X], F.p<float>(O_X1), F.p<bf16>(O_X1B), F.p<float>(O_SS1)}};
        pg8::gemm_phase(ring, F.wave, (const char*)F.p<bf16>(O_MIX), D, S, E);
    } SEAM(PH_WOUT);

    if (IN(PH_ROUTE)) { p7_route(F); } SEAM(PH_ROUTE);
    if (IN(PH_ROWS)) { p8_rows(F); } SEAM(PH_ROWS);

    if (IN(PH_GU)) {
        const int nblk = __builtin_amdgcn_readfirstlane(F.p<int>(O_BLKE)[NBMAX]);
        pg8::SchedMoE<true> S; S.init(nblk, 4096, D, F.p<bf16>(O_WGU), (size_t)4096 * D * 2, F.p<int>(O_BLKE), F.p<int>(O_ROWTOK), F.G, F.bid);
        pg8::EpiWrap<ESwiglu> E{{F.p<bf16>(O_ACT), F.p<float>(O_ROWRS), F.in[I_B_GU]}};
        pg8::gemm_phase(ring, F.wave, (const char*)F.p<bf16>(O_X1B), D, S, E);
    } SEAM(PH_GU);

    if (IN(PH_DN)) {
        const int nblk = __builtin_amdgcn_readfirstlane(F.p<int>(O_BLKE)[NBMAX]);
        pg8::SchedMoE<false> S; S.init(nblk, D, DFF, F.p<bf16>(O_WDN), (size_t)D * DFF * 2, F.p<int>(O_BLKE), F.p<int>(O_ROWTOK), F.G, F.bid);
        pg8::EpiWrap<EDown> E{{F.p<bf16>(O_YBUF), F.p<float>(O_ROWG), F.in[I_B_DN]}};
        pg8::gemm_phase(ring, F.wave, (const char*)F.p<bf16>(O_ACT), DFF, S, E);
    } SEAM(PH_DN);

    if (IN(PH_COMBINE)) {
        p11_combine(F);
        pg8::SchedPlain S; S.init(T, D, PLE, F.p<bf16>(O_WPLE), F.G, F.bid);
        pg8::EpiWrap<EPw> E{{F.p<bf16>(O_PW)}};
        pg8::gemm_phase(ring, F.wave, (const char*)F.p<bf16>(O_PB), PLE, S, E);
    } SEAM(PH_COMBINE);

    if (IN(PH_GATE)) {
        pg8::SchedPlain S; S.init(T, D, D, F.p<bf16>(O_WPG), F.G, F.bid);
        pg8::EpiWrap<EGate> E{{F.p<float>(O_X2), F.p<bf16>(O_PW), F.p<float>(O_RS2), F.out, F.p<float>(O_SS3)}};
        pg8::gemm_phase(ring, F.wave, (const char*)F.p<bf16>(O_X2B), D, S, E);
    } SEAM(PH_GATE);

    if (IN(PH_FINAL)) { p13_final(F); }
#undef IN
#undef SEAM
}

template <class Sched, class E> __global__ void __launch_bounds__(256) naive_gemm(const char* Abase, int K, Sched S, E e, const int* nblk_dev) {
    if (nblk_dev) S.nM = *nblk_dev;
    Unit u; if (!S.unit_of((int)blockIdx.x, u)) return;
    const int lane = threadIdx.x & 63, wc = threadIdx.x >> 6, fr = lane & 15, fq = lane >> 4;
    const int r = 16 * blockIdx.y + fr, lc = wc * 32 + 8 * fq;
    const bf16* arow = (const bf16*)(Abase + S.a_row_off(u, r));
    const bf16* b0 = (const bf16*)S.b_ptr(u) + (size_t)lc * K; const bf16* b1 = b0 + (size_t)128 * K;
    float v0[8], v1[8];
#pragma unroll
    for (int i = 0; i < 8; ++i) { v0[i] = 0.f; v1[i] = 0.f; }
    for (int k = 0; k < K; k += 8) {
        float a[8]; unpack8(*(const u32x4*)(arow + k), a);
#pragma unroll
        for (int i = 0; i < 8; ++i) {
            float b[8]; unpack8(*(const u32x4*)(b0 + (size_t)i * K + k), b);
#pragma unroll
            for (int q = 0; q < 8; ++q) v0[i] += a[q] * b[q];
            unpack8(*(const u32x4*)(b1 + (size_t)i * K + k), b);
#pragma unroll
            for (int q = 0; q < 8; ++q) v1[i] += a[q] * b[q];
        }
    }
    e.store(u, u.pm * 256 + r, lc, v0, v1);
}

__global__ void __launch_bounds__(128) naive_hgrn(const bf16* Z, const float* LF, const float* gain, bf16* YA) {
    __shared__ float sq[128], sf[128], sk[128], red[2];
    const int b = blockIdx.x >> 3, h = blockIdx.x & 7, e = threadIdx.x;
    float S[128];
#pragma unroll
    for (int c = 0; c < 128; ++c) S[c] = 0.f;
    const float ge = gain[h * 128 + e];
    for (int s = 0; s < SEQ; ++s) {
        const size_t t = (size_t)b * SEQ + s;
        sq[e] = bf2f(Z[t * NZ + ZQA + h * 128 + e]);
        sf[e] = __expf(LF[t * 1024 + h * 128 + e]);
        sk[e] = bf2f(Z[t * NZ + ZKA + h * 128 + e]);
        const float v = bf2f(Z[t * NZ + ZVA + h * 128 + e]);
        const float ga = bf2f(Z[t * NZ + ZGA + h * 128 + e]);
        __syncthreads();
        float o = 0.f;
#pragma unroll
        for (int c = 0; c < 128; ++c) { S[c] = sf[c] * S[c] + sk[c] * v; o += sq[c] * S[c]; }
        float ss = wave_sum(o * o);
        if ((e & 63) == 0) red[e >> 6] = ss;
        __syncthreads();
        const float rstd = rsqrtf((red[0] + red[1]) * (1.f / 128.f) + EPS);
        YA[t * 1024 + h * 128 + e] = (bf16)f2bf(o * rstd * ge * ga);
        __syncthreads();
    }
}
__global__ void __launch_bounds__(256) naive_mlstm(const bf16* Z, const float* GATES, const float* convw, const float* convb, const float* gain, bf16* YB) {
    __shared__ float sq[128], sk[128], sn[128], red[4];
    const int b = blockIdx.x >> 2, h = blockIdx.x & 3, e = threadIdx.x;
    float C[128];
#pragma unroll
    for (int d = 0; d < 128; ++d) C[d] = 0.f;
    if (e < 128) sn[e] = 0.f;
    float mrun = -1e30f;
    const float ge = gain[h * 256 + e];
    const int ch = e < 128 ? h * 128 + e : 512 + h * 128 + (e - 128);
    const float w0 = convw[0 * 1024 + ch], w1 = convw[1 * 1024 + ch], w2 = convw[2 * 1024 + ch], w3 = convw[3 * 1024 + ch], cb = convb[ch];
    float u0 = 0.f, u1 = 0.f, u2 = 0.f;
    for (int s = 0; s < SEQ; ++s) {
        const size_t t = (size_t)b * SEQ + s;
        const float u3 = bf2f(Z[t * NZ + ZQK + ch]);
        float cv = cb + u0 * w0 + u1 * w1 + u2 * w2 + u3 * w3; u0 = u1; u1 = u2; u2 = u3;
        cv = cv * sigm(cv);
        if (e < 128) sq[e] = cv; else sk[e - 128] = cv * 0.08838834764831845f;
        const float ip = GATES[t * 8 + h], fp = GATES[t * 8 + 4 + h];
        const float lf = log_sigmoid(fp);
        const float mnew = fmaxf(lf + mrun, ip);
        const float fd = __expf(lf + mrun - mnew), ii = __expf(ip - mnew);
        mrun = mnew;
        const float v = bf2f(Z[t * NZ + ZVB + h * 256 + e]);
        const float og = bf2f(Z[t * NZ + ZOB + h * 256 + e]);
        __syncthreads();
        if (e < 128) sn[e] = fd * sn[e] + ii * sk[e];
        __syncthreads();
        float num = 0.f, den = 0.f;
#pragma unroll
        for (int d = 0; d < 128; ++d) { C[d] = fd * C[d] + ii * v * sk[d]; num += C[d] * sq[d]; den += sn[d] * sq[d]; }
        const float hv = num / fmaxf(fabsf(den), __expf(-mnew));
        float ss = wave_sum(hv * hv);
        if ((e & 63) == 0) red[e >> 6] = ss;
        __syncthreads();
        const float rstd = rsqrtf(((red[0] + red[1]) + (red[2] + red[3])) * (1.f / 256.f) + EPS);
        YB[t * 1024 + h * 256 + e] = (bf16)f2bf(hv * rstd * ge * og);
        __syncthreads();
    }
}

static void launch_fwd(const Args& base, int lo, int hi, int grid, hipStream_t stream) {
    Args a = base; a.ph_lo = lo; a.ph_hi = hi;
    hipLaunchKernelGGL(fwd, dim3(grid), dim3(512), LDS_BYTES, stream, a);
}

extern "C" void kernel_launch(void* const* d_in, const int* in_sizes, int n_in, void* d_out, int out_size, void* d_ws, size_t ws_size, hipStream_t stream) {
    static int grid = 0;
    if (grid == 0) {
        if (n_in != 25 || out_size != T * D || ws_size < WS_END) { fprintf(stderr, "kernel_launch: unexpected shapes: n_in %d out %d ws %zu (need %zu)\n", n_in, out_size, ws_size, (size_t)WS_END); grid = -1; return; }
        int dev = 0, cus = 0;
        hipGetDevice(&dev); hipDeviceGetAttribute(&cus, hipDeviceAttributeMultiprocessorCount, dev);
        if (hipFuncSetAttribute((const void*)fwd, hipFuncAttributeMaxDynamicSharedMemorySize, LDS_BYTES) != hipSuccess) { fprintf(stderr, "kernel_launch: hipFuncSetAttribute failed\n"); grid = -1; return; }
        int per_cu = 0; (void)hipOccupancyMaxActiveBlocksPerMultiprocessor(&per_cu, (const void*)fwd, 512, LDS_BYTES); (void)hipGetLastError();
        if (per_cu < 1) fprintf(stderr, "kernel_launch: occupancy query says %d\n", per_cu);
        grid = cus;
    }
    if (grid < 0) return;
    hipMemsetAsync((char*)d_ws + O_CTL, 0, 1 * MiB, stream);
    Args a{};
    for (int i = 0; i < 25; ++i) a.in[i] = (const float*)d_in[i];
    a.out = (float*)d_out; a.ws = (unsigned char*)d_ws; a.ph_lo = 0; a.ph_hi = PH_COUNT;
    unsigned char* ws = (unsigned char*)d_ws;
#define WP(Tp, off) ((Tp*)(ws + (off)))
    const int* nblk_dev = WP(int, O_BLKE) + NBMAX;
#if ONE_LAUNCH
    launch_fwd(a, 0, PH_COUNT, grid, stream);
#else
    const unsigned nm = NAIVE_GEMM_MASK;
    launch_fwd(a, PH_PROLOGUE, PH_PROLOGUE + 1, grid, stream);
    if (nm & (1u << 0)) { pg8::SchedPlain S; memset((void*)&S, 0, sizeof(S)); S.nM = T / 256; S.nN = NZ / 256; S.Bt = (const char*)WP(bf16, O_WIN); S.K = D;
        EInproj e{WP(bf16, O_Z), WP(float, O_LF), WP(float, O_RS0), a.in[I_HGRN_LB]};
        hipLaunchKernelGGL((naive_gemm<pg8::SchedPlain, EInproj>), dim3(S.nM * S.nN, 16), dim3(256), 0, stream, (const char*)WP(bf16, O_XB), D, S, e, (const int*)nullptr);
    } else launch_fwd(a, PH_INPROJ, PH_INPROJ + 1, grid, stream);
#if NAIVE_MIXERS
    hipLaunchKernelGGL(naive_hgrn, dim3(32), dim3(128), 0, stream, WP(bf16, O_Z), WP(float, O_LF), a.in[I_HGRN_NORM], WP(bf16, O_YA));
    hipLaunchKernelGGL(naive_mlstm, dim3(16), dim3(256), 0, stream, WP(bf16, O_Z), WP(float, O_GATES), a.in[I_CONV_W], a.in[I_CONV_B], a.in[I_MLSTM_NORM], WP(bf16, O_YB));
#else
    launch_fwd(a, PH_MIXA, PH_MIXA + 1, grid, stream); launch_fwd(a, PH_SCAN, PH_SCAN + 1, grid, stream); launch_fwd(a, PH_MIXC, PH_MIXC + 1, grid, stream);
#endif
    if (nm & (1u << 1)) {
        { pg8::SchedPlain S; memset((void*)&S, 0, sizeof(S)); S.nM = T / 256; S.nN = D / 256; S.Bt = (const char*)WP(bf16, O_WA); S.K = 1024; EMixA e{WP(float, O_MIXT), WP(bf16, O_Z)};
          hipLaunchKernelGGL((naive_gemm<pg8::SchedPlain, EMixA>), dim3(S.nM * S.nN, 16), dim3(256), 0, stream, (const char*)WP(bf16, O_YA), 1024, S, e, (const int*)nullptr); }
        { pg8::SchedPlain S; memset((void*)&S, 0, sizeof(S)); S.nM = T / 256; S.nN = D / 256; S.Bt = (const char*)WP(bf16, O_WB); S.K = 1024; EMixB e{WP(float, O_MIXT), WP(bf16, O_Z), WP(bf16, O_MIX)};
          hipLaunchKernelGGL((naive_gemm<pg8::SchedPlain, EMixB>), dim3(S.nM * S.nN, 16), dim3(256), 0, stream, (const char*)WP(bf16, O_YB), 1024, S, e, (const int*)nullptr); }
    } else launch_fwd(a, PH_MIXPROJ, PH_MIXPROJ + 1, grid, stream);
    if (nm & (1u << 2)) { pg8::SchedPlain S; memset((void*)&S, 0, sizeof(S)); S.nM = T / 256; S.nN = D / 256; S.Bt = (const char*)WP(bf16, O_WOUT); S.K = D; EX1 e{a.in[I_X], WP(float, O_X1), WP(bf16, O_X1B), WP(float, O_SS1)};
        hipLaunchKernelGGL((naive_gemm<pg8::SchedPlain, EX1>), dim3(S.nM * S.nN, 16), dim3(256), 0, stream, (const char*)WP(bf16, O_MIX), D, S, e, (const int*)nullptr);
    } else launch_fwd(a, PH_WOUT, PH_WOUT + 1, grid, stream);
    launch_fwd(a, PH_ROUTE, PH_ROUTE + 1, grid, stream);
    launch_fwd(a, PH_ROWS, PH_ROWS + 1, grid, stream);
    if (nm & (1u << 3)) { pg8::SchedMoE<true> S; memset((void*)&S, 0, sizeof(S)); S.nM = NBMAX; S.nN = 4096 / 256; S.Bt = (const char*)WP(bf16, O_WGU); S.K = D; S.blke = WP(int, O_BLKE); S.rowtok = WP(int, O_ROWTOK); S.estride = (size_t)4096 * D * 2;
        ESwiglu e{WP(bf16, O_ACT), WP(float, O_ROWRS), a.in[I_B_GU]};
        hipLaunchKernelGGL((naive_gemm<pg8::SchedMoE<true>, ESwiglu>), dim3(NBMAX * 16, 16), dim3(256), 0, stream, (const char*)WP(bf16, O_X1B), D, S, e, nblk_dev);
    } else launch_fwd(a, PH_GU, PH_GU + 1, grid, stream);
    if (nm & (1u << 4)) { pg8::SchedMoE<false> S; memset((void*)&S, 0, sizeof(S)); S.nM = NBMAX; S.nN = D / 256; S.Bt = (const char*)WP(bf16, O_WDN); S.K = DFF; S.blke = WP(int, O_BLKE); S.rowtok = WP(int, O_ROWTOK); S.estride = (size_t)D * DFF * 2;
        EDown e{WP(bf16, O_YBUF), WP(float, O_ROWG), a.in[I_B_DN]};
        hipLaunchKernelGGL((naive_gemm<pg8::SchedMoE<false>, EDown>), dim3(NBMAX * 8, 16), dim3(256), 0, stream, (const char*)WP(bf16, O_ACT), DFF, S, e, nblk_dev);
    } else launch_fwd(a, PH_DN, PH_DN + 1, grid, stream);
    launch_fwd(a, PH_COMBINE, PH_COMBINE + 1, grid, stream);
    if (nm & (1u << 5)) { pg8::SchedPlain S; memset((void*)&S, 0, sizeof(S)); S.nM = T / 256; S.nN = D / 256; S.Bt = (const char*)WP(bf16, O_WPLE); S.K = PLE; EPw e{WP(bf16, O_PW)};
        hipLaunchKernelGGL((naive_gemm<pg8::SchedPlain, EPw>), dim3(S.nM * S.nN, 16), dim3(256), 0, stream, (const char*)WP(bf16, O_PB), PLE, S, e, (const int*)nullptr); }
    if (nm & (1u << 6)) { pg8::SchedPlain S; memset((void*)&S, 0, sizeof(S)); S.nM = T / 256; S.nN = D / 256; S.Bt = (const char*)WP(bf16, O_WPG); S.K = D; EGate e{WP(float, O_X2), WP(bf16, O_PW), WP(float, O_RS2), a.out, WP(float, O_SS3)};
        hipLaunchKernelGGL((naive_gemm<pg8::SchedPlain, EGate>), dim3(S.nM * S.nN, 16), dim3(256), 0, stream, (const char*)WP(bf16, O_X2B), D, S, e, (const int*)nullptr);
    } else launch_fwd(a, PH_GATE, PH_GATE + 1, grid, stream);
    launch_fwd(a, PH_FINAL, PH_FINAL + 1, grid, stream);
#endif
#undef WP
}
```

```cpp
#include <hip/hip_runtime.h>
#include <cstdio>
#include <cstdint>
#include <cstring>

#define DI __device__ __forceinline__
#define LAS __attribute__((address_space(3)))

typedef unsigned short bf16;
typedef short bf16x8 __attribute__((ext_vector_type(8)));
typedef float f32x4 __attribute__((ext_vector_type(4)));
typedef float f32x16 __attribute__((ext_vector_type(16)));
typedef unsigned u32x4 __attribute__((ext_vector_type(4)));
typedef unsigned u32x2 __attribute__((ext_vector_type(2)));

#ifndef NAIVE_GEMM_MASK
#define NAIVE_GEMM_MASK 0x0
#endif
#ifndef NAIVE_MIXERS
#define NAIVE_MIXERS 0
#endif
#ifndef ONE_LAUNCH
#define ONE_LAUNCH 1
#endif
#ifndef PROBE_PH
#define PROBE_PH -1
#endif
#ifndef PROBE_N
#define PROBE_N 0
#endif

constexpr int T = 32768, D = 2048, SEQ = 8192;
constexpr int NZ = 11264, INCOLS = 11272;
constexpr int ZQA = 0, ZKA = 1024, ZVA = 2048, ZGA = 3072, ZQK = 4096, ZVB = 5120, ZOB = 6144, ZRA = 7168, ZRB = 9216;
constexpr int NE = 32, DFF = 2048, PLE = 256;
constexpr int NRMAX = T * 4 + NE * 256;
constexpr int NBMAX = NRMAX / 256;
constexpr float EPS = 1e-6f;
constexpr float SC_X = 16.f, SC_WGU = 256.f, SC_ACT = 4.f, SC_WDN = 256.f;
constexpr int NCHUNK = 128;
constexpr int NITEM_A = 4 * NCHUNK * 8;
constexpr int NITEM_B = 4 * NCHUNK * 4;

constexpr size_t al4k(size_t x) { return (x + 4095) & ~(size_t)4095; }
constexpr size_t MiB = (size_t)1 << 20;
constexpr size_t O_CTL = 0;
constexpr size_t O_RS0 = 1 * MiB;
constexpr size_t O_RS1 = O_RS0 + al4k((size_t)T * 4);
constexpr size_t O_RS2 = O_RS1 + al4k((size_t)T * 4);
constexpr size_t O_GATES = O_RS2 + al4k((size_t)T * 4);
constexpr size_t O_RWG = O_GATES + al4k((size_t)T * 8 * 4);
constexpr size_t O_DEC = O_RWG + al4k((size_t)D * NE * 4);
constexpr size_t O_NL = O_DEC + al4k((size_t)NITEM_A * 128 * 4);
constexpr size_t O_MLOC = O_NL + al4k((size_t)NITEM_B * 128 * 4);
constexpr size_t O_GTOT = O_MLOC + al4k((size_t)NITEM_B * 4);
constexpr size_t O_MST = O_GTOT + al4k((size_t)NITEM_B * 4);
constexpr size_t O_TOPE = O_MST + al4k((size_t)NITEM_B * 4);
constexpr size_t O_TOPG = O_TOPE + al4k((size_t)T * 4 * 4);
constexpr size_t O_SLOT = O_TOPG + al4k((size_t)T * 4 * 4);
constexpr size_t O_HIST = O_SLOT + al4k((size_t)T * 4 * 4);
constexpr size_t O_ROWTOK = O_HIST + al4k((size_t)256 * 32 * 4);
constexpr size_t O_ROWG = O_ROWTOK + al4k((size_t)NRMAX * 4);
constexpr size_t O_ROWRS = O_ROWG + al4k((size_t)NRMAX * 4);
constexpr size_t O_BLKE = O_ROWRS + al4k((size_t)NRMAX * 4);
constexpr size_t O_SS1 = O_BLKE + al4k((size_t)(NBMAX + 16) * 4);
constexpr size_t O_SS3 = O_SS1 + al4k((size_t)T * 32 * 4);
constexpr size_t O_SMALL_END = O_SS3 + al4k((size_t)T * 32 * 4);
static_assert(O_SMALL_END <= 32 * MiB, "small region");
constexpr size_t O_WIN = 32 * MiB;
constexpr size_t O_WA = O_WIN + (size_t)NZ * D * 2;
constexpr size_t O_WB = O_WA + (size_t)D * 1024 * 2;
constexpr size_t O_WOUT = O_WB + (size_t)D * 1024 * 2;
constexpr size_t O_WPG = O_WOUT + (size_t)D * D * 2;
constexpr size_t O_WPLE = O_WPG + (size_t)D * D * 2;
constexpr size_t O_WGU = O_WPLE + (size_t)D * PLE * 2;
constexpr size_t O_WDN = O_WGU + (size_t)NE * 4096 * D * 2;
constexpr size_t O_XB = O_WDN + (size_t)NE * D * DFF * 2;
constexpr size_t O_PB = O_XB + (size_t)T * D * 2;
constexpr size_t O_Z = O_PB + (size_t)T * PLE * 2;
constexpr size_t O_M = O_Z + (size_t)T * NZ * 2;
constexpr size_t O_LF = O_M;
constexpr size_t O_UST = O_LF + (size_t)T * 1024 * 4;
constexpr size_t O_CT = O_UST + (size_t)NITEM_A * 128 * 128 * 2;
constexpr size_t O_YA = O_CT + (size_t)NITEM_B * 256 * 128 * 2;
constexpr size_t O_YB = O_YA + (size_t)T * 1024 * 2;
constexpr size_t O_MIX = O_YB + (size_t)T * 1024 * 2;
constexpr size_t O_M_END = O_MIX + (size_t)T * D * 2;
static_assert(O_M_END - O_M >= (size_t)NRMAX * D * 2, "YBUF alias");
static_assert((size_t)T * NZ * 2 >= (size_t)NRMAX * D * 2, "ACT alias");
constexpr size_t O_MIXT = O_M_END;
constexpr size_t O_X1 = O_MIXT + (size_t)T * D * 4;
constexpr size_t O_X1B = O_X1 + (size_t)T * D * 4;
constexpr size_t WS_END = O_X1B + (size_t)T * D * 2;
constexpr size_t O_ACT = O_Z, O_YBUF = O_M, O_X2 = O_MIXT, O_X2B = O_XB, O_PW = O_X1B;

constexpr int CW_BAR = 4096;

DI int lane_id() { int l; asm volatile("v_mbcnt_lo_u32_b32 %0, -1, 0\n\tv_mbcnt_hi_u32_b32 %0, -1, %0" : "=v"(l)); return l; }
DI unsigned f2bf(float f) { unsigned u = __float_as_uint(f); return (u + 0x7fffu + ((u >> 16) & 1u)) >> 16; }
DI float bf2f(unsigned h) { return __uint_as_float(h << 16); }
DI unsigned pk2(float lo, float hi) { unsigned r; asm volatile("v_cvt_pk_bf16_f32 %0, %1, %2" : "=v"(r) : "v"(lo), "v"(hi)); return r; }
typedef float f32x2 __attribute__((ext_vector_type(2)));
typedef __bf16 bf16x2_t __attribute__((ext_vector_type(2)));
DI unsigned pk2c(float lo, float hi) { const f32x2 v = {lo, hi}; return __builtin_bit_cast(unsigned, __builtin_convertvector(v, bf16x2_t)); }
DI float sigm(float x) { return __builtin_amdgcn_rcpf(1.f + __expf(-x)); }
DI float wave_sum(float v) {
#pragma unroll
    for (int o = 1; o < 64; o <<= 1) v += __shfl_xor(v, o);
    return v;
}
DI float wave_max(float v) {
#pragma unroll
    for (int o = 1; o < 64; o <<= 1) v = fmaxf(v, __shfl_xor(v, o));
    return v;
}
DI void unpack8(const u32x4 w, float (&o)[8]) {
    o[0] = bf2f(w.x & 0xffffu); o[1] = bf2f(w.x >> 16); o[2] = bf2f(w.y & 0xffffu); o[3] = bf2f(w.y >> 16);
    o[4] = bf2f(w.z & 0xffffu); o[5] = bf2f(w.z >> 16); o[6] = bf2f(w.w & 0xffffu); o[7] = bf2f(w.w >> 16);
}
DI u32x4 pack8(const float (&v)[8]) { u32x4 w; w.x = pk2(v[0], v[1]); w.y = pk2(v[2], v[3]); w.z = pk2(v[4], v[5]); w.w = pk2(v[6], v[7]); return w; }
DI u32x4 pack8c(const float (&v)[8]) { u32x4 w; w.x = pk2c(v[0], v[1]); w.y = pk2c(v[2], v[3]); w.z = pk2c(v[4], v[5]); w.w = pk2c(v[6], v[7]); return w; }
DI unsigned pk4_fp8(float a, float b, float c, float d) { unsigned w = __builtin_amdgcn_cvt_pk_fp8_f32(a, b, 0u, false); return __builtin_amdgcn_cvt_pk_fp8_f32(c, d, w, true); }
DI float clamp8(float v) { return fminf(fmaxf(v, -440.f), 440.f); }
DI float log_sigmoid(float x) { return fminf(x, 0.f) - __logf(1.f + __expf(-fabsf(x))); }

#define XB_TMO      128
#define XB_XCNT(j)  (256  + 64 * (j))
#define XB_XSUB(j)  (1280 + 64 * (j))
#define XB_XGEN(j)  (2304 + 64 * (j))
#define XB_TOP      3328
#define XB_TOPGEN   3392
#define XCD_BAR_WORDS 3456
#define XB_SPIN_CAP (1u << 18)
__device__ __forceinline__ unsigned xb_ld(unsigned* p)              { return __hip_atomic_load(p, __ATOMIC_RELAXED, __HIP_MEMORY_SCOPE_AGENT); }
__device__ __forceinline__ unsigned xb_add(unsigned* p, unsigned v) { return __hip_atomic_fetch_add(p, v, __ATOMIC_RELAXED, __HIP_MEMORY_SCOPE_AGENT); }
__device__ __forceinline__ unsigned xb_xcc_id() { return (unsigned)__builtin_amdgcn_s_getreg((3 << 11) | 20) & 0xFu; }
#define XB_SPIN(cond, bar) do { unsigned _sp = 0; while (cond) { __builtin_amdgcn_s_sleep(1); \
    if ((++_sp & 255u) == 0u) { if (xb_ld(&(bar)[XB_TMO])) break; if (_sp > XB_SPIN_CAP) { atomicAdd(&(bar)[XB_TMO], 1u); break; } } } } while (0)
struct XcdBarrier { unsigned* bar; unsigned x; volatile LAS unsigned* st; };
__device__ __forceinline__ XcdBarrier xcd_barrier_post(unsigned* bar, volatile LAS unsigned* st, bool leader) {
    XcdBarrier b; b.bar = bar; b.x = xb_xcc_id(); b.st = st;
    if (leader) (void)xb_add(&bar[XB_XCNT(b.x)], 1u);
    return b;
}
__device__ __forceinline__ void xcd_barrier_complete(unsigned* bar, unsigned x, unsigned& nloc, unsigned& nx) {
    const unsigned G = gridDim.x * gridDim.y * gridDim.z;
    unsigned sum, cnt, mine, sp = 0u;
    for (;;) {
        sum = 0u; cnt = 0u; mine = 0u;
#pragma unroll
        for (unsigned j = 0; j < 16; ++j) { const unsigned c = xb_ld(&bar[XB_XCNT(j)]); sum += c; cnt += (c > 0u) ? 1u : 0u; mine = (j == x) ? c : mine; }
        if (sum == G) break;
        __builtin_amdgcn_s_sleep(1);
        if ((++sp & 255u) == 0u) { if (xb_ld(&bar[XB_TMO])) break; if (sp > XB_SPIN_CAP) { atomicAdd(&bar[XB_TMO], 1u); break; } }
    }
    nloc = mine > 0u ? mine : 1u; nx = cnt > 0u ? cnt : 1u;
}
__device__ __forceinline__ void xcd_barrier(const XcdBarrier& b, bool leader) {
    asm volatile("s_waitcnt vmcnt(0)" ::: "memory");
    __syncthreads();
    if (leader) {
        unsigned* bar = b.bar;
        __builtin_amdgcn_s_waitcnt(0);
        unsigned nloc = b.st[0], nx = b.st[1];
        if (nloc == 0u) { xcd_barrier_complete(bar, b.x, nloc, nx); b.st[0] = nloc; b.st[1] = nx; }
        const unsigned old = xb_add(&bar[XB_XSUB(b.x)], 1u);
        const unsigned gen = old / nloc;
        if (old + 1u == (gen + 1u) * nloc) {
            __builtin_amdgcn_fence(__ATOMIC_RELEASE, "agent");
            asm volatile("s_waitcnt vmcnt(0)" ::: "memory");
            const unsigned og = xb_add(&bar[XB_TOP], 1u);
            const unsigned tg = og / nx;
            if (og + 1u == (tg + 1u) * nx) xb_add(&bar[XB_TOPGEN], 1u);
            else XB_SPIN(xb_ld(&bar[XB_TOPGEN]) == tg, bar);
            __builtin_amdgcn_fence(__ATOMIC_ACQUIRE, "agent");
            xb_add(&bar[XB_XGEN(b.x)], 1u);
            asm volatile("s_waitcnt vmcnt(0)" ::: "memory");
        } else {
            XB_SPIN(xb_ld(&bar[XB_XGEN(b.x)]) == gen, bar);
            __builtin_amdgcn_fence(__ATOMIC_ACQUIRE, "agent");
            asm volatile("s_waitcnt vmcnt(0)" ::: "memory");
        }
    }
    __syncthreads();
}

namespace pg8 {
constexpr int BM = 256, BK = 64, HALF = 128, HTB = HALF * BK * 2, STAGE_BYTES = 8 * HTB, NXCD = 8, WGM = 8;
__host__ __device__ __forceinline__ int lds_byte(int r, int c) { const int st = (r >> 4) * 2 + (c >> 5), rr = r & 15, cc = c & 31, ob = rr * 64 + cc * 2; return st * 1024 + (ob ^ (((ob >> 9) & 1) << 5)); }
__host__ __device__ __forceinline__ void stage_rc(int b, int& R, int& C) { const int st = b / 1024, sb = b % 1024, swz = sb ^ (((sb >> 9) & 1) << 5); R = (st >> 1) * 16 + swz / 64; C = (st & 1) * 32 + (swz % 64) / 2; }
__host__ __device__ __forceinline__ int perm32(int rho) { const int n = rho >> 4, i = rho & 15; return 8 * (i >> 2) + 4 * n + (i & 3); }

struct Unit { int pm, pn, e; };

struct OrderBase {
    int nM, nN, nwg, G, c;
    DI void init_order(int nM_, int nN_, int G_, int c_) { nM = nM_; nN = nN_; nwg = nM * nN; G = G_; c = c_; }
    DI bool next_mn(int i, Unit& u) const {
        const long L = (long)i * G + c; if (L >= nwg) return false;
        int wgid = (int)L; { const int q = nwg / NXCD, r = nwg % NXCD, xcd = wgid % NXCD, off = wgid / NXCD; wgid = (xcd < r ? xcd * (q + 1) : r * (q + 1) + (xcd - r) * q) + off; }
        const int nig = WGM * nN, gid = wgid / nig, fm = gid * WGM, gsz = (nM - fm) < WGM ? (nM - fm) : WGM;
        u.pm = fm + ((wgid % nig) % gsz); u.pn = (wgid % nig) / gsz; return true;
    }
};
struct SchedPlain : OrderBase {
    static constexpr bool GATHER = false;
    const char* Bt; int K;
    DI void init(int M, int N, int K_, const void* Bt_, int G_, int c_) { init_order(M / BM, N / BM, G_, c_); Bt = (const char*)Bt_; K = K_; }
    DI bool next(int i, Unit& u) const { u.e = 0; return next_mn(i, u); }
    DI bool unit_of(int L, Unit& u) const { u.e = 0; u.pm = L / nN; u.pn = L % nN; return u.pm < nM; }
    DI unsigned a_row_off(const Unit& u, int r) const { return (unsigned)(u.pm * BM + r) * (unsigned)K; }
    DI const char* b_ptr(const Unit& u) const { return Bt + (size_t)u.pn * BM * K; }
};
template <bool GATHER_> struct SchedMoE : OrderBase {
    static constexpr bool GATHER = GATHER_;
    const char* Bt; int K; const int* blke; const int* rowtok; size_t estride;
    DI void init(int nblk, int N, int K_, const void* Bt_, size_t estride_, const int* blke_, const int* rowtok_, int G_, int c_) { init_order(nblk, N / BM, G_, c_); Bt = (const char*)Bt_; K = K_; blke = blke_; rowtok = rowtok_; estride = estride_; }
    DI bool next(int i, Unit& u) const { if (!next_mn(i, u)) return false; u.e = __builtin_amdgcn_readfirstlane(blke[u.pm]); return true; }
    DI bool unit_of(int L, Unit& u) const { u.pm = L / nN; u.pn = L % nN; if (u.pm >= nM) return false; u.e = blke[u.pm]; return true; }
    DI unsigned a_row_off(const Unit& u, int r) const { const int row = u.pm * BM + r; return (unsigned)(GATHER ? rowtok[row] : row) * (unsigned)K; }
    DI const char* b_ptr(const Unit& u) const { return Bt + (size_t)u.e * estride + (size_t)u.pn * BM * K; }
};

template <class E> struct EpiWrap {
    static constexpr bool PERM = true, AFTER_DRAIN = false;
    E e;
    DI void operator()(const f32x4 (&acc)[2][2][4][2], const Unit& u, int wr, int wc, int fr, int fq) const {
#pragma unroll
        for (int ai = 0; ai < 2; ++ai)
#pragma unroll
            for (int m = 0; m < 4; ++m) {
                const int row = u.pm * BM + ai * HALF + wr * 64 + m * 16 + fr, lc = wc * 32 + 8 * fq;
                float v0[8], v1[8];
#pragma unroll
                for (int j = 0; j < 4; ++j) { v0[j] = acc[ai][0][m][0][j]; v0[4 + j] = acc[ai][0][m][1][j]; v1[j] = acc[ai][1][m][0][j]; v1[4 + j] = acc[ai][1][m][1][j]; }
                e.store(u, row, lc, v0, v1);
            }
    }
};

typedef int i32x4 __attribute__((ext_vector_type(4)));
typedef int i32x8 __attribute__((ext_vector_type(8)));
DI i32x8 cat8(const bf16x8 lo, const bf16x8 hi) { return __builtin_shufflevector(__builtin_bit_cast(i32x4, lo), __builtin_bit_cast(i32x4, hi), 0, 1, 2, 3, 4, 5, 6, 7); }
template <bool FP8, class Epi, class Sched, bool ALIGN_EPI = true, bool SP2 = true>
__device__ __forceinline__ void gemm_phase(LAS unsigned char* lds, const int wave_, const char* Abase, const int KB, const Sched& S, const Epi& E) {
    const int lane = lane_id(), wid = wave_, tid = wid * 64 + lane, wr = wid >> 2, wc = wid & 3, fr = lane & 15, fq = lane >> 4;
    const int nt = KB / 128;
    int Rr[2], Cc[2]; unsigned voffB[2], voffA[2];
#pragma unroll
    for (int i = 0; i < 2; ++i) { stage_rc(tid * 16 + i * 8192, Rr[i], Cc[i]); const int Rb = Epi::PERM ? ((Rr[i] & ~31) + perm32(Rr[i] & 31)) : Rr[i]; voffB[i] = (unsigned)(Rb * KB + Cc[i] * 2); voffA[i] = (unsigned)(Rr[i] * KB + Cc[i] * 2); }
    const size_t kstep = (size_t)(BK * 2);
    const size_t hstep = (size_t)HALF * KB;
    const unsigned ldsw = (unsigned)wid * 1024u;
    const int aoff = lds_byte(wr * 64 + fr, fq * 8), boff = lds_byte(wc * 32 + fr, fq * 8);
#define PG8_SA(b, h) (((b) * 2 + (h)) * HTB)
#define PG8_SB(b, h) ((4 + (b) * 2 + (h)) * HTB)
#define PG8_STAGE(bufoff, gbase, v0_, v1_) do { \
        __builtin_amdgcn_global_load_lds((const unsigned*)((const char*)(gbase) + (v0_)), (LAS unsigned*)(lds + (bufoff) + ldsw), 16, 0, 0); \
        __builtin_amdgcn_global_load_lds((const unsigned*)((const char*)(gbase) + (v1_)), (LAS unsigned*)(lds + (bufoff) + ldsw + 8192), 16, 0, 0); } while (0)
#define PG8_STAGEB(bufoff, gbase) PG8_STAGE(bufoff, gbase, voffB[0], voffB[1])
#define PG8_STAGEA(bufoff, h, uptr, kb, useNext) do { if constexpr (Sched::GATHER) { const unsigned o0_ = (useNext) ? nvA[h][0] : vA[h][0], o1_ = (useNext) ? nvA[h][1] : vA[h][1]; PG8_STAGE(bufoff, Abase + (kb), o0_, o1_); } \
        else { PG8_STAGE(bufoff, (uptr) + (h) * hstep, voffA[0], voffA[1]); } } while (0)
#define PG8_LDA(dst, b, h) do { _Pragma("unroll") for (int m = 0; m < 4; ++m) { if constexpr (FP8) dst##8[m] = cat8(*(const LAS bf16x8*)(lds + PG8_SA(b, h) + aoff + m * 2048), *(const LAS bf16x8*)(lds + PG8_SA(b, h) + aoff + m * 2048 + 1024)); \
        else { _Pragma("unroll") for (int k = 0; k < 2; ++k) dst[m][k] = *(const LAS bf16x8*)(lds + PG8_SA(b, h) + aoff + m * 2048 + k * 1024); } } } while (0)
#define PG8_LDB(dst, b, h) do { _Pragma("unroll") for (int n = 0; n < 2; ++n) { if constexpr (FP8) dst##8[n] = cat8(*(const LAS bf16x8*)(lds + PG8_SB(b, h) + boff + n * 2048), *(const LAS bf16x8*)(lds + PG8_SB(b, h) + boff + n * 2048 + 1024)); \
        else { _Pragma("unroll") for (int k = 0; k < 2; ++k) dst[n][k] = *(const LAS bf16x8*)(lds + PG8_SB(b, h) + boff + n * 2048 + k * 1024); } } } while (0)
#define PG8_MMA(ai, bj, At, Bt) do { __builtin_amdgcn_s_setprio(1); _Pragma("unroll") for (int m = 0; m < 4; ++m) _Pragma("unroll") for (int n = 0; n < 2; ++n) { \
        if constexpr (FP8) asm volatile("v_mfma_f32_16x16x128_f8f6f4 %0, %1, %2, %0" : "+v"(acc[ai][bj][m][n]) : "v"(Bt##8[n]), "v"(At##8[m]));   \
        else { _Pragma("unroll") for (int k = 0; k < 2; ++k) acc[ai][bj][m][n] = __builtin_amdgcn_mfma_f32_16x16x32_bf16(Bt[n][k], At[m][k], acc[ai][bj][m][n], 0, 0, 0); } } \
        __builtin_amdgcn_s_setprio(0); } while (0)
#define PG8_WAIT_V(n) asm volatile("s_waitcnt vmcnt(" #n ")" ::: "memory")
#define PG8_WAIT_L(n) asm volatile("s_waitcnt lgkmcnt(" #n ")" ::: "memory")
#define PG8_BAR __builtin_amdgcn_s_barrier()
#define PG8_SCHED __builtin_amdgcn_sched_barrier(0)
    Unit cur, nxt; int ui = 0;
    if (!S.next(0, cur)) return;
    f32x4 acc[2][2][4][2];
#pragma unroll
    for (int a = 0; a < 2; ++a)
#pragma unroll
        for (int b = 0; b < 2; ++b)
#pragma unroll
            for (int m = 0; m < 4; ++m)
#pragma unroll
                for (int n = 0; n < 2; ++n) acc[a][b][m][n] = (f32x4){0.f, 0.f, 0.f, 0.f};
    bf16x8 At[4][2], B0[2][2], B1[2][2];
    i32x8 At8[4], B08[2], B18[2];
    unsigned vA[2][2] = {{0u, 0u}, {0u, 0u}}, nvA[2][2] = {{0u, 0u}, {0u, 0u}};
    const char* cA = Abase; const char* nA = Abase;
    if constexpr (Sched::GATHER) {
#pragma unroll
        for (int h = 0; h < 2; ++h)
#pragma unroll
            for (int i = 0; i < 2; ++i) vA[h][i] = S.a_row_off(cur, h * HALF + Rr[i]) + (unsigned)Cc[i] * 2u;
    } else cA = Abase + (size_t)S.a_row_off(cur, 0);
    const char* cB = S.b_ptr(cur);
    if constexpr (SP2) {
        PG8_STAGEB(PG8_SB(0, 0), cB); PG8_STAGEB(PG8_SB(0, 1), cB + hstep); PG8_STAGEA(PG8_SA(0, 0), 0, cA, 0, false); PG8_STAGEA(PG8_SA(0, 1), 1, cA, 0, false);
        if (wr == 1) PG8_BAR;
        PG8_WAIT_V(2); PG8_BAR;
        PG8_STAGEB(PG8_SB(1, 0), cB + kstep); PG8_STAGEA(PG8_SA(1, 0), 0, cA + kstep, kstep, false); PG8_STAGEB(PG8_SB(1, 1), cB + hstep + kstep);
        PG8_WAIT_V(6); PG8_BAR;
    } else {
        PG8_STAGEB(PG8_SB(0, 0), cB); PG8_STAGEA(PG8_SA(0, 0), 0, cA, 0, false); PG8_STAGEB(PG8_SB(0, 1), cB + hstep); PG8_STAGEA(PG8_SA(0, 1), 1, cA, 0, false);
        if (wr == 1) PG8_BAR;
        PG8_WAIT_V(4); PG8_BAR;
        PG8_STAGEB(PG8_SB(1, 0), cB + kstep); PG8_STAGEA(PG8_SA(1, 0), 0, cA + kstep, kstep, false); PG8_STAGEB(PG8_SB(1, 1), cB + hstep + kstep);
        PG8_WAIT_V(6); PG8_BAR;
    }
    for (;;) {
        const bool has_next = S.next(ui + 1, nxt);
        const char* nB = cB; nA = cA;
        if (has_next) {
            nB = S.b_ptr(nxt);
            if constexpr (Sched::GATHER) {
#pragma unroll
                for (int h = 0; h < 2; ++h)
#pragma unroll
                    for (int i = 0; i < 2; ++i) nvA[h][i] = S.a_row_off(nxt, h * HALF + Rr[i]) + (unsigned)Cc[i] * 2u;
            } else nA = Abase + (size_t)S.a_row_off(nxt, 0);
        } else if constexpr (Sched::GATHER) {
#pragma unroll
            for (int h = 0; h < 2; ++h)
#pragma unroll
                for (int i = 0; i < 2; ++i) nvA[h][i] = vA[h][i];
        }
#pragma unroll 1
        for (int t = 0; t < nt; t += 2) {
            const bool last = (t == nt - 2);
            const char* a1 = cA + (size_t)(t + 1) * kstep; const size_t k1 = (size_t)(t + 1) * kstep;
            const char* a2 = last ? nA : cA + (size_t)(t + 2) * kstep; const char* b2 = last ? nB : cB + (size_t)(t + 2) * kstep; const size_t k2 = last ? (size_t)0 : (size_t)(t + 2) * kstep;
            const char* a3 = a2 + kstep; const char* b3 = b2 + kstep; const size_t k3 = k2 + kstep;
            if constexpr (SP2) {
            PG8_LDB(B0, 0, 0); PG8_LDB(B1, 0, 1); PG8_SCHED; PG8_LDA(At, 0, 0); PG8_STAGEA(PG8_SA(1, 1), 1, a1, k1, false);
            PG8_WAIT_V(8); PG8_WAIT_L(0); PG8_BAR; PG8_MMA(0, 0, At, B0); PG8_MMA(0, 1, At, B1); PG8_BAR; PG8_SCHED;
            PG8_LDA(At, 0, 1); PG8_STAGEB(PG8_SB(0, 0), b2); PG8_STAGEB(PG8_SB(0, 1), b2 + hstep); PG8_STAGEA(PG8_SA(0, 0), 0, a2, k2, last);
            PG8_WAIT_V(8); PG8_WAIT_L(0); PG8_BAR; PG8_MMA(1, 0, At, B0); PG8_MMA(1, 1, At, B1); PG8_BAR; PG8_SCHED;
            PG8_LDB(B0, 1, 0); PG8_LDB(B1, 1, 1); PG8_SCHED; PG8_LDA(At, 1, 0); PG8_STAGEA(PG8_SA(0, 1), 1, a2, k2, last);
            PG8_WAIT_V(8); PG8_WAIT_L(0); PG8_BAR; PG8_MMA(0, 0, At, B0); PG8_MMA(0, 1, At, B1); PG8_BAR; PG8_SCHED;
            PG8_LDA(At, 1, 1); PG8_STAGEB(PG8_SB(1, 0), b3); PG8_STAGEB(PG8_SB(1, 1), b3 + hstep); PG8_STAGEA(PG8_SA(1, 0), 0, a3, k3, last);
            PG8_WAIT_V(8); PG8_WAIT_L(0); PG8_BAR; PG8_MMA(1, 0, At, B0); PG8_MMA(1, 1, At, B1); PG8_BAR; PG8_SCHED;
            } else {
            PG8_LDB(B0, 0, 0); PG8_SCHED; PG8_LDA(At, 0, 0); PG8_STAGEA(PG8_SA(1, 1), 1, a1, k1, false);
            PG8_WAIT_L(8); PG8_BAR; PG8_WAIT_L(0); PG8_MMA(0, 0, At, B0); PG8_BAR; PG8_SCHED;
            PG8_LDB(B1, 0, 1); PG8_STAGEB(PG8_SB(0, 0), b2);
            PG8_BAR; PG8_WAIT_L(0); PG8_MMA(0, 1, At, B1); PG8_BAR;
            PG8_LDA(At, 0, 1); PG8_STAGEA(PG8_SA(0, 0), 0, a2, k2, last);
            PG8_BAR; PG8_WAIT_L(0); PG8_MMA(1, 0, At, B0); PG8_BAR; PG8_SCHED;
            PG8_STAGEB(PG8_SB(0, 1), b2 + hstep);
            PG8_WAIT_V(6); PG8_BAR; PG8_MMA(1, 1, At, B1); PG8_BAR;
            PG8_LDB(B0, 1, 0); PG8_SCHED; PG8_LDA(At, 1, 0); PG8_STAGEA(PG8_SA(0, 1), 1, a2, k2, last);
            PG8_WAIT_L(8); PG8_BAR; PG8_WAIT_L(0); PG8_MMA(0, 0, At, B0); PG8_BAR; PG8_SCHED;
            PG8_LDB(B1, 1, 1); PG8_STAGEB(PG8_SB(1, 0), b3);
            PG8_BAR; PG8_WAIT_L(0); PG8_MMA(0, 1, At, B1); PG8_BAR;
            PG8_LDA(At, 1, 1); PG8_STAGEA(PG8_SA(1, 0), 0, a3, k3, last);
            PG8_BAR; PG8_WAIT_L(0); PG8_MMA(1, 0, At, B0); PG8_BAR; PG8_SCHED;
            PG8_STAGEB(PG8_SB(1, 1), b3 + hstep);
            PG8_WAIT_V(6); PG8_BAR; PG8_MMA(1, 1, At, B1); PG8_BAR;
            }
        }
        if constexpr (FP8) asm volatile("s_nop 15\n\ts_nop 15" ::: "memory");
        if constexpr (ALIGN_EPI) { if (wr == 0) PG8_BAR; }
        E(acc, cur, wr, wc, fr, fq);
        if (!has_next) break;
#pragma unroll
        for (int a = 0; a < 2; ++a)
#pragma unroll
            for (int b = 0; b < 2; ++b)
#pragma unroll
                for (int m = 0; m < 4; ++m)
#pragma unroll
                    for (int n = 0; n < 2; ++n) acc[a][b][m][n] = (f32x4){0.f, 0.f, 0.f, 0.f};
        cur = nxt; cB = nB; cA = nA; ++ui;
        if constexpr (Sched::GATHER) {
#pragma unroll
            for (int h = 0; h < 2; ++h)
#pragma unroll
                for (int i = 0; i < 2; ++i) vA[h][i] = nvA[h][i];
        }
        if constexpr (ALIGN_EPI) { if (wr == 1) PG8_BAR; }
    }
    PG8_WAIT_V(0);
    if constexpr (!ALIGN_EPI) { if (wr == 0) PG8_BAR; }
    PG8_BAR;
#undef PG8_SA
#undef PG8_SB
#undef PG8_STAGE
#undef PG8_STAGEB
#undef PG8_STAGEA
#undef PG8_LDA
#undef PG8_LDB
#undef PG8_MMA
#undef PG8_WAIT_V
#undef PG8_WAIT_L
#undef PG8_BAR
#undef PG8_SCHED
}
}
using pg8::Unit;

struct EInproj {
    bf16* Z; float* LF; const float* rs0; const float* hlb;
    DI void store(const Unit& u, int row, int lc, const float (&v0)[8], const float (&v1)[8]) const {
        const float rs = rs0[row];
        const int kind = u.pn >> 2;
#pragma unroll
        for (int bj = 0; bj < 2; ++bj) {
            const int col = u.pn * 256 + bj * 128 + lc;
            float o[8];
            if (kind == 2 || kind == 4 || kind == 5) {
#pragma unroll
                for (int i = 0; i < 8; ++i) o[i] = rs * (bj ? v1[i] : v0[i]);
            } else if (kind == 1) {
                const int c = col - 1024;
                float lf[8];
#pragma unroll
                for (int i = 0; i < 8; ++i) {
                    const float lbv = sigm(hlb[c + i] - hlb[1024 + c + i]);
                    float z = rs * (bj ? v1[i] : v0[i]); z = fminf(fmaxf(z, -80.f), 80.f);
                    const float e = __expf(-z), s = __builtin_amdgcn_rcpf(1.f + e), sn = e * s;
                    lf[i] = __logf(lbv + (1.f - lbv) * s);
                    o[i] = (1.f - lbv) * sn;
                }
                float* lp = LF + (size_t)row * 1024 + c;
                *(f32x4*)lp = (f32x4){lf[0], lf[1], lf[2], lf[3]}; *(f32x4*)(lp + 4) = (f32x4){lf[4], lf[5], lf[6], lf[7]};
            } else {
                const bool silu = (kind == 0 || kind == 3);
#pragma unroll
                for (int i = 0; i < 8; ++i) { const float z = rs * (bj ? v1[i] : v0[i]); const float s = sigm(z); o[i] = silu ? z * s : s; }
            }
            *(u32x4*)(Z + (size_t)row * NZ + col) = pack8(o);
        }
    }
};
struct EMixA {
    float* MIXT; const bf16* Z;
    DI void store(const Unit& u, int row, int lc, const float (&v0)[8], const float (&v1)[8]) const {
#pragma unroll
        for (int bj = 0; bj < 2; ++bj) {
            const int col = u.pn * 256 + bj * 128 + lc; float g[8];
            unpack8(*(const u32x4*)(Z + (size_t)row * NZ + ZRA + col), g);
            float* p = MIXT + (size_t)row * D + col;
            f32x4 a, b;
#pragma unroll
            for (int i = 0; i < 4; ++i) { a[i] = g[i] * (bj ? v1[i] : v0[i]); b[i] = g[4 + i] * (bj ? v1[4 + i] : v0[4 + i]); }
            *(f32x4*)p = a; *(f32x4*)(p + 4) = b;
        }
    }
};
struct EMixB {
    const float* MIXT; const bf16* Z; bf16* MIX;
    DI void store(const Unit& u, int row, int lc, const float (&v0)[8], const float (&v1)[8]) const {
#pragma unroll
        for (int bj = 0; bj < 2; ++bj) {
            const int col = u.pn * 256 + bj * 128 + lc; float g[8], o[8];
            unpack8(*(const u32x4*)(Z + (size_t)row * NZ + ZRB + col), g);
            const float* p = MIXT + (size_t)row * D + col;
            const f32x4 a = *(const f32x4*)p, b = *(const f32x4*)(p + 4);
#pragma unroll
            for (int i = 0; i < 4; ++i) { o[i] = a[i] + g[i] * (bj ? v1[i] : v0[i]); o[4 + i] = b[i] + g[4 + i] * (bj ? v1[4 + i] : v0[4 + i]); }
            *(u32x4*)(MIX + (size_t)row * D + col) = pack8(o);
        }
    }
};
struct EX1 {
    const float* x; float* X1; unsigned char* X18; float* SS1;
    DI void store(const Unit& u, int row, int lc, const float (&v0)[8], const float (&v1)[8]) const {
        float ss = 0.f;
#pragma unroll
        for (int bj = 0; bj < 2; ++bj) {
            const int col = u.pn * 256 + bj * 128 + lc; float o[8];
            const float* p = x + (size_t)row * D + col;
            const f32x4 a = *(const f32x4*)p, b = *(const f32x4*)(p + 4);
#pragma unroll
            for (int i = 0; i < 4; ++i) { o[i] = a[i] + (bj ? v1[i] : v0[i]); o[4 + i] = b[i] + (bj ? v1[4 + i] : v0[4 + i]); }
#pragma unroll
            for (int i = 0; i < 8; ++i) ss += o[i] * o[i];
            float* q = X1 + (size_t)row * D + col;
            *(f32x4*)q = (f32x4){o[0], o[1], o[2], o[3]}; *(f32x4*)(q + 4) = (f32x4){o[4], o[5], o[6], o[7]};
            u32x2 q8; q8.x = pk4_fp8(clamp8(o[0] * SC_X), clamp8(o[1] * SC_X), clamp8(o[2] * SC_X), clamp8(o[3] * SC_X)); q8.y = pk4_fp8(clamp8(o[4] * SC_X), clamp8(o[5] * SC_X), clamp8(o[6] * SC_X), clamp8(o[7] * SC_X));
            *(u32x2*)(X18 + (size_t)row * D + col) = q8;
        }
        ss += __shfl_xor(ss, 16); ss += __shfl_xor(ss, 32);
        if ((lane_id() >> 4) == 0) SS1[(size_t)row * 32 + u.pn * 4 + (lc >> 5)] = ss;
    }
};
struct ESwiglu {
    unsigned char* ACT; const float* rowrs; const float* bgu;
    DI void store(const Unit& u, int row, int lc, const float (&v0)[8], const float (&v1)[8]) const {
        const float rs = rowrs[row] * (1.f / (SC_X * SC_WGU));
        const int j = u.pn * 128 + lc; float o[8];
        const float* ba = bgu + (size_t)u.e * 4096 + j; const float* bu = ba + 2048;
#pragma unroll
        for (int i = 0; i < 8; ++i) {
            float a = rs * v0[i] + ba[i], uu = rs * v1[i] + bu[i];
            a = fminf(a, 7.f); uu = fminf(fmaxf(uu, -7.f), 7.f);
            o[i] = clamp8((uu + 1.f) * a * sigm(1.702f * a) * SC_ACT);
        }
        u32x2 q8; q8.x = pk4_fp8(o[0], o[1], o[2], o[3]); q8.y = pk4_fp8(o[4], o[5], o[6], o[7]);
        *(u32x2*)(ACT + (size_t)row * DFF + j) = q8;
    }
};
struct EDown {
    bf16* YB; const float* rowg; const float* bdn;
    DI void store(const Unit& u, int row, int lc, const float (&v0)[8], const float (&v1)[8]) const {
        const float g = rowg[row];
#pragma unroll
        for (int bj = 0; bj < 2; ++bj) {
            const int col = u.pn * 256 + bj * 128 + lc; float o[8];
            const float* b = bdn + (size_t)u.e * D + col;
#pragma unroll
            for (int i = 0; i < 8; ++i) o[i] = ((bj ? v1[i] : v0[i]) * (1.f / (SC_ACT * SC_WDN)) + b[i]) * g;
            *(u32x4*)(YB + (size_t)row * D + col) = pack8(o);
        }
    }
};
struct EPw {
    bf16* PW;
    DI void store(const Unit& u, int row, int lc, const float (&v0)[8], const float (&v1)[8]) const {
        *(u32x4*)(PW + (size_t)row * D + u.pn * 256 + lc) = pack8(v0);
        *(u32x4*)(PW + (size_t)row * D + u.pn * 256 + 128 + lc) = pack8(v1);
    }
};
struct EGate {
    const float* X2; const bf16* PW; const float* rs2; float* out; float* SS3;
    DI void store(const Unit& u, int row, int lc, const float (&v0)[8], const float (&v1)[8]) const {
        const float rs = rs2[row]; float ss = 0.f;
#pragma unroll
        for (int bj = 0; bj < 2; ++bj) {
            const int col = u.pn * 256 + bj * 128 + lc; float pw[8], o[8];
            unpack8(*(const u32x4*)(PW + (size_t)row * D + col), pw);
            const float* p = X2 + (size_t)row * D + col;
            const f32x4 a = *(const f32x4*)p, b = *(const f32x4*)(p + 4);
#pragma unroll
            for (int i = 0; i < 4; ++i) { o[i] = a[i] + pw[i] * sigm(rs * (bj ? v1[i] : v0[i])); o[4 + i] = b[i] + pw[4 + i] * sigm(rs * (bj ? v1[4 + i] : v0[4 + i])); }
#pragma unroll
            for (int i = 0; i < 8; ++i) ss += o[i] * o[i];
            float* q = out + (size_t)row * D + col;
            *(f32x4*)q = (f32x4){o[0], o[1], o[2], o[3]}; *(f32x4*)(q + 4) = (f32x4){o[4], o[5], o[6], o[7]};
        }
        ss += __shfl_xor(ss, 16); ss += __shfl_xor(ss, 32);
        if ((lane_id() >> 4) == 0) SS3[(size_t)row * 32 + u.pn * 4 + (lc >> 5)] = ss;
    }
};

struct Args {
    const float* in[25]; float* out; unsigned char* ws; int ph_lo, ph_hi;
};
enum { I_X = 0, I_P, I_NORM_MIX, I_W_IN, I_HGRN_LB, I_HGRN_NORM, I_CONV_W, I_CONV_B, I_B_I, I_B_F, I_MLSTM_NORM, I_W_BRA, I_W_BRB, I_W_OUT, I_NORM_MOE,
       I_ROUTER_W, I_ROUTER_B, I_W_GU, I_B_GU, I_W_DN, I_B_DN, I_NORM_PLE, I_W_PLE, I_W_PLE_GATE, I_NORM_FINAL };

struct Frame {
    LAS unsigned char* lds; int wave, G, bid;
    const float* const* in; float* out; unsigned char* ws;
    template <class Tp> DI Tp* p(size_t off) const { return (Tp*)(ws + off); }
};

constexpr int LDS_BYTES = 147456;
constexpr int LDS_MISC = 131072;

DI void tr_tile(const float* __restrict__ W, size_t ldw, int k0, int sc0, const float* __restrict__ kscale, bf16* __restrict__ dst, size_t drow0, int ldd, LAS unsigned* scr, int lane) {
    const int a = lane & 15, b = lane >> 4;
    f32x4 v[16];
#pragma unroll
    for (int i = 0; i < 8; ++i) {
        const int k = k0 + 8 * i + 2 * b;
        v[2 * i] = *(const f32x4*)(W + (size_t)k * ldw + sc0 + 4 * a);
        v[2 * i + 1] = *(const f32x4*)(W + (size_t)(k + 1) * ldw + sc0 + 4 * a);
    }
#pragma unroll
    for (int i = 0; i < 8; ++i) {
        const int k = k0 + 8 * i + 2 * b;
        float s0 = 1.f, s1 = 1.f; if (kscale) { s0 = kscale[k]; s1 = kscale[k + 1]; }
#pragma unroll
        for (int c = 0; c < 4; ++c) scr[(4 * a + c) * 33 + 4 * i + b] = pk2(v[2 * i][c] * s0, v[2 * i + 1][c] * s1);
    }
    asm volatile("s_waitcnt lgkmcnt(0)" ::: "memory");
#pragma unroll
    for (int j = 0; j < 8; ++j) {
        const int n = (lane >> 3) + 8 * j, kc = lane & 7;
        u32x4 o; o.x = scr[n * 33 + 4 * kc]; o.y = scr[n * 33 + 4 * kc + 1]; o.z = scr[n * 33 + 4 * kc + 2]; o.w = scr[n * 33 + 4 * kc + 3];
        *(u32x4*)(dst + (drow0 + n) * (size_t)ldd + k0 + 8 * kc) = o;
    }
    asm volatile("s_waitcnt lgkmcnt(0)" ::: "memory");
}

DI void tr_tile8(const float* __restrict__ W, size_t ldw, int k0, int sc0, const float* __restrict__ kscale, float wscale, unsigned char* __restrict__ dst, size_t drow0, int ldd, LAS unsigned* scr, int lane) {
    const int a = lane & 15, b = lane >> 4;
    f32x4 v[16];
#pragma unroll
    for (int i = 0; i < 4; ++i)
#pragma unroll
        for (int r = 0; r < 4; ++r) v[4 * i + r] = *(const f32x4*)(W + (size_t)(k0 + 16 * i + 4 * b + r) * ldw + sc0 + 4 * a);
#pragma unroll
    for (int i = 0; i < 4; ++i) {
        const int k = k0 + 16 * i + 4 * b;
        float s0 = wscale, s1 = wscale, s2 = wscale, s3 = wscale; if (kscale) { s0 *= kscale[k]; s1 *= kscale[k + 1]; s2 *= kscale[k + 2]; s3 *= kscale[k + 3]; }
#pragma unroll
        for (int c = 0; c < 4; ++c) scr[(4 * a + c) * 17 + 4 * i + b] = pk4_fp8(v[4 * i][c] * s0, v[4 * i + 1][c] * s1, v[4 * i + 2][c] * s2, v[4 * i + 3][c] * s3);
    }
    asm volatile("s_waitcnt lgkmcnt(0)" ::: "memory");
#pragma unroll
    for (int j = 0; j < 4; ++j) {
        const int n = (lane >> 2) + 16 * j, kc = lane & 3;
        u32x4 o; o.x = scr[n * 17 + 4 * kc]; o.y = scr[n * 17 + 4 * kc + 1]; o.z = scr[n * 17 + 4 * kc + 2]; o.w = scr[n * 17 + 4 * kc + 3];
        *(u32x4*)(dst + (drow0 + n) * (size_t)ldd + k0 + 16 * kc) = o;
    }
    asm volatile("s_waitcnt lgkmcnt(0)" ::: "memory");
}

DI void p0_prologue(const Frame& F) {
    const int lane = lane_id(), wave = F.wave, tid = wave * 64 + lane;
    const int gw = F.bid * 8 + wave, NGW = F.G * 8;
    {
        LAS unsigned* scr = (LAS unsigned*)(F.lds + wave * 8704);
        constexpr int TI_WIN = 32 * 176, TI_WA = 16 * 32, TI_WB = 16 * 32, TI_WOUT = 32 * 32, TI_WPG = 32 * 32, TI_WPLE = 4 * 32, TI_WGU = 32 * 2048, TI_WDN = 32 * 1024;
        constexpr int NTI = TI_WIN + TI_WA + TI_WB + TI_WOUT + TI_WPG + TI_WPLE + TI_WGU + TI_WDN;
        for (int it = gw; it < NTI; it += NGW) {
            int r = it;
            if (r < TI_WIN) { const int kb = r / 176, nb = r % 176, n0 = 64 * nb, sc0 = n0 < 6144 ? n0 : n0 + 8;
                tr_tile(F.in[I_W_IN], INCOLS, 64 * kb, sc0, F.in[I_NORM_MIX], F.p<bf16>(O_WIN), n0, D, scr, lane); continue; } r -= TI_WIN;
            if (r < TI_WA) { const int kb = r / 32, nb = r % 32; tr_tile(F.in[I_W_BRA], D, 64 * kb, 64 * nb, nullptr, F.p<bf16>(O_WA), 64 * nb, 1024, scr, lane); continue; } r -= TI_WA;
            if (r < TI_WB) { const int kb = r / 32, nb = r % 32; tr_tile(F.in[I_W_BRB], D, 64 * kb, 64 * nb, nullptr, F.p<bf16>(O_WB), 64 * nb, 1024, scr, lane); continue; } r -= TI_WB;
            if (r < TI_WOUT) { const int kb = r / 32, nb = r % 32; tr_tile(F.in[I_W_OUT], D, 64 * kb, 64 * nb, nullptr, F.p<bf16>(O_WOUT), 64 * nb, D, scr, lane); continue; } r -= TI_WOUT;
            if (r < TI_WPG) { const int kb = r / 32, nb = r % 32; tr_tile(F.in[I_W_PLE_GATE], D, 64 * kb, 64 * nb, F.in[I_NORM_PLE], F.p<bf16>(O_WPG), 64 * nb, D, scr, lane); continue; } r -= TI_WPG;
            if (r < TI_WPLE) { const int kb = r / 32, nb = r % 32; tr_tile(F.in[I_W_PLE], D, 64 * kb, 64 * nb, nullptr, F.p<bf16>(O_WPLE), 64 * nb, PLE, scr, lane); continue; } r -= TI_WPLE;
            if (r < TI_WGU) { const int e = r / 2048, rr = r % 2048, kb = rr / 64, nb = rr % 64, c0 = 64 * nb, j0 = c0 & 2047, part = c0 >> 11;
                tr_tile8(F.in[I_W_GU] + (size_t)e * D * 4096, 4096, 64 * kb, c0, F.in[I_NORM_MOE], SC_WGU, F.p<unsigned char>(O_WGU), (size_t)e * 4096 + (j0 >> 7) * 256 + part * 128 + (j0 & 127), D, scr, lane); continue; } r -= TI_WGU;
            { const int e = r / 1024, rr = r % 1024, kb = rr / 32, nb = rr % 32;
                tr_tile8(F.in[I_W_DN] + (size_t)e * DFF * D, D, 64 * kb, 64 * nb, nullptr, SC_WDN, F.p<unsigned char>(O_WDN), (size_t)e * D + 64 * nb, DFF, scr, lane); }
        }
    }
    __syncthreads();
    LAS float* W8 = (LAS float*)F.lds;
    for (int idx = tid; idx < 8 * D; idx += 512) { const int k = idx >> 3, j = idx & 7; W8[j * D + k] = F.in[I_W_IN][(size_t)k * INCOLS + 6144 + j] * F.in[I_NORM_MIX][k]; }
    __syncthreads();
    {
        const float* x = F.in[I_X]; bf16* XB = F.p<bf16>(O_XB); float* RS0 = F.p<float>(O_RS0); float* GT = F.p<float>(O_GATES);
        for (int m = gw; m < T; m += NGW) {
            const f32x4* xr = (const f32x4*)(x + (size_t)m * D) + lane;
            f32x4 v[8]; float ss = 0.f;
#pragma unroll
            for (int j = 0; j < 8; ++j) { v[j] = xr[64 * j]; ss += (v[j].x * v[j].x + v[j].y * v[j].y) + (v[j].z * v[j].z + v[j].w * v[j].w); }
            ss = wave_sum(ss);
            const float rstd = rsqrtf(ss * (1.f / D) + EPS);
            u32x2* o = (u32x2*)(XB + (size_t)m * D) + lane;
#pragma unroll
            for (int j = 0; j < 8; ++j) { u32x2 w; w.x = pk2(v[j].x, v[j].y); w.y = pk2(v[j].z, v[j].w); o[64 * j] = w; }
            float g[8];
#pragma unroll
            for (int jj = 0; jj < 8; ++jj) { float a = 0.f;
#pragma unroll
                for (int j = 0; j < 8; ++j) { const f32x4 w = *(const LAS f32x4*)(W8 + jj * D + 4 * (lane + 64 * j)); a += (v[j].x * w.x + v[j].y * w.y) + (v[j].z * w.z + v[j].w * w.w); }
                g[jj] = wave_sum(a); }
            if (lane == 0) { RS0[m] = rstd;
#pragma unroll
                for (int jj = 0; jj < 8; ++jj) GT[(size_t)m * 8 + jj] = rstd * g[jj] + (jj < 4 ? F.in[I_B_I][jj] : F.in[I_B_F][jj - 4]); }
        }
    }
    {
        const f32x4* p4 = (const f32x4*)F.in[I_P]; u32x2* o = (u32x2*)F.p<bf16>(O_PB);
        for (size_t i = (size_t)F.bid * 512 + tid; i < (size_t)T * PLE / 4; i += (size_t)F.G * 512) { const f32x4 v = p4[i]; u32x2 w; w.x = pk2(v.x, v.y); w.y = pk2(v.z, v.w); o[i] = w; }
    }
    {
        float* RWG = F.p<float>(O_RWG);
        for (int i = F.bid * 512 + tid; i < D * NE; i += F.G * 512) RWG[i] = F.in[I_ROUTER_W][i] * F.in[I_NORM_MOE][i >> 5];
    }
    __syncthreads();
}

DI void p7_route(const Frame& F) {
    LAS float* LG = (LAS float*)F.lds;
    LAS float* RSL = (LAS float*)(F.lds + 2 * 128 * 33 * 4);
    LAS int* HL = (LAS int*)(F.lds + 2 * 128 * 33 * 4 + 512);
    const float* X1 = F.p<float>(O_X1); const float* SS1 = F.p<float>(O_SS1); const float* RWG = F.p<float>(O_RWG);
    float* RS1 = F.p<float>(O_RS1); int* TOPE = F.p<int>(O_TOPE); float* TOPG = F.p<float>(O_TOPG); int* HIST = F.p<int>(O_HIST);
    const int lane = lane_id(), w = F.wave, tid = w * 64 + lane;
    for (int tg = F.bid; tg < T / 128; tg += F.G) {
        const int t0 = tg * 128;
        if (tid < 128) { const f32x4* s = (const f32x4*)(SS1 + (size_t)(t0 + tid) * 32); float a = 0.f;
#pragma unroll
            for (int j = 0; j < 8; ++j) { const f32x4 q = s[j]; a += q.x; a += q.y; a += q.z; a += q.w; }
            const float rs = rsqrtf(a * (1.f / D) + EPS); RSL[tid] = rs; RS1[t0 + tid] = rs; }
        if (tid < 32) HL[tid] = 0;
        {
            const int g = w & 3, kh = w >> 2, m = lane & 31, hh = lane >> 5;
            const float* arow = X1 + (size_t)(t0 + 32 * g + m) * D + kh * 1024 + 4 * hh;
            const float* brow = RWG + (size_t)(kh * 1024 + 4 * hh) * 32 + m;
            f32x16 acc;
#pragma unroll
            for (int i = 0; i < 16; ++i) acc[i] = 0.f;
#pragma unroll 4
            for (int j = 0; j < 128; ++j) {
                const f32x4 a = *(const f32x4*)(arow + 8 * j);
                const float b0 = brow[(8 * j + 0) * 32], b1 = brow[(8 * j + 1) * 32], b2 = brow[(8 * j + 2) * 32], b3 = brow[(8 * j + 3) * 32];
                acc = __builtin_amdgcn_mfma_f32_32x32x2f32(a.x, b0, acc, 0, 0, 0);
                acc = __builtin_amdgcn_mfma_f32_32x32x2f32(a.y, b1, acc, 0, 0, 0);
                acc = __builtin_amdgcn_mfma_f32_32x32x2f32(a.z, b2, acc, 0, 0, 0);
                acc = __builtin_amdgcn_mfma_f32_32x32x2f32(a.w, b3, acc, 0, 0, 0);
            }
#pragma unroll
            for (int i = 0; i < 16; ++i) { const int tok = 32 * g + (i & 3) + 8 * (i >> 2) + 4 * hh; LG[(kh * 128 + tok) * 33 + m] = acc[i]; }
        }
        __syncthreads();
        if (tid < 128) {
            const int tt = tid; const float rs = RSL[tt];
            LAS float* l0 = LG + tt * 33; const LAS float* l1 = LG + (128 + tt) * 33;
            for (int e = 0; e < 32; ++e) l0[e] = rs * (l0[e] + l1[e]) + F.in[I_ROUTER_B][e];
            float tv[4]; int te[4];
#pragma unroll
            for (int k = 0; k < 4; ++k) { float bv = -3.0e38f; int be = 0;
                for (int e = 0; e < 32; ++e) { const float v = l0[e]; if (v > bv) { bv = v; be = e; } }
                tv[k] = bv; te[k] = be; l0[be] = -3.3e38f; }
            float ex[4], sum = 0.f;
#pragma unroll
            for (int k = 0; k < 4; ++k) { ex[k] = __expf(tv[k] - tv[0]); sum += ex[k]; }
            const float inv = 1.f / sum;
#pragma unroll
            for (int k = 0; k < 4; ++k) { TOPE[(size_t)(t0 + tt) * 4 + k] = te[k]; TOPG[(size_t)(t0 + tt) * 4 + k] = ex[k] * inv; __hip_atomic_fetch_add(&HL[te[k]], 1, __ATOMIC_RELAXED, __HIP_MEMORY_SCOPE_WORKGROUP); }
        }
        __syncthreads();
        if (tid < 32) HIST[tg * 32 + tid] = HL[tid];
        __syncthreads();
    }
}

DI void p8_rows(const Frame& F) {
    LAS int* PT = (LAS int*)F.lds;
    LAS int* PB = PT + 512;
    LAS int* TOT = PB + 512;
    LAS int* BASE = TOT + 32;
    LAS int* PST = BASE + 32;
    LAS int* WCNT = PST + 40;
    const int* HIST = F.p<int>(O_HIST); const int* TOPE = F.p<int>(O_TOPE); const float* TOPG = F.p<float>(O_TOPG); const float* RS1 = F.p<float>(O_RS1);
    int* ROWTOK = F.p<int>(O_ROWTOK); float* ROWG = F.p<float>(O_ROWG); float* ROWRS = F.p<float>(O_ROWRS); int* SLOT = F.p<int>(O_SLOT); int* BLKE = F.p<int>(O_BLKE);
    const int lane = lane_id(), w = F.wave, tid = w * 64 + lane;
    for (int tg = F.bid; tg < T / 128; tg += F.G) {
        const int t0 = tg * 128;
        { const int e = tid & 31, part = tid >> 5; int pt = 0, pb = 0;
          for (int ww = part * 16; ww < part * 16 + 16; ++ww) { const int h = HIST[ww * 32 + e]; pt += h; if (ww < tg) pb += h; }
          PT[part * 32 + e] = pt; PB[part * 32 + e] = pb; }
        __syncthreads();
        if (tid < 32) { int a = 0, b = 0; for (int q = 0; q < 16; ++q) { a += PT[q * 32 + tid]; b += PB[q * 32 + tid]; } TOT[tid] = a; BASE[tid] = b; }
        __syncthreads();
        if (tid == 0) { int s = 0; for (int e = 0; e < 32; ++e) { PST[e] = s; s += (TOT[e] + 255) & ~255; } PST[32] = s; }
        __syncthreads();
        const int i = tid, t = t0 + (i >> 2), k = i & 3;
        const int ei = TOPE[(size_t)t * 4 + k];
        int lrank = 0, mycnt = 0;
        for (int e = 0; e < 32; ++e) { const unsigned long long mk = __ballot(ei == e); if (ei == e) lrank = __popcll(mk & ((1ull << lane) - 1ull)); if (lane == e) mycnt = __popcll(mk); }
        if (lane < 32) WCNT[w * 32 + lane] = mycnt;
        __syncthreads();
        int woff = 0; for (int ww = 0; ww < w; ++ww) woff += WCNT[ww * 32 + ei];
        const int row = PST[ei] + BASE[ei] + woff + lrank;
        ROWTOK[row] = t; ROWG[row] = TOPG[(size_t)t * 4 + k]; ROWRS[row] = RS1[t]; SLOT[(size_t)t * 4 + k] = row;
        if (tg < 32) { const int e = tg, padded = (TOT[e] + 255) & ~255; for (int r = TOT[e] + tid; r < padded; r += 512) { ROWTOK[PST[e] + r] = 0; ROWG[PST[e] + r] = 0.f; ROWRS[PST[e] + r] = 0.f; } }
        if (tg == 0) { for (int j = tid; j < NBMAX; j += 512) { int e = 31; for (int q = 0; q < 32; ++q) if (j * 256 >= PST[q] && j * 256 < PST[q + 1]) e = q; BLKE[j] = e; }
            if (tid == 0) BLKE[NBMAX] = PST[32] >> 8; }
        __syncthreads();
    }
}

DI void p11_combine(const Frame& F) {
    const float* X1 = F.p<float>(O_X1); const bf16* YB = F.p<bf16>(O_YBUF); const int* SLOT = F.p<int>(O_SLOT);
    float* X2 = F.p<float>(O_X2); bf16* X2B = F.p<bf16>(O_X2B); float* RS2 = F.p<float>(O_RS2);
    const int lane = lane_id(), gw = F.bid * 8 + F.wave, NGW = F.G * 8;
    for (int t = gw; t < T; t += NGW) {
        const int r0 = SLOT[(size_t)t * 4], r1 = SLOT[(size_t)t * 4 + 1], r2 = SLOT[(size_t)t * 4 + 2], r3 = SLOT[(size_t)t * 4 + 3];
        const f32x4* xr = (const f32x4*)(X1 + (size_t)t * D) + lane;
        const u32x2* y0 = (const u32x2*)(YB + (size_t)r0 * D) + lane; const u32x2* y1 = (const u32x2*)(YB + (size_t)r1 * D) + lane;
        const u32x2* y2 = (const u32x2*)(YB + (size_t)r2 * D) + lane; const u32x2* y3 = (const u32x2*)(YB + (size_t)r3 * D) + lane;
        f32x4* xo = (f32x4*)(X2 + (size_t)t * D) + lane; u32x2* bo = (u32x2*)(X2B + (size_t)t * D) + lane;
        float ss = 0.f;
#pragma unroll
        for (int j = 0; j < 8; ++j) {
            f32x4 v = xr[64 * j];
            const u32x2 a = y0[64 * j], b = y1[64 * j], c = y2[64 * j], d = y3[64 * j];
            f32x4 s;
            s.x = ((bf2f(a.x & 0xffffu) + bf2f(b.x & 0xffffu)) + bf2f(c.x & 0xffffu)) + bf2f(d.x & 0xffffu);
            s.y = ((bf2f(a.x >> 16) + bf2f(b.x >> 16)) + bf2f(c.x >> 16)) + bf2f(d.x >> 16);
            s.z = ((bf2f(a.y & 0xffffu) + bf2f(b.y & 0xffffu)) + bf2f(c.y & 0xffffu)) + bf2f(d.y & 0xffffu);
            s.w = ((bf2f(a.y >> 16) + bf2f(b.y >> 16)) + bf2f(c.y >> 16)) + bf2f(d.y >> 16);
            v = v + s;
            ss += (v.x * v.x + v.y * v.y) + (v.z * v.z + v.w * v.w);
            xo[64 * j] = v; u32x2 wv; wv.x = pk2(v.x, v.y); wv.y = pk2(v.z, v.w); bo[64 * j] = wv;
        }
        ss = wave_sum(ss);
        if (lane == 0) RS2[t] = rsqrtf(ss * (1.f / D) + EPS);
    }
}

DI void p13_final(const Frame& F) {
    const float* SS3 = F.p<float>(O_SS3); const float* g = F.in[I_NORM_FINAL];
    const int lane = lane_id(), gw = F.bid * 8 + F.wave, NGW = F.G * 8;
    for (int t = gw; t < T; t += NGW) {
        float a = lane < 32 ? SS3[(size_t)t * 32 + lane] : 0.f; a = wave_sum(a);
        const float rstd = rsqrtf(a * (1.f / D) + EPS);
        f32x4* o = (f32x4*)(F.out + (size_t)t * D) + lane; const f32x4* g4 = (const f32x4*)g + lane;
#pragma unroll
        for (int j = 0; j < 8; ++j) { f32x4 v = o[64 * j]; const f32x4 gg = g4[64 * j]; v.x *= rstd * gg.x; v.y *= rstd * gg.y; v.z *= rstd * gg.z; v.w *= rstd * gg.w; o[64 * j] = v; }
    }
}


DI bf16x8 fragL(const LAS bf16* base, int pitch, int row, int k) { return *(const LAS bf16x8*)(base + row * pitch + k); }
DI bf16x8 fragG(const bf16* base, int pitch, int row, int k) { return *(const bf16x8*)(base + (size_t)row * pitch + k); }
DI int prow(int i, int nf) { return 8 * (i >> 2) + 4 * nf + (i & 3); }
#define MFMA16(b, a, c) __builtin_amdgcn_mfma_f32_16x16x32_bf16((b), (a), (c), 0, 0, 0)
DI float incl_scan_add(float v, int lane) {
#pragma unroll
    for (int o = 1; o < 64; o <<= 1) { const float t = __shfl_up(v, o); if (lane >= o) v += t; }
    return v;
}
DI float incl_scan_max(float v, int lane) {
#pragma unroll
    for (int o = 1; o < 64; o <<= 1) { const float t = __shfl_up(v, o); if (lane >= o) v = fmaxf(v, t); }
    return v;
}
DI void store16bf(LAS bf16* p, const float (&v)[16]) {
    u32x4 a, b; a.x = pk2c(v[0], v[1]); a.y = pk2c(v[2], v[3]); a.z = pk2c(v[4], v[5]); a.w = pk2c(v[6], v[7]);
    b.x = pk2c(v[8], v[9]); b.y = pk2c(v[10], v[11]); b.z = pk2c(v[12], v[13]); b.w = pk2c(v[14], v[15]);
    *(LAS u32x4*)p = a; *(LAS u32x4*)(p + 8) = b;
}
constexpr int PK = 72, PD = 136;

DI void hgrn_a_item(const Frame& F, int it, int lane, int w, int tid) {
    const int h = it & 7; const size_t t0 = (size_t)(it >> 3) * 64;
    LAS bf16* KT = (LAS bf16*)F.lds; LAS bf16* VT = KT + 128 * PK; LAS float* SEGT = (LAS float*)(VT + 128 * PK);
    const bf16* Z = F.p<bf16>(O_Z); const float* LF = F.p<float>(O_LF);
    const int c = tid & 127, seg = tid >> 7;
    float cs[16]; float run = 0.f;
#pragma unroll
    for (int i = 0; i < 16; ++i) { run += LF[(t0 + 16 * seg + i) * 1024 + h * 128 + c]; cs[i] = run; }
    SEGT[seg * 128 + c] = run;
    float kk[16], vv[16];
#pragma unroll
    for (int i = 0; i < 16; ++i) { kk[i] = bf2f(Z[(t0 + 16 * seg + i) * NZ + ZKA + h * 128 + c]); vv[i] = bf2f(Z[(t0 + 16 * seg + i) * NZ + ZVA + h * 128 + c]); }
    __syncthreads();
    float pre = 0.f, tot = 0.f;
#pragma unroll
    for (int q = 0; q < 4; ++q) { const float v = SEGT[q * 128 + c]; tot += v; if (q < seg) pre += v; }
#pragma unroll
    for (int i = 0; i < 16; ++i) kk[i] *= __expf(tot - (pre + cs[i]));
    store16bf(KT + c * PK + 16 * seg, kk); store16bf(VT + c * PK + 16 * seg, vv);
    if (seg == 0) F.p<float>(O_DEC)[(size_t)it * 128 + c] = __expf(tot);
    __syncthreads();
    const int fr = lane & 15, fq = lane >> 4, e0 = 16 * w;
    f32x4 acc[8];
#pragma unroll
    for (int i = 0; i < 8; ++i) acc[i] = (f32x4){0.f, 0.f, 0.f, 0.f};
#pragma unroll
    for (int ks = 0; ks < 2; ++ks) {
        const bf16x8 a = fragL(VT, PK, e0 + fr, 32 * ks + 8 * fq);
#pragma unroll
        for (int p = 0; p < 4; ++p)
#pragma unroll
            for (int nf = 0; nf < 2; ++nf) { const bf16x8 b = fragL(KT, PK, 32 * p + prow(fr, nf), 32 * ks + 8 * fq); acc[2 * p + nf] = MFMA16(b, a, acc[2 * p + nf]); }
    }
    bf16* U = F.p<bf16>(O_UST) + ((size_t)it * 128 + e0 + fr) * 128 + 8 * fq;
#pragma unroll
    for (int p = 0; p < 4; ++p) { const float o[8] = {acc[2 * p][0], acc[2 * p][1], acc[2 * p][2], acc[2 * p][3], acc[2 * p + 1][0], acc[2 * p + 1][1], acc[2 * p + 1][2], acc[2 * p + 1][3]}; *(u32x4*)(U + 32 * p) = pack8c(o); }
    __syncthreads();
}

DI void conv16(const bf16* Z, size_t t0, int s0  , int ch, const float* cw, const float* cb, float (&o)[16]) {
    const float w0 = cw[ch], w1 = cw[1024 + ch], w2 = cw[2048 + ch], w3 = cw[3072 + ch], b = cb[ch];
    float u0 = s0 >= 3 ? bf2f(Z[(t0 - 3) * NZ + ZQK + ch]) : 0.f, u1 = s0 >= 2 ? bf2f(Z[(t0 - 2) * NZ + ZQK + ch]) : 0.f, u2 = s0 >= 1 ? bf2f(Z[(t0 - 1) * NZ + ZQK + ch]) : 0.f;
#pragma unroll
    for (int i = 0; i < 16; ++i) { const float u3 = bf2f(Z[(t0 + i) * NZ + ZQK + ch]); const float cv = b + u0 * w0 + u1 * w1 + u2 * w2 + u3 * w3; o[i] = cv * sigm(cv); u0 = u1; u1 = u2; u2 = u3; }
}

DI void mlstm_a_item(const Frame& F, int it, int lane, int w, int tid) {
    const int h = it & 3, bn = it >> 2, n = bn & 127; const size_t t0 = (size_t)bn * 64;
    LAS bf16* KT = (LAS bf16*)F.lds; LAS bf16* VT = KT + 128 * PK; LAS float* NP = (LAS float*)(VT + 256 * PK); LAS float* WE = NP + 512;
    const bf16* Z = F.p<bf16>(O_Z); const float* GT = F.p<float>(O_GATES);
    {
        const float ip = GT[(t0 + lane) * 8 + h], lf = log_sigmoid(GT[(t0 + lane) * 8 + 4 + h]);
        const float fc = incl_scan_add(lf, lane), gt = __shfl(fc, 63);
        const float ae = gt - fc + ip, ml = wave_max(ae);
        if (w == 0) { WE[lane] = __expf(ae - ml); if (lane == 0) { F.p<float>(O_MLOC)[it] = ml; F.p<float>(O_GTOT)[it] = gt; } }
    }
    const int d = tid & 127, seg = tid >> 7;
    float kk[16];
    conv16(Z, t0 + 16 * seg, n * 64 + 16 * seg, 512 + h * 128 + d, F.in[I_CONV_W], F.in[I_CONV_B], kk);
    const int ev = tid & 255, hv = tid >> 8;
    float v0[16], v1[16];
#pragma unroll
    for (int i = 0; i < 16; ++i) { v0[i] = bf2f(Z[(t0 + 32 * hv + i) * NZ + ZVB + h * 256 + ev]); v1[i] = bf2f(Z[(t0 + 32 * hv + 16 + i) * NZ + ZVB + h * 256 + ev]); }
    __syncthreads();
    float np = 0.f;
#pragma unroll
    for (int i = 0; i < 16; ++i) { kk[i] *= 0.08838834764831845f * WE[16 * seg + i]; np += kk[i]; }
    NP[seg * 128 + d] = np;
    store16bf(KT + d * PK + 16 * seg, kk); store16bf(VT + ev * PK + 32 * hv, v0); store16bf(VT + ev * PK + 32 * hv + 16, v1);
    __syncthreads();
    if (tid < 128) F.p<float>(O_NL)[(size_t)it * 128 + tid] = (NP[tid] + NP[128 + tid]) + (NP[256 + tid] + NP[384 + tid]);
    const int fr = lane & 15, fq = lane >> 4;
    f32x4 acc[2][8];
#pragma unroll
    for (int m = 0; m < 2; ++m)
#pragma unroll
        for (int i = 0; i < 8; ++i) acc[m][i] = (f32x4){0.f, 0.f, 0.f, 0.f};
#pragma unroll
    for (int ks = 0; ks < 2; ++ks) {
        const bf16x8 a0 = fragL(VT, PK, 32 * w + fr, 32 * ks + 8 * fq), a1 = fragL(VT, PK, 32 * w + 16 + fr, 32 * ks + 8 * fq);
#pragma unroll
        for (int p = 0; p < 4; ++p)
#pragma unroll
            for (int nf = 0; nf < 2; ++nf) { const bf16x8 b = fragL(KT, PK, 32 * p + prow(fr, nf), 32 * ks + 8 * fq); acc[0][2 * p + nf] = MFMA16(b, a0, acc[0][2 * p + nf]); acc[1][2 * p + nf] = MFMA16(b, a1, acc[1][2 * p + nf]); }
    }
#pragma unroll
    for (int m = 0; m < 2; ++m) {
        bf16* Cp = F.p<bf16>(O_CT) + ((size_t)it * 256 + 32 * w + 16 * m + fr) * 128 + 8 * fq;
#pragma unroll
        for (int p = 0; p < 4; ++p) { const float o[8] = {acc[m][2 * p][0], acc[m][2 * p][1], acc[m][2 * p][2], acc[m][2 * p][3], acc[m][2 * p + 1][0], acc[m][2 * p + 1][1], acc[m][2 * p + 1][2], acc[m][2 * p + 1][3]}; *(u32x4*)(Cp + 32 * p) = pack8c(o); }
    }
    __syncthreads();
}

DI void scan_phase(const Frame& F) {
    const int lane = lane_id(), tid = F.wave * 64 + lane;
    for (int g = F.bid * 512 + tid; g < 131072; g += F.G * 512) {
        {
            const int c4 = g & 31, e = (g >> 5) & 127, bh = g >> 12, b = bh >> 3, h = bh & 7;
            float S0 = 0.f, S1 = 0.f, S2 = 0.f, S3 = 0.f;
            bf16* U = F.p<bf16>(O_UST); const float* DC = F.p<float>(O_DEC);
#pragma unroll 4
            for (int n = 0; n < 128; ++n) {
                const size_t it = (size_t)(b * 128 + n) * 8 + h;
                u32x2* p = (u32x2*)(U + (it * 128 + e) * 128 + c4 * 4);
                const f32x4 dc = *(const f32x4*)(DC + it * 128 + c4 * 4);
                const u32x2 uu = *p;
                u32x2 o; o.x = pk2c(S0, S1); o.y = pk2c(S2, S3); *p = o;
                S0 = dc.x * S0 + bf2f(uu.x & 0xffffu); S1 = dc.y * S1 + bf2f(uu.x >> 16); S2 = dc.z * S2 + bf2f(uu.y & 0xffffu); S3 = dc.w * S3 + bf2f(uu.y >> 16);
            }
        }
        {
            const int d4 = g & 31, e = (g >> 5) & 255, bh = g >> 13, b = bh >> 2, h = bh & 3;
            float C0 = 0.f, C1 = 0.f, C2 = 0.f, C3 = 0.f, mrun = -1e30f; f32x4 nn = (f32x4){0.f, 0.f, 0.f, 0.f};
            bf16* CT = F.p<bf16>(O_CT); float* NL = F.p<float>(O_NL); const float* GTOT = F.p<float>(O_GTOT); const float* MLOC = F.p<float>(O_MLOC); float* MST = F.p<float>(O_MST);
#pragma unroll 4
            for (int n = 0; n < 128; ++n) {
                const size_t it = (size_t)(b * 128 + n) * 4 + h;
                const float gt = GTOT[it], ml = MLOC[it];
                const float mnew = fmaxf(gt + mrun, ml), sp = __expf(gt + mrun - mnew), sl = __expf(ml - mnew);
                u32x2* p = (u32x2*)(CT + (it * 256 + e) * 128 + d4 * 4);
                const u32x2 cl = *p;
                u32x2 o; o.x = pk2c(C0, C1); o.y = pk2c(C2, C3); *p = o;
                C0 = sp * C0 + sl * bf2f(cl.x & 0xffffu); C1 = sp * C1 + sl * bf2f(cl.x >> 16); C2 = sp * C2 + sl * bf2f(cl.y & 0xffffu); C3 = sp * C3 + sl * bf2f(cl.y >> 16);
                if (e == 0) { f32x4* q = (f32x4*)(NL + it * 128 + d4 * 4); const f32x4 nl = *q; *q = nn; nn = sp * nn + sl * nl; if (d4 == 0) MST[it] = mrun; }
                mrun = mnew;
            }
        }
    }
}

DI void hgrn_c_item(const Frame& F, int it, int lane, int w, int tid) {
    const int h = it & 7; const size_t t0 = (size_t)(it >> 3) * 64;
    LAS bf16* Qs = (LAS bf16*)F.lds; LAS bf16* Ks = Qs + 64 * PD; LAS bf16* Qh = Ks + 64 * PD; LAS bf16* VT = Qh + 64 * PD; LAS bf16* Pm = VT + 128 * PK;
    LAS float* SEGT = (LAS float*)(Pm + 64 * PK); LAS float* BREF = SEGT + 512; LAS float* RED = BREF + 128;
    const bf16* Z = F.p<bf16>(O_Z); const float* LF = F.p<float>(O_LF);
    const int c = tid & 127, seg = tid >> 7;
    float cs[16]; float run = 0.f;
#pragma unroll
    for (int i = 0; i < 16; ++i) { run += LF[(t0 + 16 * seg + i) * 1024 + h * 128 + c]; cs[i] = run; }
    SEGT[seg * 128 + c] = run;
    float qq[16], kk[16], vv[16];
#pragma unroll
    for (int i = 0; i < 16; ++i) { const size_t r = (t0 + 16 * seg + i) * NZ + h * 128 + c; qq[i] = bf2f(Z[r + ZQA]); kk[i] = bf2f(Z[r + ZKA]); vv[i] = bf2f(Z[r + ZVA]); }
    __syncthreads();
    float pre = 0.f;
#pragma unroll
    for (int q = 0; q < 4; ++q) { const float v = SEGT[q * 128 + c]; if (q < seg) pre += v; }
    if (seg == 2) BREF[c] = pre + cs[0];
    __syncthreads();
    const float bref = BREF[c];
#pragma unroll
    for (int i = 0; i < 16; ++i) {
        const float bc = pre + cs[i]; const int l = 16 * seg + i;
        Qs[l * PD + c] = (bf16)f2bf(qq[i] * __expf(bc - bref)); Ks[l * PD + c] = (bf16)f2bf(kk[i] * __expf(bref - bc)); Qh[l * PD + c] = (bf16)f2bf(qq[i] * __expf(bc));
    }
    store16bf(VT + c * PK + 16 * seg, vv);
    __syncthreads();
    const int fr = lane & 15, fq = lane >> 4, mf = w & 3, nh = w >> 2;
    {
        f32x4 sc[2] = {(f32x4){0.f, 0.f, 0.f, 0.f}, (f32x4){0.f, 0.f, 0.f, 0.f}};
#pragma unroll
        for (int ks = 0; ks < 4; ++ks) { const bf16x8 a = fragL(Qs, PD, 16 * mf + fr, 32 * ks + 8 * fq);
#pragma unroll
            for (int nf = 0; nf < 2; ++nf) { const bf16x8 b = fragL(Ks, PD, 32 * nh + prow(fr, nf), 32 * ks + 8 * fq); sc[nf] = MFMA16(b, a, sc[nf]); } }
        const int l = 16 * mf + fr, m0 = 32 * nh + 8 * fq; float o[8];
#pragma unroll
        for (int j = 0; j < 4; ++j) { o[j] = (m0 + j <= l) ? sc[0][j] : 0.f; o[4 + j] = (m0 + 4 + j <= l) ? sc[1][j] : 0.f; }
        *(LAS u32x4*)(Pm + l * PK + m0) = pack8c(o);
    }
    __syncthreads();
    f32x4 acc[4];
#pragma unroll
    for (int i = 0; i < 4; ++i) acc[i] = (f32x4){0.f, 0.f, 0.f, 0.f};
#pragma unroll
    for (int ks = 0; ks < 2; ++ks) { const bf16x8 a = fragL(Pm, PK, 16 * mf + fr, 32 * ks + 8 * fq);
#pragma unroll
        for (int p = 0; p < 2; ++p)
#pragma unroll
            for (int nf = 0; nf < 2; ++nf) { const bf16x8 b = fragL(VT, PK, 64 * nh + 32 * p + prow(fr, nf), 32 * ks + 8 * fq); acc[2 * p + nf] = MFMA16(b, a, acc[2 * p + nf]); } }
    const bf16* ST = F.p<bf16>(O_UST) + (size_t)it * 128 * 128;
#pragma unroll
    for (int ks = 0; ks < 4; ++ks) { const bf16x8 a = fragL(Qh, PD, 16 * mf + fr, 32 * ks + 8 * fq);
#pragma unroll
        for (int p = 0; p < 2; ++p)
#pragma unroll
            for (int nf = 0; nf < 2; ++nf) { const bf16x8 b = fragG(ST, 128, 64 * nh + 32 * p + prow(fr, nf), 32 * ks + 8 * fq); acc[2 * p + nf] = MFMA16(b, a, acc[2 * p + nf]); } }
    float ss = 0.f;
#pragma unroll
    for (int i = 0; i < 4; ++i) ss += (acc[i][0] * acc[i][0] + acc[i][1] * acc[i][1]) + (acc[i][2] * acc[i][2] + acc[i][3] * acc[i][3]);
    ss += __shfl_xor(ss, 16); ss += __shfl_xor(ss, 32);
    const int l = 16 * mf + fr;
    if (fq == 0) RED[nh * 64 + l] = ss;
    __syncthreads();
    const float rstd = rsqrtf((RED[l] + RED[64 + l]) * (1.f / 128.f) + EPS);
    const float* gn = F.in[I_HGRN_NORM] + h * 128;
#pragma unroll
    for (int p = 0; p < 2; ++p) {
        const int e = 64 * nh + 32 * p + 8 * fq; float ga[8], o[8];
        unpack8(*(const u32x4*)(Z + (t0 + l) * NZ + ZGA + h * 128 + e), ga);
#pragma unroll
        for (int j = 0; j < 4; ++j) { o[j] = acc[2 * p][j] * rstd * gn[e + j] * ga[j]; o[4 + j] = acc[2 * p + 1][j] * rstd * gn[e + 4 + j] * ga[4 + j]; }
        *(u32x4*)(F.p<bf16>(O_YA) + (t0 + l) * 1024 + h * 128 + e) = pack8c(o);
    }
    __syncthreads();
}

DI void mlstm_c_item(const Frame& F, int it, int lane, int w, int tid) {
    const int h = it & 3, bn = it >> 2, n = bn & 127; const size_t t0 = (size_t)bn * 64;
    LAS bf16* Qs = (LAS bf16*)F.lds; LAS bf16* Ks = Qs + 64 * PD; LAS bf16* VT = Ks + 64 * PD; LAS bf16* Pm = VT + 272 * PK; LAS bf16* NST = Pm + 64 * PK;
    LAS float* ROWV = (LAS float*)(NST + 16 * PD); LAS float* COLV = ROWV + 64; LAS float* WST = COLV + 64; LAS float* EINV = WST + 64; LAS float* RED = EINV + 64;
    const bf16* Z = F.p<bf16>(O_Z); const float* GT = F.p<float>(O_GATES);
    {
        const float ip = GT[(t0 + lane) * 8 + h], lf = log_sigmoid(GT[(t0 + lane) * 8 + 4 + h]);
        const float fc = incl_scan_add(lf, lane), mst = F.p<float>(O_MST)[it];
        const float cv = ip - fc, aint = fc + mst, dmax = fc + incl_scan_max(cv, lane), mt = fmaxf(dmax, aint);
        if (w == 0) { ROWV[lane] = fc - mt; COLV[lane] = cv; WST[lane] = __expf(aint - mt); EINV[lane] = __expf(-mt); }
    }
    const int d = tid & 127, seg = tid >> 7;
    {
        float qq[16], kk[16];
        conv16(Z, t0 + 16 * seg, n * 64 + 16 * seg, h * 128 + d, F.in[I_CONV_W], F.in[I_CONV_B], qq);
        conv16(Z, t0 + 16 * seg, n * 64 + 16 * seg, 512 + h * 128 + d, F.in[I_CONV_W], F.in[I_CONV_B], kk);
#pragma unroll
        for (int i = 0; i < 16; ++i) { const int l = 16 * seg + i; Qs[l * PD + d] = (bf16)f2bf(qq[i]); Ks[l * PD + d] = (bf16)f2bf(kk[i] * 0.08838834764831845f); }
    }
    {
        const int ev = tid & 255, hv = tid >> 8; float v0[16], v1[16];
#pragma unroll
        for (int i = 0; i < 16; ++i) { v0[i] = bf2f(Z[(t0 + 32 * hv + i) * NZ + ZVB + h * 256 + ev]); v1[i] = bf2f(Z[(t0 + 32 * hv + 16 + i) * NZ + ZVB + h * 256 + ev]); }
        store16bf(VT + ev * PK + 32 * hv, v0); store16bf(VT + ev * PK + 32 * hv + 16, v1);
        for (int i = tid; i < 16 * 64; i += 512) VT[(256 + (i >> 6)) * PK + (i & 63)] = (bf16)((i >> 6) == 0 ? 0x3f80 : 0);
        const float* NLp = F.p<float>(O_NL) + (size_t)it * 128;
        for (int i = tid; i < 16 * 128; i += 512) NST[(i >> 7) * PD + (i & 127)] = (bf16)((i >> 7) == 0 ? f2bf(NLp[i & 127]) : 0u);
    }
    __syncthreads();
    const int fr = lane & 15, fq = lane >> 4, mf = w & 3, nh = w >> 2, l = 16 * mf + fr;
    {
        f32x4 sc[2] = {(f32x4){0.f, 0.f, 0.f, 0.f}, (f32x4){0.f, 0.f, 0.f, 0.f}};
#pragma unroll
        for (int ks = 0; ks < 4; ++ks) { const bf16x8 a = fragL(Qs, PD, l, 32 * ks + 8 * fq);
#pragma unroll
            for (int nf = 0; nf < 2; ++nf) { const bf16x8 b = fragL(Ks, PD, 32 * nh + prow(fr, nf), 32 * ks + 8 * fq); sc[nf] = MFMA16(b, a, sc[nf]); } }
        const int m0 = 32 * nh + 8 * fq; const float rv = ROWV[l]; float o[8];
#pragma unroll
        for (int j = 0; j < 4; ++j) { o[j] = (m0 + j <= l) ? sc[0][j] * __expf(rv + COLV[m0 + j]) : 0.f; o[4 + j] = (m0 + 4 + j <= l) ? sc[1][j] * __expf(rv + COLV[m0 + 4 + j]) : 0.f; }
        *(LAS u32x4*)(Pm + l * PK + m0) = pack8c(o);
    }
    __syncthreads();
    f32x4 a1[8], a2[8], d1 = (f32x4){0.f, 0.f, 0.f, 0.f}, d2 = (f32x4){0.f, 0.f, 0.f, 0.f};
#pragma unroll
    for (int i = 0; i < 8; ++i) { a1[i] = (f32x4){0.f, 0.f, 0.f, 0.f}; a2[i] = (f32x4){0.f, 0.f, 0.f, 0.f}; }
#pragma unroll
    for (int ks = 0; ks < 2; ++ks) { const bf16x8 a = fragL(Pm, PK, l, 32 * ks + 8 * fq);
#pragma unroll
        for (int p = 0; p < 4; ++p)
#pragma unroll
            for (int nf = 0; nf < 2; ++nf) { const bf16x8 b = fragL(VT, PK, 128 * nh + 32 * p + prow(fr, nf), 32 * ks + 8 * fq); a1[2 * p + nf] = MFMA16(b, a, a1[2 * p + nf]); }
        d1 = MFMA16(fragL(VT, PK, 256 + fr, 32 * ks + 8 * fq), a, d1); }
    const bf16* CS = F.p<bf16>(O_CT) + (size_t)it * 256 * 128;
#pragma unroll
    for (int ks = 0; ks < 4; ++ks) { const bf16x8 a = fragL(Qs, PD, l, 32 * ks + 8 * fq);
#pragma unroll
        for (int p = 0; p < 4; ++p)
#pragma unroll
            for (int nf = 0; nf < 2; ++nf) { const bf16x8 b = fragG(CS, 128, 128 * nh + 32 * p + prow(fr, nf), 32 * ks + 8 * fq); a2[2 * p + nf] = MFMA16(b, a, a2[2 * p + nf]); }
        d2 = MFMA16(fragL(NST, PD, fr, 32 * ks + 8 * fq), a, d2); }
    const float ws = WST[l];
    float den = d1[0] + ws * d2[0];
    den = __shfl(den, fr);
    const float inv = 1.f / fmaxf(fabsf(den), EINV[l]);
    float ss = 0.f;
#pragma unroll
    for (int i = 0; i < 8; ++i) { a1[i] = (a1[i] + ws * a2[i]) * inv; ss += (a1[i][0] * a1[i][0] + a1[i][1] * a1[i][1]) + (a1[i][2] * a1[i][2] + a1[i][3] * a1[i][3]); }
    ss += __shfl_xor(ss, 16); ss += __shfl_xor(ss, 32);
    if (fq == 0) RED[nh * 64 + l] = ss;
    __syncthreads();
    const float rstd = rsqrtf((RED[l] + RED[64 + l]) * (1.f / 256.f) + EPS);
    const float* gn = F.in[I_MLSTM_NORM] + h * 256;
#pragma unroll
    for (int p = 0; p < 4; ++p) {
        const int e = 128 * nh + 32 * p + 8 * fq; float og[8], o[8];
        unpack8(*(const u32x4*)(Z + (t0 + l) * NZ + ZOB + h * 256 + e), og);
#pragma unroll
        for (int j = 0; j < 4; ++j) { o[j] = a1[2 * p][j] * rstd * gn[e + j] * og[j]; o[4 + j] = a1[2 * p + 1][j] * rstd * gn[e + 4 + j] * og[4 + j]; }
        *(u32x4*)(F.p<bf16>(O_YB) + (t0 + l) * 1024 + h * 256 + e) = pack8c(o);
    }
    __syncthreads();
}
DI void mix_a_phase(const Frame& F) {
    const int lane = lane_id(), w = F.wave, tid = w * 64 + lane;
    for (int it = F.bid; it < NITEM_A; it += F.G) hgrn_a_item(F, it, lane, w, tid);
    for (int it = F.bid; it < NITEM_B; it += F.G) mlstm_a_item(F, it, lane, w, tid);
}
DI void mix_c_phase(const Frame& F) {
    const int lane = lane_id(), w = F.wave, tid = w * 64 + lane;
    for (int it = F.bid; it < NITEM_A; it += F.G) hgrn_c_item(F, it, lane, w, tid);
    for (int it = F.bid; it < NITEM_B; it += F.G) mlstm_c_item(F, it, lane, w, tid);
}

enum { PH_PROLOGUE = 0, PH_INPROJ, PH_MIXA, PH_SCAN, PH_MIXC, PH_MIXPROJ, PH_WOUT, PH_ROUTE, PH_ROWS, PH_GU, PH_DN, PH_COMBINE, PH_GATE, PH_FINAL, PH_COUNT };

__global__ void __launch_bounds__(512, 2) fwd(Args args) {
    extern __shared__ __attribute__((aligned(16))) unsigned char lds_raw[];
    Frame F;
    F.lds = (LAS unsigned char*)lds_raw;
    F.wave = __builtin_amdgcn_readfirstlane((int)threadIdx.x >> 6); F.G = gridDim.x; F.bid = blockIdx.x;
    F.in = args.in; F.out = args.out; F.ws = args.ws;
    volatile LAS unsigned* misc = (volatile LAS unsigned*)(F.lds + LDS_MISC);
    if (threadIdx.x < 4) misc[threadIdx.x] = 0u;
    __syncthreads();
    const int lo = args.ph_lo, hi = args.ph_hi;
    const bool multi = (hi - lo) > 1;
    XcdBarrier bar; bar.bar = F.p<unsigned>(O_CTL) + CW_BAR; bar.x = 0; bar.st = misc;
    if (multi) bar = xcd_barrier_post(F.p<unsigned>(O_CTL) + CW_BAR, misc, threadIdx.x == 0);
#define IN(k) (lo <= (k) && (k) < hi)
#define REPS(k) for (int rep_ = 0; rep_ < 1 + ((k) == PROBE_PH ? PROBE_N : 0); ++rep_)
#define REPBAR(k) do { if ((k) == PROBE_PH && rep_ < PROBE_N) xcd_barrier(bar, F.wave == 0 && lane_id() == 0); } while (0)
#define SEAM(k) do { if (IN(k) && IN((k) + 1)) xcd_barrier(bar, F.wave == 0 && lane_id() == 0); } while (0)
    LAS unsigned char* ring = F.lds;

    if (IN(PH_PROLOGUE)) REPS(PH_PROLOGUE) { p0_prologue(F); REPBAR(PH_PROLOGUE); } SEAM(PH_PROLOGUE);

    if (IN(PH_INPROJ)) REPS(PH_INPROJ) {
        pg8::SchedPlain S; S.init(T, NZ, 2 * D, F.p<bf16>(O_WIN), F.G, F.bid);
        pg8::EpiWrap<EInproj> E{{F.p<bf16>(O_Z), F.p<float>(O_LF), F.p<float>(O_RS0), F.in[I_HGRN_LB]}};
        pg8::gemm_phase<false>(ring, F.wave, (const char*)F.p<bf16>(O_XB), 2 * D, S, E); REPBAR(PH_INPROJ);
    } SEAM(PH_INPROJ);

    if (IN(PH_MIXA)) REPS(PH_MIXA) { mix_a_phase(F); REPBAR(PH_MIXA); } SEAM(PH_MIXA);
    if (IN(PH_SCAN)) { scan_phase(F); } SEAM(PH_SCAN);
    if (IN(PH_MIXC)) REPS(PH_MIXC) { mix_c_phase(F); REPBAR(PH_MIXC); } SEAM(PH_MIXC);

    if (IN(PH_MIXPROJ)) {
        { pg8::SchedPlain S; S.init(T, D, 2048, F.p<bf16>(O_WA), F.G, F.bid);
          pg8::EpiWrap<EMixA> E{{F.p<float>(O_MIXT), F.p<bf16>(O_Z)}};
          pg8::gemm_phase<false>(ring, F.wave, (const char*)F.p<bf16>(O_YA), 2048, S, E); }
        { pg8::SchedPlain S; S.init(T, D, 2048, F.p<bf16>(O_WB), F.G, F.bid);
          pg8::EpiWrap<EMixB> E{{F.p<float>(O_MIXT), F.p<bf16>(O_Z), F.p<bf16>(O_MIX)}};
          pg8::gemm_phase<false>(ring, F.wave, (const char*)F.p<bf16>(O_YB), 2048, S, E); }
    } SEAM(PH_MIXPROJ);

    if (IN(PH_WOUT)) {
        pg8::SchedPlain S; S.init(T, D, 2 * D, F.p<bf16>(O_WOUT), F.G, F.bid);
        pg8::EpiWrap<EX1> E{{F.in[I_X], F.p<float>(O_X1), F.p<unsigned char>(O_X1B), F.p<float>(O_SS1)}};
        pg8::gemm_phase<false>(ring, F.wave, (const char*)F.p<bf16>(O_MIX), 2 * D, S, E);
    } SEAM(PH_WOUT);

    if (IN(PH_ROUTE)) REPS(PH_ROUTE) { p7_route(F); REPBAR(PH_ROUTE); } SEAM(PH_ROUTE);
    if (IN(PH_ROWS)) { p8_rows(F); } SEAM(PH_ROWS);

    if (IN(PH_GU)) REPS(PH_GU) {
        const int nblk = __builtin_amdgcn_readfirstlane(F.p<int>(O_BLKE)[NBMAX]);
        pg8::SchedMoE<true> S; S.init(nblk, 4096, D, F.p<unsigned char>(O_WGU), (size_t)4096 * D, F.p<int>(O_BLKE), F.p<int>(O_ROWTOK), F.G, F.bid);
        pg8::EpiWrap<ESwiglu> E{{F.p<unsigned char>(O_ACT), F.p<float>(O_ROWRS), F.in[I_B_GU]}};
        pg8::gemm_phase<true>(ring, F.wave, (const char*)F.p<unsigned char>(O_X1B), D, S, E); REPBAR(PH_GU);
    } SEAM(PH_GU);

    if (IN(PH_DN)) {
        const int nblk = __builtin_amdgcn_readfirstlane(F.p<int>(O_BLKE)[NBMAX]);
        pg8::SchedMoE<false> S; S.init(nblk, D, DFF, F.p<unsigned char>(O_WDN), (size_t)D * DFF, F.p<int>(O_BLKE), F.p<int>(O_ROWTOK), F.G, F.bid);
        pg8::EpiWrap<EDown> E{{F.p<bf16>(O_YBUF), F.p<float>(O_ROWG), F.in[I_B_DN]}};
        pg8::gemm_phase<true>(ring, F.wave, (const char*)F.p<unsigned char>(O_ACT), DFF, S, E);
    } SEAM(PH_DN);

    if (IN(PH_COMBINE)) REPS(PH_COMBINE) {
        p11_combine(F);
        pg8::SchedPlain S; S.init(T, D, 2 * PLE, F.p<bf16>(O_WPLE), F.G, F.bid);
        pg8::EpiWrap<EPw> E{{F.p<bf16>(O_PW)}};
        pg8::gemm_phase<false>(ring, F.wave, (const char*)F.p<bf16>(O_PB), 2 * PLE, S, E); REPBAR(PH_COMBINE);
    } SEAM(PH_COMBINE);

    if (IN(PH_GATE)) {
        pg8::SchedPlain S; S.init(T, D, 2 * D, F.p<bf16>(O_WPG), F.G, F.bid);
        pg8::EpiWrap<EGate> E{{F.p<float>(O_X2), F.p<bf16>(O_PW), F.p<float>(O_RS2), F.out, F.p<float>(O_SS3)}};
        pg8::gemm_phase<false>(ring, F.wave, (const char*)F.p<bf16>(O_X2B), 2 * D, S, E);
    } SEAM(PH_GATE);

    if (IN(PH_FINAL)) { p13_final(F); }
#undef IN
#undef SEAM
}

static void launch_fwd(const Args& base, int lo, int hi, int grid, hipStream_t stream) {
    Args a = base; a.ph_lo = lo; a.ph_hi = hi;
    hipLaunchKernelGGL(fwd, dim3(grid), dim3(512), LDS_BYTES, stream, a);
}

extern "C" void kernel_launch(void* const* d_in, const int* in_sizes, int n_in, void* d_out, int out_size, void* d_ws, size_t ws_size, hipStream_t stream) {
    static int grid = 0;
    if (grid == 0) {
        if (n_in != 25 || out_size != T * D || ws_size < WS_END) { fprintf(stderr, "kernel_launch: unexpected shapes: n_in %d out %d ws %zu (need %zu)\n", n_in, out_size, ws_size, (size_t)WS_END); grid = -1; return; }
        int dev = 0, cus = 0;
        hipGetDevice(&dev); hipDeviceGetAttribute(&cus, hipDeviceAttributeMultiprocessorCount, dev);
        if (hipFuncSetAttribute((const void*)fwd, hipFuncAttributeMaxDynamicSharedMemorySize, LDS_BYTES) != hipSuccess) { fprintf(stderr, "kernel_launch: hipFuncSetAttribute failed\n"); grid = -1; return; }
        int per_cu = 0; (void)hipOccupancyMaxActiveBlocksPerMultiprocessor(&per_cu, (const void*)fwd, 512, LDS_BYTES); (void)hipGetLastError();
        if (per_cu < 1) fprintf(stderr, "kernel_launch: occupancy query says %d\n", per_cu);
        grid = cus;
    }
    if (grid < 0) return;
    hipMemsetAsync((char*)d_ws + O_CTL, 0, 1 * MiB, stream);
    Args a{};
    for (int i = 0; i < 25; ++i) a.in[i] = (const float*)d_in[i];
    a.out = (float*)d_out; a.ws = (unsigned char*)d_ws; a.ph_lo = 0; a.ph_hi = PH_COUNT;
#if ONE_LAUNCH
    launch_fwd(a, 0, PH_COUNT, grid, stream);
#else
    for (int ph = 0; ph < PH_COUNT; ++ph) launch_fwd(a, ph, ph + 1, grid, stream);
#endif
}
```

```cpp
#include <hip/hip_runtime.h>
#include <cstdio>
#include <cstdint>
#include <cstring>

#define DI __device__ __forceinline__
#define LAS __attribute__((address_space(3)))

typedef unsigned short bf16;
typedef short bf16x8 __attribute__((ext_vector_type(8)));
typedef float f32x4 __attribute__((ext_vector_type(4)));
typedef float f32x16 __attribute__((ext_vector_type(16)));
typedef unsigned u32x4 __attribute__((ext_vector_type(4)));
typedef unsigned u32x2 __attribute__((ext_vector_type(2)));

#ifndef NAIVE_GEMM_MASK
#define NAIVE_GEMM_MASK 0x0
#endif
#ifndef NAIVE_MIXERS
#define NAIVE_MIXERS 0
#endif
#ifndef ONE_LAUNCH
#define ONE_LAUNCH 1
#endif
#ifndef STG_INPROJ
#define STG_INPROJ 0u
#endif
#ifndef STG_MIX
#define STG_MIX 0u
#endif
#ifndef STG_GU
#define STG_GU 0u
#endif
#ifndef STG_DN
#define STG_DN 0u
#endif
#ifndef PROBE_PH
#define PROBE_PH -1
#endif
#ifndef PROBE_N
#define PROBE_N 0
#endif

constexpr int T = 32768, D = 2048, SEQ = 8192;
constexpr int NZ = 11264, INCOLS = 11272;
constexpr int ZQA = 0, ZKA = 1024, ZVA = 2048, ZGA = 3072, ZQK = 4096, ZVB = 5120, ZOB = 6144, ZRA = 7168, ZRB = 9216;
constexpr int NE = 32, DFF = 2048, PLE = 256;
constexpr int NRMAX = T * 4 + NE * 256;
constexpr int NBMAX = NRMAX / 256;
constexpr float EPS = 1e-6f;
constexpr float SC_X = 16.f, SC_WGU = 256.f, SC_ACT = 4.f, SC_WDN = 256.f;
constexpr float SQ_M = 127.f / 2.6f;
constexpr float SQ_YA = 127.f / 8.f, SQ_YB = 127.f / 5.5f, SQ_WAB = 127.f / (4.75f * 0.03125f);
constexpr float SC_C = 64.f;
constexpr float SC_U = 16.f;
constexpr float SC_Y = 64.f;
constexpr float SQ_W = 127.f / (4.75f * 0.02209709f), SQ_X = 127.f / 6.f;
constexpr int NCHUNK = 128;
constexpr int NITEM_A = 4 * NCHUNK * 8;
constexpr int NITEM_B = 4 * NCHUNK * 4;

constexpr size_t al4k(size_t x) { return (x + 4095) & ~(size_t)4095; }
constexpr size_t MiB = (size_t)1 << 20;
constexpr size_t O_CTL = 0;
constexpr size_t O_RS0 = 1 * MiB;
constexpr size_t O_RS1 = O_RS0 + al4k((size_t)T * 4);
constexpr size_t O_RS2 = O_RS1 + al4k((size_t)T * 4);
constexpr size_t O_GATES = O_RS2 + al4k((size_t)T * 4);
constexpr size_t O_RWG = O_GATES + al4k((size_t)T * 8 * 4);
constexpr size_t O_DEC = O_RWG + al4k((size_t)D * NE * 4);
constexpr size_t O_NL = O_DEC + al4k((size_t)NITEM_A * 128 * 4);
constexpr size_t O_MLOC = O_NL + al4k((size_t)NITEM_B * 128 * 4);
constexpr size_t O_GTOT = O_MLOC + al4k((size_t)NITEM_B * 4);
constexpr size_t O_MST = O_GTOT + al4k((size_t)NITEM_B * 4);
constexpr size_t O_TOPE = O_MST + al4k((size_t)NITEM_B * 4);
constexpr size_t O_TOPG = O_TOPE + al4k((size_t)T * 4 * 4);
constexpr size_t O_SLOT = O_TOPG + al4k((size_t)T * 4 * 4);
constexpr size_t O_HIST = O_SLOT + al4k((size_t)T * 4 * 4);
constexpr size_t O_ROWTOK = O_HIST + al4k((size_t)256 * 32 * 4);
constexpr size_t O_ROWG = O_ROWTOK + al4k((size_t)NRMAX * 4);
constexpr size_t O_ROWRS = O_ROWG + al4k((size_t)NRMAX * 4);
constexpr size_t O_BLKE = O_ROWRS + al4k((size_t)NRMAX * 4);
constexpr size_t O_SS1 = O_BLKE + al4k((size_t)(NBMAX + 16) * 4);
constexpr size_t O_SS3 = O_SS1 + al4k((size_t)T * 32 * 4);
constexpr size_t O_SMALL_END = O_SS3 + al4k((size_t)T * 32 * 4);
static_assert(O_SMALL_END <= 32 * MiB, "small region");
constexpr size_t O_WIN = 32 * MiB;
constexpr size_t O_WA = O_WIN + (size_t)NZ * D * 2;
constexpr size_t O_WB = O_WA + (size_t)D * 1024 * 2;
constexpr size_t O_WOUT = O_WB + (size_t)D * 1024 * 2;
constexpr size_t O_WPG = O_WOUT + (size_t)D * D * 2;
constexpr size_t O_WPLE = O_WPG + (size_t)D * D * 2;
constexpr size_t O_WGU = O_WPLE + (size_t)D * PLE * 2;
constexpr size_t O_WDN = O_WGU + (size_t)NE * 4096 * D * 2;
constexpr size_t O_XB = O_WDN + (size_t)NE * D * DFF * 2;
constexpr size_t O_PB = O_XB + (size_t)T * D * 2;
constexpr size_t O_Z = O_PB + (size_t)T * PLE * 2;
constexpr size_t O_M = O_Z + (size_t)T * NZ * 2;
constexpr size_t O_LF = O_M;
constexpr size_t O_UST = O_LF + (size_t)T * 1024 * 4;
constexpr size_t O_CT = O_UST + (size_t)NITEM_A * 128 * 128 * 2;
constexpr size_t O_YA = O_CT + (size_t)NITEM_B * 256 * 128 * 2;
constexpr size_t O_YB = O_YA + (size_t)T * 1024 * 2;
constexpr size_t O_MIX = O_YB + (size_t)T * 1024 * 2;
constexpr size_t O_M_END = O_MIX + (size_t)T * D * 2;
static_assert(O_M_END - O_M >= (size_t)NRMAX * D * 2, "YBUF alias");
static_assert((size_t)T * NZ * 2 >= (size_t)NRMAX * D * 2, "ACT alias");
constexpr size_t O_MIXT = O_M_END;
constexpr size_t O_X1 = O_MIXT + (size_t)T * D * 4;
constexpr size_t O_X1B = O_X1 + (size_t)T * D * 4;
constexpr size_t WS_END = O_X1B + (size_t)T * D * 2;
constexpr size_t O_ACT = O_Z, O_YBUF = O_M, O_X2 = O_MIXT, O_X2B = O_XB, O_PW = O_X1B, O_X3 = O_MIXT + (size_t)T * D * 2;

constexpr int CW_BAR = 4096;

DI int lane_id() { int l; asm volatile("v_mbcnt_lo_u32_b32 %0, -1, 0\n\tv_mbcnt_hi_u32_b32 %0, -1, %0" : "=v"(l)); return l; }
DI unsigned f2bf(float f) { unsigned u = __float_as_uint(f); return (u + 0x7fffu + ((u >> 16) & 1u)) >> 16; }
DI float bf2f(unsigned h) { return __uint_as_float(h << 16); }
DI unsigned pk2(float lo, float hi) { unsigned r; asm volatile("v_cvt_pk_bf16_f32 %0, %1, %2" : "=v"(r) : "v"(lo), "v"(hi)); return r; }
typedef float f32x2 __attribute__((ext_vector_type(2)));
typedef __bf16 bf16x2_t __attribute__((ext_vector_type(2)));
DI unsigned pk2c(float lo, float hi) { const f32x2 v = {lo, hi}; return __builtin_bit_cast(unsigned, __builtin_convertvector(v, bf16x2_t)); }
DI float sigm(float x) { return __builtin_amdgcn_rcpf(1.f + __expf(-x)); }
DI float wave_sum(float v) {
#pragma unroll
    for (int o = 1; o < 64; o <<= 1) v += __shfl_xor(v, o);
    return v;
}
DI float wave_max(float v) {
#pragma unroll
    for (int o = 1; o < 64; o <<= 1) v = fmaxf(v, __shfl_xor(v, o));
    return v;
}
DI void unpack8(const u32x4 w, float (&o)[8]) {
    o[0] = bf2f(w.x & 0xffffu); o[1] = bf2f(w.x >> 16); o[2] = bf2f(w.y & 0xffffu); o[3] = bf2f(w.y >> 16);
    o[4] = bf2f(w.z & 0xffffu); o[5] = bf2f(w.z >> 16); o[6] = bf2f(w.w & 0xffffu); o[7] = bf2f(w.w >> 16);
}
DI u32x4 pack8(const float (&v)[8]) { u32x4 w; w.x = pk2(v[0], v[1]); w.y = pk2(v[2], v[3]); w.z = pk2(v[4], v[5]); w.w = pk2(v[6], v[7]); return w; }
DI u32x4 pack8c(const float (&v)[8]) { u32x4 w; w.x = pk2c(v[0], v[1]); w.y = pk2c(v[2], v[3]); w.z = pk2c(v[4], v[5]); w.w = pk2c(v[6], v[7]); return w; }
DI unsigned pk4_fp8(float a, float b, float c, float d) { unsigned w = __builtin_amdgcn_cvt_pk_fp8_f32(a, b, 0u, false); return __builtin_amdgcn_cvt_pk_fp8_f32(c, d, w, true); }
DI float clamp8(float v) { return fminf(fmaxf(v, -440.f), 440.f); }
DI unsigned pk4_i8(float a, float b, float c, float d, float s) {
    typedef short s16x2 __attribute__((ext_vector_type(2)));
    const float k = s * (256.f / 32767.f), o = 128.f / 32767.f;
    const s16x2 lo = __builtin_amdgcn_cvt_pknorm_i16(fmaf(a, k, o), fmaf(b, k, o)), hi = __builtin_amdgcn_cvt_pknorm_i16(fmaf(c, k, o), fmaf(d, k, o));
    return __builtin_amdgcn_perm(__builtin_bit_cast(unsigned, hi), __builtin_bit_cast(unsigned, lo), 0x07050301u);
}
DI unsigned pk4_u8(float a, float b, float c, float d) {
    typedef unsigned short u16x2 __attribute__((ext_vector_type(2)));
    const float k = 255.f * 256.f / 65535.f, o = 128.f / 65535.f;
    const u16x2 lo = __builtin_amdgcn_cvt_pknorm_u16(fmaf(a, k, o), fmaf(b, k, o)), hi = __builtin_amdgcn_cvt_pknorm_u16(fmaf(c, k, o), fmaf(d, k, o));
    return __builtin_amdgcn_perm(__builtin_bit_cast(unsigned, hi), __builtin_bit_cast(unsigned, lo), 0x07050301u);
}
DI float ub(unsigned w, int i) { return (float)((w >> (8 * i)) & 0xffu); }
DI float log_sigmoid(float x) { return fminf(x, 0.f) - __logf(1.f + __expf(-fabsf(x))); }

#define XB_TMO      128
#define XB_XCNT(j)  (256  + 64 * (j))
#define XB_XSUB(j)  (1280 + 64 * (j))
#define XB_XGEN(j)  (2304 + 64 * (j))
#define XB_TOP      3328
#define XB_TOPGEN   3392
#define XCD_BAR_WORDS 3456
#define XB_SPIN_CAP (1u << 18)
__device__ __forceinline__ unsigned xb_ld(unsigned* p)              { return __hip_atomic_load(p, __ATOMIC_RELAXED, __HIP_MEMORY_SCOPE_AGENT); }
__device__ __forceinline__ unsigned xb_add(unsigned* p, unsigned v) { return __hip_atomic_fetch_add(p, v, __ATOMIC_RELAXED, __HIP_MEMORY_SCOPE_AGENT); }
__device__ __forceinline__ unsigned xb_xcc_id() { return (unsigned)__builtin_amdgcn_s_getreg((3 << 11) | 20) & 0xFu; }
#define XB_SPIN(cond, bar) do { unsigned _sp = 0; while (cond) { __builtin_amdgcn_s_sleep(1); \
    if ((++_sp & 255u) == 0u) { if (xb_ld(&(bar)[XB_TMO])) break; if (_sp > XB_SPIN_CAP) { atomicAdd(&(bar)[XB_TMO], 1u); break; } } } } while (0)
struct XcdBarrier { unsigned* bar; unsigned x; volatile LAS unsigned* st; };
__device__ __forceinline__ XcdBarrier xcd_barrier_post(unsigned* bar, volatile LAS unsigned* st, bool leader) {
    XcdBarrier b; b.bar = bar; b.x = xb_xcc_id(); b.st = st;
    if (leader) (void)xb_add(&bar[XB_XCNT(b.x)], 1u);
    return b;
}
__device__ __forceinline__ void xcd_barrier_complete(unsigned* bar, unsigned x, unsigned& nloc, unsigned& nx) {
    const unsigned G = gridDim.x * gridDim.y * gridDim.z;
    unsigned sum, cnt, mine, sp = 0u;
    for (;;) {
        sum = 0u; cnt = 0u; mine = 0u;
#pragma unroll
        for (unsigned j = 0; j < 16; ++j) { const unsigned c = xb_ld(&bar[XB_XCNT(j)]); sum += c; cnt += (c > 0u) ? 1u : 0u; mine = (j == x) ? c : mine; }
        if (sum == G) break;
        __builtin_amdgcn_s_sleep(1);
        if ((++sp & 255u) == 0u) { if (xb_ld(&bar[XB_TMO])) break; if (sp > XB_SPIN_CAP) { atomicAdd(&bar[XB_TMO], 1u); break; } }
    }
    nloc = mine > 0u ? mine : 1u; nx = cnt > 0u ? cnt : 1u;
}
__device__ __forceinline__ void xcd_barrier(const XcdBarrier& b, bool leader) {
    asm volatile("s_waitcnt vmcnt(0)" ::: "memory");
    __syncthreads();
    if (leader) {
        unsigned* bar = b.bar;
        __builtin_amdgcn_s_waitcnt(0);
        unsigned nloc = b.st[0], nx = b.st[1];
        if (nloc == 0u) { xcd_barrier_complete(bar, b.x, nloc, nx); b.st[0] = nloc; b.st[1] = nx; }
        const unsigned old = xb_add(&bar[XB_XSUB(b.x)], 1u);
        const unsigned gen = old / nloc;
        if (old + 1u == (gen + 1u) * nloc) {
            __builtin_amdgcn_fence(__ATOMIC_RELEASE, "agent");
            asm volatile("s_waitcnt vmcnt(0)" ::: "memory");
            const unsigned og = xb_add(&bar[XB_TOP], 1u);
            const unsigned tg = og / nx;
            if (og + 1u == (tg + 1u) * nx) xb_add(&bar[XB_TOPGEN], 1u);
            else XB_SPIN(xb_ld(&bar[XB_TOPGEN]) == tg, bar);
            __builtin_amdgcn_fence(__ATOMIC_ACQUIRE, "agent");
            xb_add(&bar[XB_XGEN(b.x)], 1u);
            asm volatile("s_waitcnt vmcnt(0)" ::: "memory");
        } else {
            XB_SPIN(xb_ld(&bar[XB_XGEN(b.x)]) == gen, bar);
            __builtin_amdgcn_fence(__ATOMIC_ACQUIRE, "agent");
            asm volatile("s_waitcnt vmcnt(0)" ::: "memory");
        }
    }
    __syncthreads();
}

namespace pg8 {
constexpr int BM = 256, BK = 64, HALF = 128, HTB = HALF * BK * 2, STAGE_BYTES = 8 * HTB, NXCD = 8, WGM = 8;
__host__ __device__ __forceinline__ int lds_byte(int r, int c) { const int st = (r >> 4) * 2 + (c >> 5), rr = r & 15, cc = c & 31, ob = rr * 64 + cc * 2; return st * 1024 + (ob ^ (((ob >> 9) & 1) << 5)); }
__host__ __device__ __forceinline__ void stage_rc(int b, int& R, int& C) { const int st = b / 1024, sb = b % 1024, swz = sb ^ (((sb >> 9) & 1) << 5); R = (st >> 1) * 16 + swz / 64; C = (st & 1) * 32 + (swz % 64) / 2; }
__host__ __device__ __forceinline__ int perm32(int rho) { const int n = rho >> 4, i = rho & 15; return 8 * (i >> 2) + 4 * n + (i & 3); }

struct Unit { int pm, pn, e; };

struct OrderBase {
    int nM, nN, nwg, G, c;
    DI void init_order(int nM_, int nN_, int G_, int c_) { nM = nM_; nN = nN_; nwg = nM * nN; G = G_; c = c_; }
    DI bool next_mn(int i, Unit& u) const {
        const long L = (long)i * G + c; if (L >= nwg) return false;
        int wgid = (int)L; { const int q = nwg / NXCD, r = nwg % NXCD, xcd = wgid % NXCD, off = wgid / NXCD; wgid = (xcd < r ? xcd * (q + 1) : r * (q + 1) + (xcd - r) * q) + off; }
        const int nig = WGM * nN, gid = wgid / nig, fm = gid * WGM, gsz = (nM - fm) < WGM ? (nM - fm) : WGM;
        u.pm = fm + ((wgid % nig) % gsz); u.pn = (wgid % nig) / gsz; return true;
    }
};
struct SchedPlain : OrderBase {
    static constexpr bool GATHER = false;
    const char* Bt; int K;
    DI void init(int M, int N, int K_, const void* Bt_, int G_, int c_) { init_order(M / BM, N / BM, G_, c_); Bt = (const char*)Bt_; K = K_; }
    DI bool next(int i, Unit& u) const { u.e = 0; return next_mn(i, u); }
    DI bool unit_of(int L, Unit& u) const { u.e = 0; u.pm = L / nN; u.pn = L % nN; return u.pm < nM; }
    DI unsigned a_row_off(const Unit& u, int r) const { return (unsigned)(u.pm * BM + r) * (unsigned)K; }
    DI const char* b_ptr(const Unit& u) const { return Bt + (size_t)u.pn * BM * K; }
};
template <bool GATHER_> struct SchedMoE : OrderBase {
    static constexpr bool GATHER = GATHER_;
    const char* Bt; int K; const int* blke; const int* rowtok; size_t estride;
    DI void init(int nblk, int N, int K_, const void* Bt_, size_t estride_, const int* blke_, const int* rowtok_, int G_, int c_) { init_order(nblk, N / BM, G_, c_); Bt = (const char*)Bt_; K = K_; blke = blke_; rowtok = rowtok_; estride = estride_; }
    DI bool next(int i, Unit& u) const { if (!next_mn(i, u)) return false; u.e = __builtin_amdgcn_readfirstlane(blke[u.pm]); return true; }
    DI bool unit_of(int L, Unit& u) const { u.pm = L / nN; u.pn = L % nN; if (u.pm >= nM) return false; u.e = blke[u.pm]; return true; }
    DI unsigned a_row_off(const Unit& u, int r) const { const int row = u.pm * BM + r; return (unsigned)(GATHER ? rowtok[row] : row) * (unsigned)K; }
    DI const char* b_ptr(const Unit& u) const { return Bt + (size_t)u.e * estride + (size_t)u.pn * BM * K; }
};

template <class E, bool INTACC = false, bool P16_ = false> struct EpiWrap {
    static constexpr bool PERM = true, AFTER_DRAIN = false, P16 = P16_;
    E e;
    DI void operator()(const f32x4 (&acc)[2][2][4][2], const Unit& u, int wr, int wc, int fr, int fq) const {
        const int lc = P16 ? wc * 64 + 16 * fq : wc * 32 + 8 * fq;
        typename E::Pre pre; e.begin(u, lc, pre);
#pragma unroll
        for (int ai = 0; ai < 2; ++ai) {
            typename E::Row rd[4];
#pragma unroll
            for (int m = 0; m < 4; ++m) e.load(u, u.pm * BM + ai * HALF + wr * 64 + m * 16 + fr, lc, rd[m]);
#pragma unroll
            for (int m = 0; m < 4; ++m) {
                const int row = u.pm * BM + ai * HALF + wr * 64 + m * 16 + fr;
                float v0[8], v1[8];
#pragma unroll
                for (int j = 0; j < 4; ++j) {
                    if constexpr (INTACC) { v0[j] = (float)__float_as_int(acc[ai][0][m][0][j]); v0[4 + j] = (float)__float_as_int(acc[ai][0][m][1][j]); v1[j] = (float)__float_as_int(acc[ai][1][m][0][j]); v1[4 + j] = (float)__float_as_int(acc[ai][1][m][1][j]); }
                    else { v0[j] = acc[ai][0][m][0][j]; v0[4 + j] = acc[ai][0][m][1][j]; v1[j] = acc[ai][1][m][0][j]; v1[4 + j] = acc[ai][1][m][1][j]; } }
                e.store(u, row, lc, v0, v1, pre, rd[m]);
            }
        }
    }
};

typedef int i32x4 __attribute__((ext_vector_type(4)));
typedef int i32x8 __attribute__((ext_vector_type(8)));
DI i32x8 cat8(const bf16x8 lo, const bf16x8 hi) { return __builtin_shufflevector(__builtin_bit_cast(i32x4, lo), __builtin_bit_cast(i32x4, hi), 0, 1, 2, 3, 4, 5, 6, 7); }
struct NoHook { static constexpr bool ENABLED = false; DI void apply(f32x4 (&)[2][2][4][2], const Unit&, int, int, int, int) const {} };
template <int MODE  , class Epi, class Sched, class Hook = NoHook, bool ALIGN_EPI = true, bool SP2 = true>
__device__ __forceinline__ void gemm_phase(LAS unsigned char* lds, const int wave_, const char* Abase, const int KB, const Sched& S, const Epi& E, const unsigned stagger_ticks = 0u, const Hook& H = Hook()) {
    if (stagger_ticks) { const unsigned long long t0 = __builtin_amdgcn_s_memrealtime(), dl = (unsigned long long)(xb_xcc_id() & 7u) * stagger_ticks; while (__builtin_amdgcn_s_memrealtime() - t0 < dl) __builtin_amdgcn_s_sleep(16); }
    constexpr bool FP8 = (MODE == 1);
    const int lane = lane_id(), wid = wave_, tid = wid * 64 + lane, wr = wid >> 2, wc = wid & 3, fr = lane & 15, fq = lane >> 4;
    const int nt = KB / 128;
    int Rr[2], Cc[2]; unsigned voffB[2], voffA[2];
#pragma unroll
    for (int i = 0; i < 2; ++i) { stage_rc(tid * 16 + i * 8192, Rr[i], Cc[i]); const int Rb = Epi::PERM ? (Epi::P16 ? (64 * (Rr[i] >> 5) + 16 * ((Rr[i] & 15) >> 2) + 4 * ((Rr[i] >> 4) & 1) + (Rr[i] & 3)) : ((Rr[i] & ~31) + perm32(Rr[i] & 31))) : Rr[i]; voffB[i] = (unsigned)(Rb * KB + Cc[i] * 2); voffA[i] = (unsigned)(Rr[i] * KB + Cc[i] * 2); }
    const size_t kstep = (size_t)(BK * 2);
    const size_t hstep = (size_t)HALF * KB;
    const size_t hstepB = Epi::P16 ? (size_t)8 * KB : hstep;
    const unsigned ldsw = (unsigned)wid * 1024u;
    const int aoff = lds_byte(wr * 64 + fr, fq * 8), boff = lds_byte(wc * 32 + fr, fq * 8);
#define PG8_SA(b, h) (((b) * 2 + (h)) * HTB)
#define PG8_SB(b, h) ((4 + (b) * 2 + (h)) * HTB)
#define PG8_STAGE(bufoff, gbase, v0_, v1_) do { \
        __builtin_amdgcn_global_load_lds((const unsigned*)((const char*)(gbase) + (v0_)), (LAS unsigned*)(lds + (bufoff) + ldsw), 16, 0, 0); \
        __builtin_amdgcn_global_load_lds((const unsigned*)((const char*)(gbase) + (v1_)), (LAS unsigned*)(lds + (bufoff) + ldsw + 8192), 16, 0, 0); } while (0)
#define PG8_STAGEB(bufoff, gbase) PG8_STAGE(bufoff, gbase, voffB[0], voffB[1])
#define PG8_STAGEA(bufoff, h, uptr, kb, useNext) do { if constexpr (Sched::GATHER) { const unsigned o0_ = (useNext) ? nvA[h][0] : vA[h][0], o1_ = (useNext) ? nvA[h][1] : vA[h][1]; PG8_STAGE(bufoff, Abase + (kb), o0_, o1_); } \
        else { PG8_STAGE(bufoff, (uptr) + (h) * hstep, voffA[0], voffA[1]); } } while (0)
#define PG8_LDA(dst, b, h) do { _Pragma("unroll") for (int m = 0; m < 4; ++m) { if constexpr (FP8) dst##8[m] = cat8(*(const LAS bf16x8*)(lds + PG8_SA(b, h) + aoff + m * 2048), *(const LAS bf16x8*)(lds + PG8_SA(b, h) + aoff + m * 2048 + 1024)); \
        else { _Pragma("unroll") for (int k = 0; k < 2; ++k) dst[m][k] = *(const LAS bf16x8*)(lds + PG8_SA(b, h) + aoff + m * 2048 + k * 1024); } } } while (0)
#define PG8_LDB(dst, b, h) do { _Pragma("unroll") for (int n = 0; n < 2; ++n) { if constexpr (FP8) dst##8[n] = cat8(*(const LAS bf16x8*)(lds + PG8_SB(b, h) + boff + n * 2048), *(const LAS bf16x8*)(lds + PG8_SB(b, h) + boff + n * 2048 + 1024)); \
        else { _Pragma("unroll") for (int k = 0; k < 2; ++k) dst[n][k] = *(const LAS bf16x8*)(lds + PG8_SB(b, h) + boff + n * 2048 + k * 1024); } } } while (0)
#define PG8_MMA(ai, bj, At, Bt) do { __builtin_amdgcn_s_setprio(1); _Pragma("unroll") for (int m = 0; m < 4; ++m) _Pragma("unroll") for (int n = 0; n < 2; ++n) { \
        if constexpr (FP8) asm volatile("v_mfma_f32_16x16x128_f8f6f4 %0, %1, %2, %0" : "+v"(acc[ai][bj][m][n]) : "v"(Bt##8[n]), "v"(At##8[m]));   \
        else if constexpr (MODE == 2) { _Pragma("unroll") for (int k = 0; k < 2; ++k) acc[ai][bj][m][n] = __builtin_bit_cast(f32x4, __builtin_amdgcn_mfma_i32_16x16x64_i8(__builtin_bit_cast(i32x4, Bt[n][k]), __builtin_bit_cast(i32x4, At[m][k]), __builtin_bit_cast(i32x4, acc[ai][bj][m][n]), 0, 0, 0)); }   \
        else { _Pragma("unroll") for (int k = 0; k < 2; ++k) acc[ai][bj][m][n] = __builtin_amdgcn_mfma_f32_16x16x32_bf16(Bt[n][k], At[m][k], acc[ai][bj][m][n], 0, 0, 0); } } \
        __builtin_amdgcn_s_setprio(0); } while (0)
#define PG8_WAIT_V(n) asm volatile("s_waitcnt vmcnt(" #n ")" ::: "memory")
#define PG8_WAIT_L(n) asm volatile("s_waitcnt lgkmcnt(" #n ")" ::: "memory")
#define PG8_BAR __builtin_amdgcn_s_barrier()
#define PG8_SCHED __builtin_amdgcn_sched_barrier(0)
    Unit cur, nxt; int ui = 0;
    if (!S.next(0, cur)) return;
    f32x4 acc[2][2][4][2];
#pragma unroll
    for (int a = 0; a < 2; ++a)
#pragma unroll
        for (int b = 0; b < 2; ++b)
#pragma unroll
            for (int m = 0; m < 4; ++m)
#pragma unroll
                for (int n = 0; n < 2; ++n) acc[a][b][m][n] = (f32x4){0.f, 0.f, 0.f, 0.f};
    bf16x8 At[4][2], B0[2][2], B1[2][2];
    i32x8 At8[4], B08[2], B18[2];
    unsigned vA[2][2] = {{0u, 0u}, {0u, 0u}}, nvA[2][2] = {{0u, 0u}, {0u, 0u}};
    const char* cA = Abase; const char* nA = Abase;
    if constexpr (Sched::GATHER) {
#pragma unroll
        for (int h = 0; h < 2; ++h)
#pragma unroll
            for (int i = 0; i < 2; ++i) vA[h][i] = S.a_row_off(cur, h * HALF + Rr[i]) + (unsigned)Cc[i] * 2u;
    } else cA = Abase + (size_t)S.a_row_off(cur, 0);
    const char* cB = S.b_ptr(cur);
    if constexpr (SP2) {
        PG8_STAGEB(PG8_SB(0, 0), cB); PG8_STAGEB(PG8_SB(0, 1), cB + hstepB); PG8_STAGEA(PG8_SA(0, 0), 0, cA, 0, false); PG8_STAGEA(PG8_SA(0, 1), 1, cA, 0, false);
        if (wr == 1) PG8_BAR;
        PG8_WAIT_V(2); PG8_BAR;
        PG8_STAGEB(PG8_SB(1, 0), cB + kstep); PG8_STAGEA(PG8_SA(1, 0), 0, cA + kstep, kstep, false); PG8_STAGEB(PG8_SB(1, 1), cB + hstepB + kstep);
        PG8_WAIT_V(6); PG8_BAR;
    } else {
        PG8_STAGEB(PG8_SB(0, 0), cB); PG8_STAGEA(PG8_SA(0, 0), 0, cA, 0, false); PG8_STAGEB(PG8_SB(0, 1), cB + hstepB); PG8_STAGEA(PG8_SA(0, 1), 1, cA, 0, false);
        if (wr == 1) PG8_BAR;
        PG8_WAIT_V(4); PG8_BAR;
        PG8_STAGEB(PG8_SB(1, 0), cB + kstep); PG8_STAGEA(PG8_SA(1, 0), 0, cA + kstep, kstep, false); PG8_STAGEB(PG8_SB(1, 1), cB + hstepB + kstep);
        PG8_WAIT_V(6); PG8_BAR;
    }
    for (;;) {
        const bool has_next = S.next(ui + 1, nxt);
        const char* nB = cB; nA = cA;
        if (has_next) {
            nB = S.b_ptr(nxt);
            if constexpr (Sched::GATHER) {
#pragma unroll
                for (int h = 0; h < 2; ++h)
#pragma unroll
                    for (int i = 0; i < 2; ++i) nvA[h][i] = S.a_row_off(nxt, h * HALF + Rr[i]) + (unsigned)Cc[i] * 2u;
            } else nA = Abase + (size_t)S.a_row_off(nxt, 0);
        } else if constexpr (Sched::GATHER) {
#pragma unroll
            for (int h = 0; h < 2; ++h)
#pragma unroll
                for (int i = 0; i < 2; ++i) nvA[h][i] = vA[h][i];
        }
#pragma unroll 1
        for (int t = 0; t < nt; t += 2) {
            const bool last = (t == nt - 2);
            if constexpr (Hook::ENABLED) { if (t == nt / 2) H.apply(acc, cur, wr, wc, fr, fq); }
            const char* a1 = cA + (size_t)(t + 1) * kstep; const size_t k1 = (size_t)(t + 1) * kstep;
            const char* a2 = last ? nA : cA + (size_t)(t + 2) * kstep; const char* b2 = last ? nB : cB + (size_t)(t + 2) * kstep; const size_t k2 = last ? (size_t)0 : (size_t)(t + 2) * kstep;
            const char* a3 = a2 + kstep; const char* b3 = b2 + kstep; const size_t k3 = k2 + kstep;
            if constexpr (SP2) {
            PG8_LDB(B0, 0, 0); PG8_LDB(B1, 0, 1); PG8_SCHED; PG8_LDA(At, 0, 0); PG8_STAGEA(PG8_SA(1, 1), 1, a1, k1, false);
            PG8_WAIT_V(8); PG8_WAIT_L(0); PG8_BAR; PG8_MMA(0, 0, At, B0); PG8_MMA(0, 1, At, B1); PG8_BAR; PG8_SCHED;
            PG8_LDA(At, 0, 1); PG8_STAGEB(PG8_SB(0, 0), b2); PG8_STAGEB(PG8_SB(0, 1), b2 + hstepB); PG8_STAGEA(PG8_SA(0, 0), 0, a2, k2, last);
            PG8_WAIT_V(8); PG8_WAIT_L(0); PG8_BAR; PG8_MMA(1, 0, At, B0); PG8_MMA(1, 1, At, B1); PG8_BAR; PG8_SCHED;
            PG8_LDB(B0, 1, 0); PG8_LDB(B1, 1, 1); PG8_SCHED; PG8_LDA(At, 1, 0); PG8_STAGEA(PG8_SA(0, 1), 1, a2, k2, last);
            PG8_WAIT_V(8); PG8_WAIT_L(0); PG8_BAR; PG8_MMA(0, 0, At, B0); PG8_MMA(0, 1, At, B1); PG8_BAR; PG8_SCHED;
            PG8_LDA(At, 1, 1); PG8_STAGEB(PG8_SB(1, 0), b3); PG8_STAGEB(PG8_SB(1, 1), b3 + hstepB); PG8_STAGEA(PG8_SA(1, 0), 0, a3, k3, last);
            PG8_WAIT_V(8); PG8_WAIT_L(0); PG8_BAR; PG8_MMA(1, 0, At, B0); PG8_MMA(1, 1, At, B1); PG8_BAR; PG8_SCHED;
            } else {
            PG8_LDB(B0, 0, 0); PG8_SCHED; PG8_LDA(At, 0, 0); PG8_STAGEA(PG8_SA(1, 1), 1, a1, k1, false);
            PG8_WAIT_L(8); PG8_BAR; PG8_WAIT_L(0); PG8_MMA(0, 0, At, B0); PG8_BAR; PG8_SCHED;
            PG8_LDB(B1, 0, 1); PG8_STAGEB(PG8_SB(0, 0), b2);
            PG8_BAR; PG8_WAIT_L(0); PG8_MMA(0, 1, At, B1); PG8_BAR;
            PG8_LDA(At, 0, 1); PG8_STAGEA(PG8_SA(0, 0), 0, a2, k2, last);
            PG8_BAR; PG8_WAIT_L(0); PG8_MMA(1, 0, At, B0); PG8_BAR; PG8_SCHED;
            PG8_STAGEB(PG8_SB(0, 1), b2 + hstepB);
            PG8_WAIT_V(6); PG8_BAR; PG8_MMA(1, 1, At, B1); PG8_BAR;
            PG8_LDB(B0, 1, 0); PG8_SCHED; PG8_LDA(At, 1, 0); PG8_STAGEA(PG8_SA(0, 1), 1, a2, k2, last);
            PG8_WAIT_L(8); PG8_BAR; PG8_WAIT_L(0); PG8_MMA(0, 0, At, B0); PG8_BAR; PG8_SCHED;
            PG8_LDB(B1, 1, 1); PG8_STAGEB(PG8_SB(1, 0), b3);
            PG8_BAR; PG8_WAIT_L(0); PG8_MMA(0, 1, At, B1); PG8_BAR;
            PG8_LDA(At, 1, 1); PG8_STAGEA(PG8_SA(1, 0), 0, a3, k3, last);
            PG8_BAR; PG8_WAIT_L(0); PG8_MMA(1, 0, At, B0); PG8_BAR; PG8_SCHED;
            PG8_STAGEB(PG8_SB(1, 1), b3 + hstepB);
            PG8_WAIT_V(6); PG8_BAR; PG8_MMA(1, 1, At, B1); PG8_BAR;
            }
        }
        if constexpr (FP8) asm volatile("s_nop 15\n\ts_nop 15" ::: "memory");
        if constexpr (ALIGN_EPI) { if (wr == 0) PG8_BAR; }
        E(acc, cur, wr, wc, fr, fq);
        if (!has_next) break;
#pragma unroll
        for (int a = 0; a < 2; ++a)
#pragma unroll
            for (int b = 0; b < 2; ++b)
#pragma unroll
                for (int m = 0; m < 4; ++m)
#pragma unroll
                    for (int n = 0; n < 2; ++n) acc[a][b][m][n] = (f32x4){0.f, 0.f, 0.f, 0.f};
        cur = nxt; cB = nB; cA = nA; ++ui;
        if constexpr (Sched::GATHER) {
#pragma unroll
            for (int h = 0; h < 2; ++h)
#pragma unroll
                for (int i = 0; i < 2; ++i) vA[h][i] = nvA[h][i];
        }
        if constexpr (ALIGN_EPI) { if (wr == 1) PG8_BAR; }
    }
    PG8_WAIT_V(0);
    if constexpr (!ALIGN_EPI) { if (wr == 0) PG8_BAR; }
    PG8_BAR;
#undef PG8_SA
#undef PG8_SB
#undef PG8_STAGE
#undef PG8_STAGEB
#undef PG8_STAGEA
#undef PG8_LDA
#undef PG8_LDB
#undef PG8_MMA
#undef PG8_WAIT_V
#undef PG8_WAIT_L
#undef PG8_BAR
#undef PG8_SCHED
}
}
using pg8::Unit;

struct EInproj {
    struct Row { float rs; }; DI void load(const Unit&, int row, int, Row& r) const { r.rs = rs0[row]; }
    struct Pre { float lb[2][8]; };
    DI void begin(const Unit& u, int lc, Pre& p) const {
        if ((u.pn >> 2) == 1) {
#pragma unroll
            for (int bj = 0; bj < 2; ++bj)
#pragma unroll
                for (int i = 0; i < 8; ++i) { const int c = u.pn * 256 + bj * 128 + lc - 1024 + i; p.lb[bj][i] = sigm(hlb[c] - hlb[1024 + c]); }
        }
    }
    bf16* Z; bf16* LF; const float* rs0; const float* hlb;
    DI void store(const Unit& u, int row, int lc, const float (&v0)[8], const float (&v1)[8], const Pre& pre, const Row& rd) const {
        const float rs = rd.rs * (1.f / SQ_W);
        const int kind = u.pn >> 2;
        if (u.pn >= 28) {
            const int g = (u.pn - 28) * 16 + (lc >> 3); float sa[8], sb[8];
#pragma unroll
            for (int i = 0; i < 8; ++i) {
                const float za = fminf(fmaxf(rs * v0[i], -30.f), 30.f), zb = fminf(fmaxf(rs * v1[i], -30.f), 30.f);
                const float ea = __expf(-za), eb = __expf(-zb);
                sa[i] = __builtin_amdgcn_rcpf(1.f + ea); sb[i] = fmaxf(__builtin_amdgcn_rcpf(1.f + eb), 1.f / 255.f);
            }
            u32x4 q; q.x = pk4_u8(sa[0], sa[1], sa[2], sa[3]); q.y = pk4_u8(sa[4], sa[5], sa[6], sa[7]); q.z = pk4_u8(sb[0], sb[1], sb[2], sb[3]); q.w = pk4_u8(sb[4], sb[5], sb[6], sb[7]);
            *(u32x4*)((unsigned char*)(Z + (size_t)row * NZ + ZRA) + 16 * g) = q;
            return;
        }
#pragma unroll
        for (int bj = 0; bj < 2; ++bj) {
            const int col = u.pn * 256 + bj * 128 + lc;
            float o[8];
            if (kind == 2 || kind == 4 || kind == 5) {
#pragma unroll
                for (int i = 0; i < 8; ++i) o[i] = rs * (bj ? v1[i] : v0[i]);
            } else if (kind == 1) {
                const int c = col - 1024;
                float lf[8];
#pragma unroll
                for (int i = 0; i < 8; ++i) {
                    const float lbv = pre.lb[bj][i];
                    float z = rs * (bj ? v1[i] : v0[i]); z = fminf(fmaxf(z, -80.f), 80.f);
                    const float e = __expf(-z), s = __builtin_amdgcn_rcpf(1.f + e), sn = e * s;
                    lf[i] = __logf(lbv + (1.f - lbv) * s);
                    o[i] = (1.f - lbv) * sn;
                }
                *(u32x4*)(LF + (size_t)row * 1024 + c) = pack8(lf);
            } else {
                const bool silu = (kind == 0 || kind == 3);
#pragma unroll
                for (int i = 0; i < 8; ++i) { const float z = rs * (bj ? v1[i] : v0[i]); const float s = sigm(z); o[i] = silu ? z * s : s; }
            }
            *(u32x4*)(Z + (size_t)row * NZ + col) = pack8(o);
        }
    }
};
struct ENullProbe {
    struct Row {}; DI void load(const Unit&, int, int, Row&) const {}
    struct Pre {}; DI void begin(const Unit&, int, Pre&) const {}
    float* sink; int flag;
    DI void store(const Unit& u, int row, int lc, const float (&v0)[8], const float (&v1)[8], const Pre& pre, const Row& rd) const {
        if (flag) { float a = 0.f;
#pragma unroll
            for (int i = 0; i < 8; ++i) a += v0[i] + v1[i];
            sink[(size_t)row * 256 + lc] = a; }
    }
};
struct MixHook {
    static constexpr bool ENABLED = true;
    const bf16* Z;
    DI void apply(f32x4 (&acc)[2][2][4][2], const Unit& u, int wr, int wc, int fr, int fq) const {
        int frl = fr; asm volatile("" : "+v"(frl));
        const unsigned char* base = (const unsigned char*)(Z + (size_t)(u.pm * 256 + wr * 64 + frl) * NZ + ZRA) + 16 * (u.pn * 32 + wc * 8 + 2 * fq);
#pragma unroll
        for (int ai = 0; ai < 2; ++ai) {
            u32x4 rr[4][2];
#pragma unroll
            for (int m = 0; m < 4; ++m)
#pragma unroll
                for (int bj = 0; bj < 2; ++bj) rr[m][bj] = *(const u32x4*)(base + (size_t)(ai * 128 + m * 16) * NZ * 2 + bj * 16);
#pragma unroll
            for (int m = 0; m < 4; ++m)
#pragma unroll
                for (int bj = 0; bj < 2; ++bj) { float a[8];
#pragma unroll
                    for (int j = 0; j < 4; ++j) { a[j] = ub(rr[m][bj].x, j) * __builtin_amdgcn_rcpf(ub(rr[m][bj].z, j)); a[4 + j] = ub(rr[m][bj].y, j) * __builtin_amdgcn_rcpf(ub(rr[m][bj].w, j)); }
#pragma unroll
                    for (int j = 0; j < 4; ++j) {
                        acc[ai][bj][m][0][j] = __int_as_float(__float2int_rn((float)__float_as_int(acc[ai][bj][m][0][j]) * (a[j] * (SQ_YB / SQ_YA))));
                        acc[ai][bj][m][1][j] = __int_as_float(__float2int_rn((float)__float_as_int(acc[ai][bj][m][1][j]) * (a[4 + j] * (SQ_YB / SQ_YA)))); } }
        }
    }
};
struct EMixF {
    struct Row { u32x2 g[2]; }; DI void load(const Unit& u, int row, int lc, Row& r) const { const unsigned char* p = (const unsigned char*)(Z + (size_t)row * NZ + ZRA) + 2 * (u.pn * 256 + lc) + 8; r.g[0] = *(const u32x2*)p; r.g[1] = *(const u32x2*)(p + 16); }
    struct Pre {}; DI void begin(const Unit&, int, Pre&) const {}
    const bf16* Z; unsigned char* MIX;
    DI void store(const Unit& u, int row, int lc, const float (&v0)[8], const float (&v1)[8], const Pre& pre, const Row& rd) const {
        u32x4 q16;
#pragma unroll
        for (int bj = 0; bj < 2; ++bj) {
            float g[8], o[8];
#pragma unroll
            for (int i = 0; i < 4; ++i) { g[i] = ub(rd.g[bj].x, i); g[4 + i] = ub(rd.g[bj].y, i); }
#pragma unroll
            for (int i = 0; i < 8; ++i) o[i] = g[i] * (bj ? v1[i] : v0[i]) * (1.f / (255.f * SQ_YB * SQ_WAB));
            if (bj == 0) { q16.x = pk4_i8(o[0], o[1], o[2], o[3], SQ_M); q16.y = pk4_i8(o[4], o[5], o[6], o[7], SQ_M); } else { q16.z = pk4_i8(o[0], o[1], o[2], o[3], SQ_M); q16.w = pk4_i8(o[4], o[5], o[6], o[7], SQ_M); }
        }
        *(u32x4*)(MIX + (size_t)row * D + u.pn * 256 + lc) = q16;
    }
};
struct EMixA {
    struct Row {}; DI void load(const Unit&, int, int, Row&) const {}
    struct Pre {}; DI void begin(const Unit&, int, Pre&) const {}
    float* MIXT; const bf16* Z;
    DI void store(const Unit& u, int row, int lc, const float (&v0)[8], const float (&v1)[8], const Pre& pre, const Row& rd) const {
#pragma unroll
        for (int bj = 0; bj < 2; ++bj) {
            const int col = u.pn * 256 + bj * 128 + lc; float g[8];
            unpack8(*(const u32x4*)(Z + (size_t)row * NZ + ZRA + col), g);
            float* p = MIXT + (size_t)row * D + col;
            f32x4 a, b;
#pragma unroll
            for (int i = 0; i < 4; ++i) { a[i] = g[i] * (bj ? v1[i] : v0[i]); b[i] = g[4 + i] * (bj ? v1[4 + i] : v0[4 + i]); }
            *(f32x4*)p = a; *(f32x4*)(p + 4) = b;
        }
    }
};
struct EMixB {
    struct Row {}; DI void load(const Unit&, int, int, Row&) const {}
    struct Pre {}; DI void begin(const Unit&, int, Pre&) const {}
    const float* MIXT; const bf16* Z; bf16* MIX;
    DI void store(const Unit& u, int row, int lc, const float (&v0)[8], const float (&v1)[8], const Pre& pre, const Row& rd) const {
#pragma unroll
        for (int bj = 0; bj < 2; ++bj) {
            const int col = u.pn * 256 + bj * 128 + lc; float g[8], o[8];
            unpack8(*(const u32x4*)(Z + (size_t)row * NZ + ZRB + col), g);
            const float* p = MIXT + (size_t)row * D + col;
            const f32x4 a = *(const f32x4*)p, b = *(const f32x4*)(p + 4);
#pragma unroll
            for (int i = 0; i < 4; ++i) { o[i] = a[i] + g[i] * (bj ? v1[i] : v0[i]); o[4 + i] = b[i] + g[4 + i] * (bj ? v1[4 + i] : v0[4 + i]); }
            *(u32x4*)(MIX + (size_t)row * D + col) = pack8(o);
        }
    }
};
struct EX1 {
    struct Row { f32x4 x[4]; }; DI void load(const Unit& u, int row, int lc, Row& r) const { const float* p = x + (size_t)row * D + u.pn * 256 + lc; r.x[0] = *(const f32x4*)p; r.x[1] = *(const f32x4*)(p + 4); r.x[2] = *(const f32x4*)(p + 8); r.x[3] = *(const f32x4*)(p + 12); }
    struct Pre {}; DI void begin(const Unit&, int, Pre&) const {}
    const float* x; bf16* X1; unsigned char* X18; float* SS1;
    DI void store(const Unit& u, int row, int lc, const float (&v0)[8], const float (&v1)[8], const Pre& pre, const Row& rd) const {
        u32x4 q16;
#pragma unroll
        for (int bj = 0; bj < 2; ++bj) {
            const int col = u.pn * 256 + bj * 8 + lc; float o[8];
            const f32x4 a = rd.x[2 * bj], b = rd.x[2 * bj + 1];
#pragma unroll
            for (int i = 0; i < 4; ++i) { o[i] = a[i] + (bj ? v1[i] : v0[i]) * (1.f / (SQ_M * SQ_W)); o[4 + i] = b[i] + (bj ? v1[4 + i] : v0[4 + i]) * (1.f / (SQ_M * SQ_W)); }
            *(u32x4*)(X1 + (size_t)row * D + col) = pack8(o);
            if (bj == 0) { q16.x = pk4_i8(o[0], o[1], o[2], o[3], SQ_X); q16.y = pk4_i8(o[4], o[5], o[6], o[7], SQ_X); } else { q16.z = pk4_i8(o[0], o[1], o[2], o[3], SQ_X); q16.w = pk4_i8(o[4], o[5], o[6], o[7], SQ_X); }
        }
        *(u32x4*)(X18 + (size_t)row * D + u.pn * 256 + lc) = q16;
    }
};
struct ESwiglu {
    struct Row { float rs; }; DI void load(const Unit&, int row, int, Row& r) const { r.rs = rowrs[row]; }
    typedef float f2 __attribute__((ext_vector_type(2)));
    struct Pre { f2 ba[4], bu[4]; };
    DI void begin(const Unit& u, int lc, Pre& p) const {
        const float* b = bgu + (size_t)u.e * 4096 + u.pn * 128 + lc;
#pragma unroll
        for (int i = 0; i < 4; ++i) { p.ba[i] = (f2){b[2 * i], b[2 * i + 1]}; p.bu[i] = (f2){b[2048 + 2 * i], b[2048 + 2 * i + 1]}; }
    }
    unsigned char* ACT; const float* rowrs; const float* bgu;
    DI void store(const Unit& u, int row, int lc, const float (&v0)[8], const float (&v1)[8], const Pre& pre, const Row& rd) const {
        const float rs = rd.rs * (1.f / (SQ_X * SQ_W));
        const int j = u.pn * 128 + lc; float o[8];
#pragma unroll
        for (int i = 0; i < 4; ++i) {
            f2 a = (f2){v0[2 * i], v0[2 * i + 1]} * rs + pre.ba[i], uu = (f2){v1[2 * i], v1[2 * i + 1]} * rs + pre.bu[i];
            a.x = fminf(a.x, 7.f); a.y = fminf(a.y, 7.f); uu.x = __builtin_amdgcn_fmed3f(uu.x, -7.f, 7.f); uu.y = __builtin_amdgcn_fmed3f(uu.y, -7.f, 7.f);
            const f2 z = a * (-1.702f * 1.44269504f);
            f2 e; e.x = __builtin_amdgcn_exp2f(z.x); e.y = __builtin_amdgcn_exp2f(z.y);
            const f2 d = e * (1.f / SC_ACT) + (1.f / SC_ACT);
            f2 r; r.x = __builtin_amdgcn_rcpf(d.x); r.y = __builtin_amdgcn_rcpf(d.y);
            const f2 at = a * r, ov = uu * at + at;
            o[2 * i] = ov.x; o[2 * i + 1] = ov.y;
        }
        u32x2 q8; q8.x = pk4_fp8(o[0], o[1], o[2], o[3]); q8.y = pk4_fp8(o[4], o[5], o[6], o[7]);
        *(u32x2*)(ACT + (size_t)row * DFF + j) = q8;
    }
};
template <bool P16> struct EDownT {
    struct Row { float g; }; DI void load(const Unit&, int row, int, Row& r) const { r.g = rowg[row]; }
    struct Pre { float b[2][8]; };
    DI void begin(const Unit& u, int lc, Pre& p) const {
#pragma unroll
        for (int bj = 0; bj < 2; ++bj)
#pragma unroll
            for (int i = 0; i < 8; ++i) p.b[bj][i] = bdn[(size_t)u.e * D + u.pn * 256 + bj * (P16 ? 8 : 128) + lc + i];
    }
    unsigned char* YB; const float* rowg; const float* bdn;
    DI void store(const Unit& u, int row, int lc, const float (&v0)[8], const float (&v1)[8], const Pre& pre, const Row& rd) const {
        const float g = rd.g * SC_Y;
        u32x4 q16;
#pragma unroll
        for (int bj = 0; bj < 2; ++bj) {
            const int col = u.pn * 256 + bj * 128 + lc; float o[8];
#pragma unroll
            for (int i = 0; i < 8; ++i) o[i] = clamp8(((bj ? v1[i] : v0[i]) * (1.f / (SC_ACT * SC_WDN)) + pre.b[bj][i]) * g);
            u32x2 q8; q8.x = pk4_fp8(o[0], o[1], o[2], o[3]); q8.y = pk4_fp8(o[4], o[5], o[6], o[7]);
            if constexpr (P16) { if (bj == 0) { q16.x = q8.x; q16.y = q8.y; } else { q16.z = q8.x; q16.w = q8.y; } }
            else *(u32x2*)(YB + (size_t)row * D + col) = q8;
        }
        if constexpr (P16) *(u32x4*)(YB + (size_t)row * D + u.pn * 256 + lc) = q16;
    }
};
typedef EDownT<true> EDown;
struct EPw {
    struct Row {}; DI void load(const Unit&, int, int, Row&) const {}
    struct Pre {}; DI void begin(const Unit&, int, Pre&) const {}
    bf16* PW;
    DI void store(const Unit& u, int row, int lc, const float (&v0)[8], const float (&v1)[8], const Pre& pre, const Row& rd) const {
        *(u32x4*)(PW + (size_t)row * D + u.pn * 256 + lc) = pack8(v0);
        *(u32x4*)(PW + (size_t)row * D + u.pn * 256 + 8 + lc) = pack8(v1);
    }
};
struct EGate {
    struct Row { float rs; u32x4 x2[2], pw[2]; }; DI void load(const Unit& u, int row, int lc, Row& r) const { r.rs = rs2[row]; const size_t o = (size_t)row * D + u.pn * 256 + lc; r.x2[0] = *(const u32x4*)(X2 + o); r.x2[1] = *(const u32x4*)(X2 + o + 8); r.pw[0] = *(const u32x4*)(PW + o); r.pw[1] = *(const u32x4*)(PW + o + 8); }
    struct Pre {}; DI void begin(const Unit&, int, Pre&) const {}
    const bf16* X2; const bf16* PW; const float* rs2; bf16* X3; float* SS3;
    DI void store(const Unit& u, int row, int lc, const float (&v0)[8], const float (&v1)[8], const Pre& pre, const Row& rd) const {
        const float rs = rd.rs * (1.f / (SQ_X * SQ_W));
#pragma unroll
        for (int bj = 0; bj < 2; ++bj) {
            const int col = u.pn * 256 + bj * 8 + lc; float pw[8], o[8];
            unpack8(rd.pw[bj], pw);
            float xv[8]; unpack8(rd.x2[bj], xv);
#pragma unroll
            for (int i = 0; i < 8; ++i) o[i] = xv[i] + pw[i] * sigm(rs * (bj ? v1[i] : v0[i]));
            *(u32x4*)(X3 + (size_t)row * D + col) = pack8(o);
        }
    }
};

struct Args {
    const float* in[25]; float* out; unsigned char* ws; int ph_lo, ph_hi;
};
enum { I_X = 0, I_P, I_NORM_MIX, I_W_IN, I_HGRN_LB, I_HGRN_NORM, I_CONV_W, I_CONV_B, I_B_I, I_B_F, I_MLSTM_NORM, I_W_BRA, I_W_BRB, I_W_OUT, I_NORM_MOE,
       I_ROUTER_W, I_ROUTER_B, I_W_GU, I_B_GU, I_W_DN, I_B_DN, I_NORM_PLE, I_W_PLE, I_W_PLE_GATE, I_NORM_FINAL };

struct Frame {
    LAS unsigned char* lds; int wave, G, bid;
    const float* const* in; float* out; unsigned char* ws;
    template <class Tp> DI Tp* p(size_t off) const { return (Tp*)(ws + off); }
};

constexpr int LDS_BYTES = 147456;
constexpr int LDS_MISC = 131072;

DI void tr_tile(const float* __restrict__ W, size_t ldw, int k0, int sc0, const float* __restrict__ kscale, bf16* __restrict__ dst, size_t drow0, int ldd, LAS unsigned* scr, int lane, int kd0 = -1) {
    if (kd0 < 0) kd0 = k0;
    const int a = lane & 15, b = lane >> 4;
    f32x4 v[16];
#pragma unroll
    for (int i = 0; i < 8; ++i) {
        const int k = k0 + 8 * i + 2 * b;
        v[2 * i] = *(const f32x4*)(W + (size_t)k * ldw + sc0 + 4 * a);
        v[2 * i + 1] = *(const f32x4*)(W + (size_t)(k + 1) * ldw + sc0 + 4 * a);
    }
#pragma unroll
    for (int i = 0; i < 8; ++i) {
        const int k = k0 + 8 * i + 2 * b;
        float s0 = 1.f, s1 = 1.f; if (kscale) { s0 = kscale[k]; s1 = kscale[k + 1]; }
#pragma unroll
        for (int c = 0; c < 4; ++c) scr[(4 * a + c) * 33 + 4 * i + b] = pk2(v[2 * i][c] * s0, v[2 * i + 1][c] * s1);
    }
    asm volatile("s_waitcnt lgkmcnt(0)" ::: "memory");
#pragma unroll
    for (int j = 0; j < 8; ++j) {
        const int n = (lane >> 3) + 8 * j, kc = lane & 7;
        u32x4 o; o.x = scr[n * 33 + 4 * kc]; o.y = scr[n * 33 + 4 * kc + 1]; o.z = scr[n * 33 + 4 * kc + 2]; o.w = scr[n * 33 + 4 * kc + 3];
        *(u32x4*)(dst + (drow0 + n) * (size_t)ldd + kd0 + 8 * kc) = o;
    }
    asm volatile("s_waitcnt lgkmcnt(0)" ::: "memory");
}

template <bool I8> DI void tr_tile8(const float* __restrict__ W, size_t ldw, int k0, int sc0, const float* __restrict__ kscale, float wscale, unsigned char* __restrict__ dst, size_t drow0, int ldd, LAS unsigned* scr, int lane) {
    const int a = lane & 15, b = lane >> 4;
    f32x4 v[16];
#pragma unroll
    for (int i = 0; i < 4; ++i)
#pragma unroll
        for (int r = 0; r < 4; ++r) v[4 * i + r] = *(const f32x4*)(W + (size_t)(k0 + 16 * i + 4 * b + r) * ldw + sc0 + 4 * a);
#pragma unroll
    for (int i = 0; i < 4; ++i) {
        const int k = k0 + 16 * i + 4 * b;
        float s0 = wscale, s1 = wscale, s2 = wscale, s3 = wscale; if (kscale) { s0 *= kscale[k]; s1 *= kscale[k + 1]; s2 *= kscale[k + 2]; s3 *= kscale[k + 3]; }
#pragma unroll
        for (int c = 0; c < 4; ++c) scr[(4 * a + c) * 17 + 4 * i + b] = I8 ? pk4_i8(v[4 * i][c] * s0, v[4 * i + 1][c] * s1, v[4 * i + 2][c] * s2, v[4 * i + 3][c] * s3, 1.f) : pk4_fp8(v[4 * i][c] * s0, v[4 * i + 1][c] * s1, v[4 * i + 2][c] * s2, v[4 * i + 3][c] * s3);
    }
    asm volatile("s_waitcnt lgkmcnt(0)" ::: "memory");
#pragma unroll
    for (int j = 0; j < 4; ++j) {
        const int n = (lane >> 2) + 16 * j, kc = lane & 3;
        u32x4 o; o.x = scr[n * 17 + 4 * kc]; o.y = scr[n * 17 + 4 * kc + 1]; o.z = scr[n * 17 + 4 * kc + 2]; o.w = scr[n * 17 + 4 * kc + 3];
        *(u32x4*)(dst + (drow0 + n) * (size_t)ldd + k0 + 16 * kc) = o;
    }
    asm volatile("s_waitcnt lgkmcnt(0)" ::: "memory");
}

DI void p0_prologue(const Frame& F) {
    const int lane = lane_id(), wave = F.wave, tid = wave * 64 + lane;
    const int gw = F.bid * 8 + wave, NGW = F.G * 8;
    {
        LAS unsigned* scr = (LAS unsigned*)(F.lds + wave * 8704);
        constexpr int TI_WIN = 32 * 176, TI_WA = 16 * 32, TI_WB = 16 * 32, TI_WOUT = 32 * 32, TI_WPG = 32 * 32, TI_WPLE = 4 * 32, TI_WGU = 32 * 2048, TI_WDN = 32 * 1024;
        constexpr int NTI = TI_WIN + TI_WA + TI_WB + TI_WOUT + TI_WPG + TI_WPLE;
        for (int it = gw; it < NTI; it += NGW) {
            int r = it;
            if (r < TI_WIN) { const int kb = r / 176, nb = r % 176, n0 = 64 * nb; int sc0 = n0 < 6144 ? n0 : n0 + 8;
                if (n0 >= 7168) { const int q = n0 - 7168, within = q & 255; sc0 = ((within >> 7) ? 9224 : 7176) + (q >> 8) * 128 + (within & 127); }
                tr_tile8<true>(F.in[I_W_IN], INCOLS, 64 * kb, sc0, F.in[I_NORM_MIX], SQ_W, F.p<unsigned char>(O_WIN), n0, D, scr, lane); continue; } r -= TI_WIN;
            if (r < TI_WA) { const int kb = r / 32, nb = r % 32; tr_tile8<true>(F.in[I_W_BRA], D, 64 * kb, 64 * nb, nullptr, SQ_WAB, F.p<unsigned char>(O_WA), 64 * nb, 2048, scr, lane); continue; } r -= TI_WA;
            if (r < TI_WB) { const int kb = r / 32, nb = r % 32; tr_tile8<true>(F.in[I_W_BRB], D, 64 * kb, 64 * nb, nullptr, SQ_WAB, F.p<unsigned char>(O_WA) + 1024, 64 * nb, 2048, scr, lane); continue; } r -= TI_WB;
            if (r < TI_WOUT) { const int kb = r / 32, nb = r % 32; tr_tile8<true>(F.in[I_W_OUT], D, 64 * kb, 64 * nb, nullptr, SQ_W, F.p<unsigned char>(O_WOUT), 64 * nb, D, scr, lane); continue; } r -= TI_WOUT;
            if (r < TI_WPG) { const int kb = r / 32, nb = r % 32; tr_tile8<true>(F.in[I_W_PLE_GATE], D, 64 * kb, 64 * nb, F.in[I_NORM_PLE], SQ_W, F.p<unsigned char>(O_WPG), 64 * nb, D, scr, lane); continue; } r -= TI_WPG;
            { const int kb = r / 32, nb = r % 32; tr_tile(F.in[I_W_PLE], D, 64 * kb, 64 * nb, nullptr, F.p<bf16>(O_WPLE), 64 * nb, PLE, scr, lane); }
            (void)r;
        }
    }
    __syncthreads();
    LAS float* W8 = (LAS float*)F.lds;
    for (int idx = tid; idx < 8 * D; idx += 512) { const int k = idx >> 3, j = idx & 7; W8[j * D + k] = F.in[I_W_IN][(size_t)k * INCOLS + 6144 + j] * F.in[I_NORM_MIX][k]; }
    __syncthreads();
    {
        const float* x = F.in[I_X]; bf16* XB = F.p<bf16>(O_XB); float* RS0 = F.p<float>(O_RS0); float* GT = F.p<float>(O_GATES);
        typedef float f2 __attribute__((ext_vector_type(2)));
        for (int m = gw; m < T; m += 2 * NGW) {
            const bool has1 = m + NGW < T; const int m1 = has1 ? m + NGW : m;
            const f32x4* xr0 = (const f32x4*)(x + (size_t)m * D) + lane; const f32x4* xr1 = (const f32x4*)(x + (size_t)m1 * D) + lane;
            f32x4 v0[8], v1[8]; float ss0 = 0.f, am0 = 0.f, ss1 = 0.f, am1 = 0.f;
#pragma unroll
            for (int j = 0; j < 8; ++j) v0[j] = xr0[64 * j];
#pragma unroll
            for (int j = 0; j < 8; ++j) v1[j] = xr1[64 * j];
#pragma unroll
            for (int j = 0; j < 8; ++j) { ss0 += (v0[j].x * v0[j].x + v0[j].y * v0[j].y) + (v0[j].z * v0[j].z + v0[j].w * v0[j].w);
                am0 = fmaxf(am0, fmaxf(fmaxf(fabsf(v0[j].x), fabsf(v0[j].y)), fmaxf(fabsf(v0[j].z), fabsf(v0[j].w)))); }
#pragma unroll
            for (int j = 0; j < 8; ++j) { ss1 += (v1[j].x * v1[j].x + v1[j].y * v1[j].y) + (v1[j].z * v1[j].z + v1[j].w * v1[j].w);
                am1 = fmaxf(am1, fmaxf(fmaxf(fabsf(v1[j].x), fabsf(v1[j].y)), fmaxf(fabsf(v1[j].z), fabsf(v1[j].w)))); }
            ss0 = wave_sum(ss0); am0 = wave_max(am0); ss1 = wave_sum(ss1); am1 = wave_max(am1);
            const float rstd0 = rsqrtf(ss0 * (1.f / D) + EPS), rstd1 = rsqrtf(ss1 * (1.f / D) + EPS);
            const float sx0 = am0 > 0.f ? 127.f / am0 : 1.f, sx1 = am1 > 0.f ? 127.f / am1 : 1.f;
            unsigned* o0 = (unsigned*)((unsigned char*)XB + (size_t)m * D) + lane; unsigned* o1 = (unsigned*)((unsigned char*)XB + (size_t)m1 * D) + lane;
#pragma unroll
            for (int j = 0; j < 8; ++j) o0[64 * j] = pk4_i8(v0[j].x, v0[j].y, v0[j].z, v0[j].w, sx0);
            if (has1) {
#pragma unroll
                for (int j = 0; j < 8; ++j) o1[64 * j] = pk4_i8(v1[j].x, v1[j].y, v1[j].z, v1[j].w, sx1); }
            float g0[8], g1[8];
            int lw = lane; asm volatile("" : "+v"(lw));
#pragma unroll
            for (int jj = 0; jj < 8; ++jj) { f2 a0 = {0.f, 0.f}, a1 = {0.f, 0.f};
#pragma unroll
                for (int j = 0; j < 8; ++j) { const f32x4 w = *(const LAS f32x4*)(W8 + jj * D + 4 * (lw + 64 * j)); const f2 wl = {w.x, w.y}, wh = {w.z, w.w};
                    a0 += (f2){v0[j].x, v0[j].y} * wl; a0 += (f2){v0[j].z, v0[j].w} * wh; a1 += (f2){v1[j].x, v1[j].y} * wl; a1 += (f2){v1[j].z, v1[j].w} * wh; }
                g0[jj] = wave_sum(a0.x + a0.y); g1[jj] = wave_sum(a1.x + a1.y); }
            if (lane == 0) { RS0[m] = rstd0 / sx0;
#pragma unroll
                for (int jj = 0; jj < 8; ++jj) GT[(size_t)m * 8 + jj] = rstd0 * g0[jj] + (jj < 4 ? F.in[I_B_I][jj] : F.in[I_B_F][jj - 4]);
                if (has1) { RS0[m1] = rstd1 / sx1;
#pragma unroll
                    for (int jj = 0; jj < 8; ++jj) GT[(size_t)m1 * 8 + jj] = rstd1 * g1[jj] + (jj < 4 ? F.in[I_B_I][jj] : F.in[I_B_F][jj - 4]); } }
        }
    }
    {
        const f32x4* p4 = (const f32x4*)F.in[I_P]; u32x2* o = (u32x2*)F.p<bf16>(O_PB);
        for (size_t i = (size_t)F.bid * 512 + tid; i < (size_t)T * PLE / 4; i += (size_t)F.G * 512) { const f32x4 v = p4[i]; u32x2 w; w.x = pk2(v.x, v.y); w.y = pk2(v.z, v.w); o[i] = w; }
    }
    {
        float* RWG = F.p<float>(O_RWG);
        for (int i = F.bid * 512 + tid; i < D * NE; i += F.G * 512) RWG[i] = F.in[I_ROUTER_W][i] * F.in[I_NORM_MOE][i >> 5];
    }
    __syncthreads();
}

DI void p7_route(const Frame& F) {
    constexpr int XP = 68;
    LAS float* XS = (LAS float*)F.lds;
    LAS float* LG = (LAS float*)(F.lds + 2 * 128 * XP * 4);
    LAS float* RSL = LG + 2 * 128 * 33;
    LAS int* HL = (LAS int*)(RSL + 128);
    const bf16* X1 = F.p<bf16>(O_X1); const float* RWG = F.p<float>(O_RWG);
    float* RS1 = F.p<float>(O_RS1); int* TOPE = F.p<int>(O_TOPE); float* TOPG = F.p<float>(O_TOPG); int* HIST = F.p<int>(O_HIST);
    const int lane = lane_id(), w = F.wave, tid = w * 64 + lane;
    for (int tg = F.bid; tg < T / 128; tg += F.G) {
        const int t0 = tg * 128;
        if (tid < 32) HL[tid] = 0;
        float ssr[2] = {0.f, 0.f};
        {
            const int g = w & 3, kh = w >> 2, m = lane & 31, hh = lane >> 5;
            const bf16* gsrc = X1 + (size_t)(t0 + (tid >> 3)) * D + 8 * (tid & 7);
            const int lofs = (tid >> 3) * XP + 8 * (tid & 7);
            u32x4 ra[2], rb[2], rc[2];
#define P7_LOAD(r, c) do { _Pragma("unroll") for (int j = 0; j < 2; ++j) r[j] = *(const u32x4*)(gsrc + (size_t)(64 * j) * D + 64 * (c)); } while (0)
#define P7_PARK(r, buf) do { _Pragma("unroll") for (int j = 0; j < 2; ++j) { float lv_[8]; unpack8(r[j], lv_); LAS float* d_ = XS + (buf) * 128 * XP + lofs + 64 * j * XP; \
                ssr[j] += ((lv_[0] * lv_[0] + lv_[1] * lv_[1]) + (lv_[2] * lv_[2] + lv_[3] * lv_[3])) + ((lv_[4] * lv_[4] + lv_[5] * lv_[5]) + (lv_[6] * lv_[6] + lv_[7] * lv_[7])); \
                *(LAS f32x4*)d_ = (f32x4){lv_[0], lv_[1], lv_[2], lv_[3]}; *(LAS f32x4*)(d_ + 4) = (f32x4){lv_[4], lv_[5], lv_[6], lv_[7]}; } } while (0)
            P7_LOAD(ra, 0); P7_LOAD(rb, 1); P7_LOAD(rc, 2);
            P7_PARK(ra, 0);
            __syncthreads();
            f32x16 acc;
#pragma unroll
            for (int i = 0; i < 16; ++i) acc[i] = 0.f;
            const LAS float* arow = XS + (32 * g + m) * XP + 32 * kh + 4 * hh;
            const float* brow = RWG + (size_t)(32 * kh + 4 * hh) * 32 + m;
#pragma unroll 1
            for (int c = 0; c < 32; c += 3) {
#define P7_STEP(cc, rcur_next, rload) do { if ((cc) < 32) { \
                    const LAS float* ar = arow + ((cc) & 1) * 128 * XP; const float* br = brow + (size_t)(64 * (cc)) * 32; \
                    float bq[16]; _Pragma("unroll") for (int q = 0; q < 16; ++q) bq[q] = br[(8 * (q >> 2) + (q & 3)) * 32];     \
                    if ((cc) + 3 < 32) P7_LOAD(rload, (cc) + 3); \
                    if ((cc) + 1 < 32) P7_PARK(rcur_next, ((cc) + 1) & 1); \
                    _Pragma("unroll") for (int jj = 0; jj < 4; ++jj) { const f32x4 a = *(const LAS f32x4*)(ar + 8 * jj); \
                        acc = __builtin_amdgcn_mfma_f32_32x32x2f32(a.x, bq[4 * jj + 0], acc, 0, 0, 0); acc = __builtin_amdgcn_mfma_f32_32x32x2f32(a.y, bq[4 * jj + 1], acc, 0, 0, 0); \
                        acc = __builtin_amdgcn_mfma_f32_32x32x2f32(a.z, bq[4 * jj + 2], acc, 0, 0, 0); acc = __builtin_amdgcn_mfma_f32_32x32x2f32(a.w, bq[4 * jj + 3], acc, 0, 0, 0); } \
                    __syncthreads(); } } while (0)
                P7_STEP(c, rb, ra); P7_STEP(c + 1, rc, rb); P7_STEP(c + 2, ra, rc);
            }
#undef P7_STEP
#undef P7_LOAD
#undef P7_PARK
#pragma unroll
            for (int i = 0; i < 16; ++i) { const int tok = 32 * g + (i & 3) + 8 * (i >> 2) + 4 * hh; LG[(kh * 128 + tok) * 33 + m] = acc[i]; }
#pragma unroll
            for (int j = 0; j < 2; ++j) { float a = ssr[j]; a += __shfl_xor(a, 1); a += __shfl_xor(a, 2); a += __shfl_xor(a, 4);
                if ((tid & 7) == 0) { const float rs = rsqrtf(a * (1.f / D) + EPS); RSL[64 * j + (tid >> 3)] = rs; RS1[t0 + 64 * j + (tid >> 3)] = rs; } }
        }
        __syncthreads();
        if (tid < 128) {
            const int tt = tid; const float rs = RSL[tt];
            LAS float* l0 = LG + tt * 33; const LAS float* l1 = LG + (128 + tt) * 33;
            for (int e = 0; e < 32; ++e) l0[e] = rs * (l0[e] + l1[e]) + F.in[I_ROUTER_B][e];
            float tv[4]; int te[4];
#pragma unroll
            for (int k = 0; k < 4; ++k) { float bv = -3.0e38f; int be = 0;
                for (int e = 0; e < 32; ++e) { const float v = l0[e]; if (v > bv) { bv = v; be = e; } }
                tv[k] = bv; te[k] = be; l0[be] = -3.3e38f; }
            float ex[4], sum = 0.f;
#pragma unroll
            for (int k = 0; k < 4; ++k) { ex[k] = __expf(tv[k] - tv[0]); sum += ex[k]; }
            const float inv = 1.f / sum;
#pragma unroll
            for (int k = 0; k < 4; ++k) { TOPE[(size_t)(t0 + tt) * 4 + k] = te[k]; TOPG[(size_t)(t0 + tt) * 4 + k] = ex[k] * inv; __hip_atomic_fetch_add(&HL[te[k]], 1, __ATOMIC_RELAXED, __HIP_MEMORY_SCOPE_WORKGROUP); }
        }
        __syncthreads();
        if (tid < 32) HIST[tg * 32 + tid] = HL[tid];
        __syncthreads();
    }
}

DI void p8_rows(const Frame& F) {
    LAS int* PT = (LAS int*)F.lds;
    LAS int* PB = PT + 512;
    LAS int* TOT = PB + 512;
    LAS int* BASE = TOT + 32;
    LAS int* PST = BASE + 32;
    LAS int* WCNT = PST + 40;
    const int* HIST = F.p<int>(O_HIST); const int* TOPE = F.p<int>(O_TOPE); const float* TOPG = F.p<float>(O_TOPG); const float* RS1 = F.p<float>(O_RS1);
    int* ROWTOK = F.p<int>(O_ROWTOK); float* ROWG = F.p<float>(O_ROWG); float* ROWRS = F.p<float>(O_ROWRS); int* SLOT = F.p<int>(O_SLOT); int* BLKE = F.p<int>(O_BLKE);
    const int lane = lane_id(), w = F.wave, tid = w * 64 + lane;
    for (int tg = F.bid; tg < T / 128; tg += F.G) {
        const int t0 = tg * 128;
        { const int e = tid & 31, part = tid >> 5; int pt = 0, pb = 0;
          for (int ww = part * 16; ww < part * 16 + 16; ++ww) { const int h = HIST[ww * 32 + e]; pt += h; if (ww < tg) pb += h; }
          PT[part * 32 + e] = pt; PB[part * 32 + e] = pb; }
        __syncthreads();
        if (tid < 32) { int a = 0, b = 0; for (int q = 0; q < 16; ++q) { a += PT[q * 32 + tid]; b += PB[q * 32 + tid]; } TOT[tid] = a; BASE[tid] = b; }
        __syncthreads();
        if (tid == 0) { int s = 0; for (int e = 0; e < 32; ++e) { PST[e] = s; s += (TOT[e] + 255) & ~255; } PST[32] = s; }
        __syncthreads();
        const int i = tid, t = t0 + (i >> 2), k = i & 3;
        const int ei = TOPE[(size_t)t * 4 + k];
        int lrank = 0, mycnt = 0;
        for (int e = 0; e < 32; ++e) { const unsigned long long mk = __ballot(ei == e); if (ei == e) lrank = __popcll(mk & ((1ull << lane) - 1ull)); if (lane == e) mycnt = __popcll(mk); }
        if (lane < 32) WCNT[w * 32 + lane] = mycnt;
        __syncthreads();
        int woff = 0; for (int ww = 0; ww < w; ++ww) woff += WCNT[ww * 32 + ei];
        const int row = PST[ei] + BASE[ei] + woff + lrank;
        ROWTOK[row] = t; ROWG[row] = TOPG[(size_t)t * 4 + k]; ROWRS[row] = RS1[t]; SLOT[(size_t)t * 4 + k] = row;
        if (tg < 32) { const int e = tg, padded = (TOT[e] + 255) & ~255; for (int r = TOT[e] + tid; r < padded; r += 512) { ROWTOK[PST[e] + r] = 0; ROWG[PST[e] + r] = 0.f; ROWRS[PST[e] + r] = 0.f; } }
        if (tg == 0) { for (int j = tid; j < NBMAX; j += 512) { int e = 31; for (int q = 0; q < 32; ++q) if (j * 256 >= PST[q] && j * 256 < PST[q + 1]) e = q; BLKE[j] = e; }
            if (tid == 0) BLKE[NBMAX] = PST[32] >> 8; }
        __syncthreads();
    }
}

DI void p11_token(const bf16* X1, const unsigned char* YB, bf16* X2, unsigned char* X28, float* RS2, int t, int r0, int r1, int r2, int r3, int lane) {
    const u32x2* xr = (const u32x2*)(X1 + (size_t)t * D) + lane;
    const unsigned* y0 = (const unsigned*)(YB + (size_t)r0 * D) + lane; const unsigned* y1 = (const unsigned*)(YB + (size_t)r1 * D) + lane;
    const unsigned* y2 = (const unsigned*)(YB + (size_t)r2 * D) + lane; const unsigned* y3 = (const unsigned*)(YB + (size_t)r3 * D) + lane;
    u32x2* xo = (u32x2*)(X2 + (size_t)t * D) + lane; unsigned* bo = (unsigned*)(X28 + (size_t)t * D) + lane;
    u32x2 xv[8]; unsigned ya[8], yb[8], yc[8], yd[8];
#pragma unroll
    for (int j = 0; j < 8; ++j) { xv[j] = xr[64 * j]; ya[j] = y0[64 * j]; yb[j] = y1[64 * j]; yc[j] = y2[64 * j]; yd[j] = y3[64 * j]; }
    float ss = 0.f;
#pragma unroll
    for (int j = 0; j < 8; ++j) {
        f32x4 v; v.x = bf2f(xv[j].x & 0xffffu); v.y = bf2f(xv[j].x >> 16); v.z = bf2f(xv[j].y & 0xffffu); v.w = bf2f(xv[j].y >> 16);
        const unsigned a = ya[j], b = yb[j], c = yc[j], d = yd[j];
        typedef float f2 __attribute__((ext_vector_type(2)));
        const f2 a0 = __builtin_amdgcn_cvt_pk_f32_fp8(a, false), a1 = __builtin_amdgcn_cvt_pk_f32_fp8(a, true), b0 = __builtin_amdgcn_cvt_pk_f32_fp8(b, false), b1 = __builtin_amdgcn_cvt_pk_f32_fp8(b, true);
        const f2 c0 = __builtin_amdgcn_cvt_pk_f32_fp8(c, false), c1 = __builtin_amdgcn_cvt_pk_f32_fp8(c, true), d0 = __builtin_amdgcn_cvt_pk_f32_fp8(d, false), d1 = __builtin_amdgcn_cvt_pk_f32_fp8(d, true);
        f32x4 sm;
        sm.x = ((a0.x + b0.x) + c0.x) + d0.x; sm.y = ((a0.y + b0.y) + c0.y) + d0.y; sm.z = ((a1.x + b1.x) + c1.x) + d1.x; sm.w = ((a1.y + b1.y) + c1.y) + d1.y;
        v = v + sm * (1.f / SC_Y);
        ss += (v.x * v.x + v.y * v.y) + (v.z * v.z + v.w * v.w);
        { u32x2 xw; xw.x = pk2(v.x, v.y); xw.y = pk2(v.z, v.w); xo[64 * j] = xw; } bo[64 * j] = pk4_i8(v.x, v.y, v.z, v.w, SQ_X);
    }
    ss = wave_sum(ss);
    if (lane == 0) RS2[t] = rsqrtf(ss * (1.f / D) + EPS);
}
DI void p11_combine(const Frame& F) {
    const bf16* X1 = F.p<bf16>(O_X1); const unsigned char* YB = F.p<unsigned char>(O_YBUF); const int* SLOT = F.p<int>(O_SLOT);
    bf16* X2 = F.p<bf16>(O_X2); unsigned char* X28 = F.p<unsigned char>(O_X2B); float* RS2 = F.p<float>(O_RS2);
    const int lane = lane_id(), gw = F.bid * 8 + F.wave, NGW = F.G * 8;
    for (int tb = gw; tb < T; tb += 16 * NGW) {
        const int tl = tb + (lane >> 2) * NGW;
        const int myslot = tl < T ? SLOT[(size_t)tl * 4 + (lane & 3)] : 0;
#pragma unroll 2
        for (int q = 0; q < 16; ++q) {
            const int t = tb + q * NGW;
            const int r0 = __shfl(myslot, 4 * q), r1 = __shfl(myslot, 4 * q + 1), r2 = __shfl(myslot, 4 * q + 2), r3 = __shfl(myslot, 4 * q + 3);
            if (t < T) p11_token(X1, YB, X2, X28, RS2, t, r0, r1, r2, r3, lane);
        }
    }
}

DI void p13_final(const Frame& F) {
    const float* g = F.in[I_NORM_FINAL]; const bf16* X3 = F.p<bf16>(O_X3);
    const int lane = lane_id(), gw = F.bid * 8 + F.wave, NGW = F.G * 8;
    for (int t = gw; t < T; t += NGW) {
        const u32x2* xi = (const u32x2*)(X3 + (size_t)t * D) + lane; f32x4* o = (f32x4*)(F.out + (size_t)t * D) + lane; const f32x4* g4 = (const f32x4*)g + lane;
        u32x2 xa[8];
#pragma unroll
        for (int j = 0; j < 8; ++j) xa[j] = xi[64 * j];
        float a = 0.f;
#pragma unroll
        for (int j = 0; j < 8; ++j) { const float v0 = bf2f(xa[j].x & 0xffffu), v1 = bf2f(xa[j].x >> 16), v2 = bf2f(xa[j].y & 0xffffu), v3 = bf2f(xa[j].y >> 16); a += (v0 * v0 + v1 * v1) + (v2 * v2 + v3 * v3); }
        a = wave_sum(a);
        const float rstd = rsqrtf(a * (1.f / D) + EPS);
#pragma unroll
        for (int j = 0; j < 8; ++j) { const u32x2 xw = xa[j]; const f32x4 gg = g4[64 * j]; f32x4 v;
            v.x = bf2f(xw.x & 0xffffu) * rstd * gg.x; v.y = bf2f(xw.x >> 16) * rstd * gg.y; v.z = bf2f(xw.y & 0xffffu) * rstd * gg.z; v.w = bf2f(xw.y >> 16) * rstd * gg.w; o[64 * j] = v; }
    }
}

DI bf16x8 fragL(const LAS bf16* base, int pitch, int row, int k) { return *(const LAS bf16x8*)(base + row * pitch + k); }
DI bf16x8 fragG(const bf16* base, int pitch, int row, int k) { return *(const bf16x8*)(base + (size_t)row * pitch + k); }
DI bf16x8 frag8cvt(const u32x2 w) {
    typedef float f2 __attribute__((ext_vector_type(2)));
    const f2 a = __builtin_amdgcn_cvt_pk_f32_fp8(w.x, false), b = __builtin_amdgcn_cvt_pk_f32_fp8(w.x, true), c = __builtin_amdgcn_cvt_pk_f32_fp8(w.y, false), d = __builtin_amdgcn_cvt_pk_f32_fp8(w.y, true);
    u32x4 o; o.x = pk2c(a.x, a.y); o.y = pk2c(b.x, b.y); o.z = pk2c(c.x, c.y); o.w = pk2c(d.x, d.y);
    return __builtin_bit_cast(bf16x8, o);
}
DI bf16x8 fragG8(const unsigned char* base, int pitch, int row, int k) {
    typedef float f2 __attribute__((ext_vector_type(2)));
    const u32x2 w = *(const u32x2*)(base + (size_t)row * pitch + k);
    const f2 a = __builtin_amdgcn_cvt_pk_f32_fp8(w.x, false), b = __builtin_amdgcn_cvt_pk_f32_fp8(w.x, true), c = __builtin_amdgcn_cvt_pk_f32_fp8(w.y, false), d = __builtin_amdgcn_cvt_pk_f32_fp8(w.y, true);
    u32x4 o; o.x = pk2c(a.x, a.y); o.y = pk2c(b.x, b.y); o.z = pk2c(c.x, c.y); o.w = pk2c(d.x, d.y);
    return __builtin_bit_cast(bf16x8, o);
}
DI int prow(int i, int nf) { return 8 * (i >> 2) + 4 * nf + (i & 3); }
#define MFMA16(b, a, c) __builtin_amdgcn_mfma_f32_16x16x32_bf16((b), (a), (c), 0, 0, 0)
DI float incl_scan_add(float v, int lane) {
#pragma unroll
    for (int o = 1; o < 64; o <<= 1) { const float t = __shfl_up(v, o); if (lane >= o) v += t; }
    return v;
}
DI float incl_scan_max(float v, int lane) {
#pragma unroll
    for (int o = 1; o < 64; o <<= 1) { const float t = __shfl_up(v, o); if (lane >= o) v = fmaxf(v, t); }
    return v;
}
DI void store16bf(LAS bf16* p, const float (&v)[16]) {
    u32x4 a, b; a.x = pk2c(v[0], v[1]); a.y = pk2c(v[2], v[3]); a.z = pk2c(v[4], v[5]); a.w = pk2c(v[6], v[7]);
    b.x = pk2c(v[8], v[9]); b.y = pk2c(v[10], v[11]); b.z = pk2c(v[12], v[13]); b.w = pk2c(v[14], v[15]);
    *(LAS u32x4*)p = a; *(LAS u32x4*)(p + 8) = b;
}
constexpr int PK = 72, PD = 136;

struct WTile { const float* W; size_t ldw; int k0, sc0; const float* ks; float wsc; unsigned char* dst; size_t drow0; int ldd; int q8; };
constexpr int NWT_GU = NE * 2048, NWT_DN = NE * 1024, NWT = NWT_GU + NWT_DN;
DI WTile wtile_decode(const Frame& F, int r) {
    WTile t;
    if (r < NWT_GU) { const int e = r / 2048, rr = r % 2048, kb = rr / 64, nb = rr % 64, c0 = 64 * nb, j0 = c0 & 2047, part = c0 >> 11;
        t.W = F.in[I_W_GU] + (size_t)e * D * 4096; t.ldw = 4096; t.k0 = 64 * kb; t.sc0 = c0; t.ks = F.in[I_NORM_MOE]; t.wsc = SQ_W; t.q8 = 1; t.dst = F.p<unsigned char>(O_WGU); t.drow0 = (size_t)e * 4096 + (j0 >> 7) * 256 + part * 128 + (j0 & 127); t.ldd = D; }
    else { r -= NWT_GU; const int e = r / 1024, rr = r % 1024, kb = rr / 32, nb = rr % 32;
        t.W = F.in[I_W_DN] + (size_t)e * DFF * D; t.ldw = D; t.k0 = 64 * kb; t.sc0 = 64 * nb; t.ks = nullptr; t.wsc = SC_WDN; t.q8 = 0; t.dst = F.p<unsigned char>(O_WDN); t.drow0 = (size_t)e * D + 64 * nb; t.ldd = DFF; }
    return t;
}
DI void wtile_load(const WTile& t, int lane, f32x4 (&v)[16], f32x4 (&g)[4]) {
    const int a = lane & 15, b = lane >> 4;
#pragma unroll
    for (int i = 0; i < 4; ++i) g[i] = t.ks ? *(const f32x4*)(t.ks + t.k0 + 16 * i + 4 * b) : (f32x4){1.f, 1.f, 1.f, 1.f};
#pragma unroll
    for (int i = 0; i < 4; ++i)
#pragma unroll
        for (int r = 0; r < 4; ++r) v[4 * i + r] = *(const f32x4*)(t.W + (size_t)(t.k0 + 16 * i + 4 * b + r) * t.ldw + t.sc0 + 4 * a);
}
DI void wtile_finish(const WTile& t, int lane, const f32x4 (&v)[16], const f32x4 (&g)[4], LAS unsigned* scr) {
    const int a = lane & 15, b = lane >> 4;
#pragma unroll
    for (int i = 0; i < 4; ++i) {
        const float s0 = t.wsc * g[i].x, s1 = t.wsc * g[i].y, s2 = t.wsc * g[i].z, s3 = t.wsc * g[i].w;
#pragma unroll
        for (int c = 0; c < 4; ++c) scr[(4 * a + c) * 17 + 4 * i + b] = t.q8 ? pk4_i8(v[4 * i][c] * s0, v[4 * i + 1][c] * s1, v[4 * i + 2][c] * s2, v[4 * i + 3][c] * s3, 1.f) : pk4_fp8(v[4 * i][c] * s0, v[4 * i + 1][c] * s1, v[4 * i + 2][c] * s2, v[4 * i + 3][c] * s3);
    }
    asm volatile("s_waitcnt lgkmcnt(0)" ::: "memory");
#pragma unroll
    for (int j = 0; j < 4; ++j) {
        const int n = (lane >> 2) + 16 * j, kc = lane & 3;
        u32x4 o; o.x = scr[n * 17 + 4 * kc]; o.y = scr[n * 17 + 4 * kc + 1]; o.z = scr[n * 17 + 4 * kc + 2]; o.w = scr[n * 17 + 4 * kc + 3];
        *(u32x4*)(t.dst + (t.drow0 + n) * (size_t)t.ldd + t.k0 + 16 * kc) = o;
    }
    asm volatile("s_waitcnt lgkmcnt(0)" ::: "memory");
}
constexpr int PL = 132;
constexpr int PV = 264;
constexpr int MISC_F = LDS_MISC + 256;
DI void hgrn_a_item(const Frame& F, int it, int lane, int w, int tid, const bool hasw, const WTile& wt, f32x4 (&wv)[16], f32x4 (&wg)[4]) {
    const int h = it & 7; const size_t t0 = (size_t)(it >> 3) * 64;
    LAS bf16* TK = (LAS bf16*)F.lds; LAS bf16* TV = TK + 64 * PD; LAS float* TL = (LAS float*)(TV + 64 * PD); LAS bf16* KT = (LAS bf16*)(TL + 64 * PL); LAS bf16* VT = KT + 128 * PK;
    LAS float* SEGT = (LAS float*)(F.lds + MISC_F);
    const bf16* Z = F.p<bf16>(O_Z); const bf16* LF = F.p<bf16>(O_LF);
    {
        u32x4 rk[2], rv[2]; u32x4 rl[2];
#pragma unroll
        for (int j = 0; j < 2; ++j) { const int i = tid + 512 * j, row = i >> 4, c8 = i & 15; const bf16* g = Z + (t0 + row) * NZ + h * 128 + c8 * 8; rk[j] = *(const u32x4*)(g + ZKA); rv[j] = *(const u32x4*)(g + ZVA); }
#pragma unroll
        for (int j = 0; j < 2; ++j) { const int i = tid + 512 * j, row = i >> 4, c8 = i & 15; rl[j] = *(const u32x4*)(LF + (t0 + row) * 1024 + h * 128 + c8 * 8); }
        if (hasw) wtile_load(wt, lane, wv, wg);
#pragma unroll
        for (int j = 0; j < 2; ++j) { const int i = tid + 512 * j, row = i >> 4, c8 = i & 15; *(LAS u32x4*)(TK + row * PD + c8 * 8) = rk[j]; *(LAS u32x4*)(TV + row * PD + c8 * 8) = rv[j]; }
#pragma unroll
        for (int j = 0; j < 2; ++j) { const int i = tid + 512 * j, row = i >> 4, c8 = i & 15; float lv[8]; unpack8(rl[j], lv); *(LAS f32x4*)(TL + row * PL + c8 * 8) = (f32x4){lv[0], lv[1], lv[2], lv[3]}; *(LAS f32x4*)(TL + row * PL + c8 * 8 + 4) = (f32x4){lv[4], lv[5], lv[6], lv[7]}; }
    }
    __syncthreads();
    const int c = tid & 127, seg = tid >> 7;
    float cs[16]; float run = 0.f;
#pragma unroll
    for (int i = 0; i < 16; ++i) { run += TL[(16 * seg + i) * PL + c]; cs[i] = run; }
    SEGT[seg * 128 + c] = run;
    float kk[16], vv[16];
#pragma unroll
    for (int i = 0; i < 16; ++i) { kk[i] = bf2f(TK[(16 * seg + i) * PD + c]); vv[i] = bf2f(TV[(16 * seg + i) * PD + c]); }
    __syncthreads();
    float pre = 0.f, tot = 0.f;
#pragma unroll
    for (int q = 0; q < 4; ++q) { const float v = SEGT[q * 128 + c]; tot += v; if (q < seg) pre += v; }
#pragma unroll
    for (int i = 0; i < 16; ++i) kk[i] *= __expf(tot - (pre + cs[i]));
    store16bf(KT + c * PK + 16 * seg, kk); store16bf(VT + c * PK + 16 * seg, vv);
    if (seg == 0) F.p<float>(O_DEC)[(size_t)it * 128 + c] = __expf(tot);
    __syncthreads();
    const int fr = lane & 15, fq = lane >> 4, e0 = 16 * w;
    f32x4 acc[8];
#pragma unroll
    for (int i = 0; i < 8; ++i) acc[i] = (f32x4){0.f, 0.f, 0.f, 0.f};
#pragma unroll
    for (int ks = 0; ks < 2; ++ks) {
        const bf16x8 a = fragL(VT, PK, e0 + fr, 32 * ks + 8 * fq);
#pragma unroll
        for (int p = 0; p < 4; ++p)
#pragma unroll
            for (int nf = 0; nf < 2; ++nf) { const bf16x8 b = fragL(KT, PK, 32 * p + prow(fr, nf), 32 * ks + 8 * fq); acc[2 * p + nf] = MFMA16(b, a, acc[2 * p + nf]); }
    }
    unsigned char* U = F.p<unsigned char>(O_UST) + ((size_t)it * 128 + e0 + fr) * 128 + 8 * fq;
#pragma unroll
    for (int p = 0; p < 4; ++p) { u32x2 q8;
        q8.x = pk4_fp8(clamp8(acc[2 * p][0] * SC_U), clamp8(acc[2 * p][1] * SC_U), clamp8(acc[2 * p][2] * SC_U), clamp8(acc[2 * p][3] * SC_U));
        q8.y = pk4_fp8(clamp8(acc[2 * p + 1][0] * SC_U), clamp8(acc[2 * p + 1][1] * SC_U), clamp8(acc[2 * p + 1][2] * SC_U), clamp8(acc[2 * p + 1][3] * SC_U));
        *(u32x2*)(U + 32 * p) = q8; }
    __syncthreads();
}

DI void raw67_load(const bf16* Z, size_t t0, int n, int col0, int tid, u32x4 (&r)[3]) {
#pragma unroll
    for (int j = 0; j < 3; ++j) { const int i = tid + 512 * j, row = i >> 4, c8 = i & 15; r[j] = (u32x4){0u, 0u, 0u, 0u};
        if (i < 67 * 16 && (n > 0 || row >= 3)) r[j] = *(const u32x4*)(Z + (t0 + row - 3) * NZ + col0 + c8 * 8); }
}
DI void raw67_store(LAS bf16* dst, int tid, const u32x4 (&r)[3]) {
#pragma unroll
    for (int j = 0; j < 3; ++j) { const int i = tid + 512 * j, row = i >> 4, c8 = i & 15; if (i < 67 * 16) *(LAS u32x4*)(dst + row * PD + c8 * 8) = r[j]; }
}
DI void conv16L(const LAS bf16* raw, int l0, int d, int ch, const float* cw, const float* cb, float (&o)[16]) {
    const float w0 = cw[ch], w1 = cw[1024 + ch], w2 = cw[2048 + ch], w3 = cw[3072 + ch], b = cb[ch];
    float u0 = bf2f(raw[(l0) * PD + d]), u1 = bf2f(raw[(l0 + 1) * PD + d]), u2 = bf2f(raw[(l0 + 2) * PD + d]);
#pragma unroll
    for (int i = 0; i < 16; ++i) { const float u3 = bf2f(raw[(l0 + 3 + i) * PD + d]); const float cv = b + u0 * w0 + u1 * w1 + u2 * w2 + u3 * w3; o[i] = cv * sigm(cv); u0 = u1; u1 = u2; u2 = u3; }
}
DI void conv16(const bf16* Z, size_t t0, int s0  , int ch, const float* cw, const float* cb, float (&o)[16]) {
    const float w0 = cw[ch], w1 = cw[1024 + ch], w2 = cw[2048 + ch], w3 = cw[3072 + ch], b = cb[ch];
    float u0 = s0 >= 3 ? bf2f(Z[(t0 - 3) * NZ + ZQK + ch]) : 0.f, u1 = s0 >= 2 ? bf2f(Z[(t0 - 2) * NZ + ZQK + ch]) : 0.f, u2 = s0 >= 1 ? bf2f(Z[(t0 - 1) * NZ + ZQK + ch]) : 0.f;
#pragma unroll
    for (int i = 0; i < 16; ++i) { const float u3 = bf2f(Z[(t0 + i) * NZ + ZQK + ch]); const float cv = b + u0 * w0 + u1 * w1 + u2 * w2 + u3 * w3; o[i] = cv * sigm(cv); u0 = u1; u1 = u2; u2 = u3; }
}

DI void mlstm_a_item(const Frame& F, int it, int lane, int w, int tid, const bool hasw, const WTile& wt, f32x4 (&wv)[16], f32x4 (&wg)[4]) {
    const int h = it & 3, bn = it >> 2, n = bn & 127; const size_t t0 = (size_t)bn * 64;
    LAS bf16* TR = (LAS bf16*)F.lds; LAS bf16* TV = TR + 68 * PD; LAS bf16* KT = TV + 64 * PV; LAS bf16* VT = KT + 128 * PK;
    LAS float* NP = (LAS float*)(F.lds + MISC_F); LAS float* WE = NP + 512;
    const bf16* Z = F.p<bf16>(O_Z); const float* GT = F.p<float>(O_GATES);
    {
        u32x4 rv[4], rr[3];
#pragma unroll
        for (int j = 0; j < 4; ++j) { const int i = tid + 512 * j, row = i >> 5, c8 = i & 31; rv[j] = *(const u32x4*)(Z + (t0 + row) * NZ + ZVB + h * 256 + c8 * 8); }
        raw67_load(Z, t0, n, ZQK + 512 + h * 128, tid, rr);
        const float ip = GT[(t0 + lane) * 8 + h], fpre = GT[(t0 + lane) * 8 + 4 + h];
        if (hasw) wtile_load(wt, lane, wv, wg);
        {
            const float lf = log_sigmoid(fpre);
            const float fc = incl_scan_add(lf, lane), gt = __shfl(fc, 63);
            const float ae = gt - fc + ip, ml = wave_max(ae);
            if (w == 0) { WE[lane] = __expf(ae - ml); if (lane == 0) { F.p<float>(O_MLOC)[it] = ml; F.p<float>(O_GTOT)[it] = gt; } }
        }
        raw67_store(TR, tid, rr);
#pragma unroll
        for (int j = 0; j < 4; ++j) { const int i = tid + 512 * j, row = i >> 5, c8 = i & 31; *(LAS u32x4*)(TV + row * PV + c8 * 8) = rv[j]; }
    }
    __syncthreads();
    const int d = tid & 127, seg = tid >> 7;
    float kk[16];
    conv16L(TR, 16 * seg, d, 512 + h * 128 + d, F.in[I_CONV_W], F.in[I_CONV_B], kk);
    float np = 0.f;
#pragma unroll
    for (int i = 0; i < 16; ++i) { kk[i] *= 0.08838834764831845f * WE[16 * seg + i]; np += kk[i]; }
    NP[seg * 128 + d] = np;
    store16bf(KT + d * PK + 16 * seg, kk);
    {
        const int ev = tid & 255, hv = tid >> 8; float v0[16], v1[16];
#pragma unroll
        for (int i = 0; i < 16; ++i) { v0[i] = bf2f(TV[(32 * hv + i) * PV + ev]); v1[i] = bf2f(TV[(32 * hv + 16 + i) * PV + ev]); }
        store16bf(VT + ev * PK + 32 * hv, v0); store16bf(VT + ev * PK + 32 * hv + 16, v1);
    }
    __syncthreads();
    if (tid < 128) F.p<float>(O_NL)[(size_t)it * 128 + tid] = (NP[tid] + NP[128 + tid]) + (NP[256 + tid] + NP[384 + tid]);
    const int fr = lane & 15, fq = lane >> 4;
    f32x4 acc[2][8];
#pragma unroll
    for (int m = 0; m < 2; ++m)
#pragma unroll
        for (int i = 0; i < 8; ++i) acc[m][i] = (f32x4){0.f, 0.f, 0.f, 0.f};
#pragma unroll
    for (int ks = 0; ks < 2; ++ks) {
        const bf16x8 a0 = fragL(VT, PK, 32 * w + fr, 32 * ks + 8 * fq), a1 = fragL(VT, PK, 32 * w + 16 + fr, 32 * ks + 8 * fq);
#pragma unroll
        for (int p = 0; p < 4; ++p)
#pragma unroll
            for (int nf = 0; nf < 2; ++nf) { const bf16x8 b = fragL(KT, PK, 32 * p + prow(fr, nf), 32 * ks + 8 * fq); acc[0][2 * p + nf] = MFMA16(b, a0, acc[0][2 * p + nf]); acc[1][2 * p + nf] = MFMA16(b, a1, acc[1][2 * p + nf]); }
    }
#pragma unroll
    for (int m = 0; m < 2; ++m) {
        unsigned char* Cp = F.p<unsigned char>(O_CT) + ((size_t)it * 256 + 32 * w + 16 * m + fr) * 128 + 8 * fq;
#pragma unroll
        for (int p = 0; p < 4; ++p) { u32x2 q8;
            q8.x = pk4_fp8(clamp8(acc[m][2 * p][0] * SC_C), clamp8(acc[m][2 * p][1] * SC_C), clamp8(acc[m][2 * p][2] * SC_C), clamp8(acc[m][2 * p][3] * SC_C));
            q8.y = pk4_fp8(clamp8(acc[m][2 * p + 1][0] * SC_C), clamp8(acc[m][2 * p + 1][1] * SC_C), clamp8(acc[m][2 * p + 1][2] * SC_C), clamp8(acc[m][2 * p + 1][3] * SC_C));
            *(u32x2*)(Cp + 32 * p) = q8; }
    }
    __syncthreads();
}

DI void scan_phase(const Frame& F) {
    const int lane = lane_id(), tid = F.wave * 64 + lane;
    for (int g = F.bid * 512 + tid; g < 131072; g += F.G * 512) {
        {
            const int c4 = g & 31, e = (g >> 5) & 127, bh = g >> 12, b = bh >> 3, h = bh & 7;
            float S0 = 0.f, S1 = 0.f, S2 = 0.f, S3 = 0.f;
            unsigned char* U = F.p<unsigned char>(O_UST); const float* DC = F.p<float>(O_DEC);
            typedef float f2 __attribute__((ext_vector_type(2)));
            for (int n0 = 0; n0 < 128; n0 += 16) {
                unsigned uu[16]; f32x4 dc[16];
#pragma unroll
                for (int j = 0; j < 16; ++j) { const size_t it = (size_t)(b * 128 + n0 + j) * 8 + h; uu[j] = *(const unsigned*)(U + (it * 128 + e) * 128 + c4 * 4); dc[j] = *(const f32x4*)(DC + it * 128 + c4 * 4); }
#pragma unroll
                for (int j = 0; j < 16; ++j) { const size_t it = (size_t)(b * 128 + n0 + j) * 8 + h;
                    *(unsigned*)(U + (it * 128 + e) * 128 + c4 * 4) = pk4_fp8(clamp8(S0), clamp8(S1), clamp8(S2), clamp8(S3));
                    const f2 lo = __builtin_amdgcn_cvt_pk_f32_fp8(uu[j], false), hi = __builtin_amdgcn_cvt_pk_f32_fp8(uu[j], true);
                    S0 = dc[j].x * S0 + lo.x; S1 = dc[j].y * S1 + lo.y; S2 = dc[j].z * S2 + hi.x; S3 = dc[j].w * S3 + hi.y; }
            }
        }
        {
            const int d4 = g & 31, e = (g >> 5) & 255, bh = g >> 13, b = bh >> 2, h = bh & 3;
            float C0 = 0.f, C1 = 0.f, C2 = 0.f, C3 = 0.f, mrun = -1e30f; f32x4 nn = (f32x4){0.f, 0.f, 0.f, 0.f};
            unsigned char* CT = F.p<unsigned char>(O_CT); float* NL = F.p<float>(O_NL); const float* GTOT = F.p<float>(O_GTOT); const float* MLOC = F.p<float>(O_MLOC); float* MST = F.p<float>(O_MST);
            typedef float f2 __attribute__((ext_vector_type(2)));
            for (int n0 = 0; n0 < 128; n0 += 16) {
                unsigned cl[16]; float gt[16], ml[16];
#pragma unroll
                for (int j = 0; j < 16; ++j) { const size_t it = (size_t)(b * 128 + n0 + j) * 4 + h; cl[j] = *(const unsigned*)(CT + (it * 256 + e) * 128 + d4 * 4); gt[j] = GTOT[it]; ml[j] = MLOC[it]; }
#pragma unroll
                for (int j = 0; j < 16; ++j) { const size_t it = (size_t)(b * 128 + n0 + j) * 4 + h;
                    const float mnew = fmaxf(gt[j] + mrun, ml[j]), sp = __expf(gt[j] + mrun - mnew), sl = __expf(ml[j] - mnew);
                    *(unsigned*)(CT + (it * 256 + e) * 128 + d4 * 4) = pk4_fp8(clamp8(C0), clamp8(C1), clamp8(C2), clamp8(C3));
                    const f2 lo = __builtin_amdgcn_cvt_pk_f32_fp8(cl[j], false), hi = __builtin_amdgcn_cvt_pk_f32_fp8(cl[j], true);
                    C0 = sp * C0 + sl * lo.x; C1 = sp * C1 + sl * lo.y; C2 = sp * C2 + sl * hi.x; C3 = sp * C3 + sl * hi.y;
                    if (e == 0) { f32x4* q = (f32x4*)(NL + it * 128 + d4 * 4); const f32x4 nl = *q; *q = nn; nn = sp * nn + sl * nl; if (d4 == 0) MST[it] = mrun; }
                    mrun = mnew; }
            }
        }
    }
}

DI void hgrn_c_item(const Frame& F, int it, int lane, int w, int tid, const bool hasw, const WTile& wt, f32x4 (&wv)[16], f32x4 (&wg)[4]) {
    const int h = it & 7; const size_t t0 = (size_t)(it >> 3) * 64;
    LAS bf16* Qs = (LAS bf16*)F.lds; LAS bf16* Ks = Qs + 64 * PD; LAS bf16* Qh = Ks + 64 * PD; LAS bf16* TV = Qh + 64 * PD; LAS bf16* VT = TV + 64 * PD;
    LAS float* TL = (LAS float*)(VT + 128 * PK); LAS bf16* Pm = (LAS bf16*)TL;
    LAS float* SEGT = (LAS float*)(F.lds + MISC_F); LAS float* BREF = SEGT + 512; LAS float* RED = BREF + 128;
    const bf16* Z = F.p<bf16>(O_Z); const bf16* LF = F.p<bf16>(O_LF);
    u32x2 stf[4][2][2]; u32x4 gaw[2];
    {
        u32x4 rq[2], rk[2], rv[2]; u32x4 rl[2];
#pragma unroll
        for (int j = 0; j < 2; ++j) { const int i = tid + 512 * j, row = i >> 4, c8 = i & 15; const bf16* g = Z + (t0 + row) * NZ + h * 128 + c8 * 8; rq[j] = *(const u32x4*)(g + ZQA); rk[j] = *(const u32x4*)(g + ZKA); rv[j] = *(const u32x4*)(g + ZVA); }
#pragma unroll
        for (int j = 0; j < 2; ++j) { const int i = tid + 512 * j, row = i >> 4, c8 = i & 15; rl[j] = *(const u32x4*)(LF + (t0 + row) * 1024 + h * 128 + c8 * 8); }
        {
            const int fr_ = lane & 15, fq_ = lane >> 4, nh_ = w >> 2, mf_ = w & 3;
            const unsigned char* STp = F.p<unsigned char>(O_UST) + (size_t)it * 128 * 128;
#pragma unroll
            for (int ks = 0; ks < 4; ++ks)
#pragma unroll
                for (int p = 0; p < 2; ++p)
#pragma unroll
                    for (int nf = 0; nf < 2; ++nf) stf[ks][p][nf] = *(const u32x2*)(STp + (size_t)(64 * nh_ + 32 * p + prow(fr_, nf)) * 128 + 32 * ks + 8 * fq_);
#pragma unroll
            for (int p = 0; p < 2; ++p) gaw[p] = *(const u32x4*)(Z + (t0 + 16 * mf_ + fr_) * NZ + ZGA + h * 128 + 64 * nh_ + 32 * p + 8 * fq_);
        }
        if (hasw) wtile_load(wt, lane, wv, wg);
#pragma unroll
        for (int j = 0; j < 2; ++j) { const int i = tid + 512 * j, row = i >> 4, c8 = i & 15; *(LAS u32x4*)(Qs + row * PD + c8 * 8) = rq[j]; *(LAS u32x4*)(Ks + row * PD + c8 * 8) = rk[j]; *(LAS u32x4*)(TV + row * PD + c8 * 8) = rv[j]; }
#pragma unroll
        for (int j = 0; j < 2; ++j) { const int i = tid + 512 * j, row = i >> 4, c8 = i & 15; float lv[8]; unpack8(rl[j], lv); *(LAS f32x4*)(TL + row * PL + c8 * 8) = (f32x4){lv[0], lv[1], lv[2], lv[3]}; *(LAS f32x4*)(TL + row * PL + c8 * 8 + 4) = (f32x4){lv[4], lv[5], lv[6], lv[7]}; }
    }
    __syncthreads();
    const int c = tid & 127, seg = tid >> 7;
    float cs[16]; float run = 0.f;
#pragma unroll
    for (int i = 0; i < 16; ++i) { run += TL[(16 * seg + i) * PL + c]; cs[i] = run; }
    SEGT[seg * 128 + c] = run;
    float qq[16], kk[16], vv[16];
#pragma unroll
    for (int i = 0; i < 16; ++i) { const int o = (16 * seg + i) * PD + c; qq[i] = bf2f(Qs[o]); kk[i] = bf2f(Ks[o]); vv[i] = bf2f(TV[o]); }
    __syncthreads();
    float pre = 0.f, sg[4];
#pragma unroll
    for (int q = 0; q < 4; ++q) { sg[q] = SEGT[q * 128 + c]; if (q < seg) pre += sg[q]; }
    const float bref = ((0.f + sg[0]) + sg[1]) + (0.f + TL[32 * PL + c]);
#pragma unroll
    for (int i = 0; i < 16; ++i) {
        const float bc = pre + cs[i]; const int o = (16 * seg + i) * PD + c;
        Qs[o] = (bf16)f2bf(qq[i] * __expf(bc - bref)); Ks[o] = (bf16)f2bf(kk[i] * __expf(bref - bc)); Qh[o] = (bf16)f2bf(qq[i] * __expf(bc) * (1.f / SC_U));
    }
    store16bf(VT + c * PK + 16 * seg, vv);
    __syncthreads();
    const int fr = lane & 15, fq = lane >> 4, mf = w & 3, nh = w >> 2;
    {
        f32x4 sc[2] = {(f32x4){0.f, 0.f, 0.f, 0.f}, (f32x4){0.f, 0.f, 0.f, 0.f}};
#pragma unroll
        for (int ks = 0; ks < 4; ++ks) { const bf16x8 a = fragL(Qs, PD, 16 * mf + fr, 32 * ks + 8 * fq);
#pragma unroll
            for (int nf = 0; nf < 2; ++nf) { const bf16x8 b = fragL(Ks, PD, 32 * nh + prow(fr, nf), 32 * ks + 8 * fq); sc[nf] = MFMA16(b, a, sc[nf]); } }
        const int l = 16 * mf + fr, m0 = 32 * nh + 8 * fq; float o[8];
#pragma unroll
        for (int j = 0; j < 4; ++j) { o[j] = (m0 + j <= l) ? sc[0][j] : 0.f; o[4 + j] = (m0 + 4 + j <= l) ? sc[1][j] : 0.f; }
        *(LAS u32x4*)(Pm + l * PK + m0) = pack8c(o);
    }
    __syncthreads();
    f32x4 acc[4];
#pragma unroll
    for (int i = 0; i < 4; ++i) acc[i] = (f32x4){0.f, 0.f, 0.f, 0.f};
#pragma unroll
    for (int ks = 0; ks < 2; ++ks) { const bf16x8 a = fragL(Pm, PK, 16 * mf + fr, 32 * ks + 8 * fq);
#pragma unroll
        for (int p = 0; p < 2; ++p)
#pragma unroll
            for (int nf = 0; nf < 2; ++nf) { const bf16x8 b = fragL(VT, PK, 64 * nh + 32 * p + prow(fr, nf), 32 * ks + 8 * fq); acc[2 * p + nf] = MFMA16(b, a, acc[2 * p + nf]); } }
#pragma unroll
    for (int ks = 0; ks < 4; ++ks) { const bf16x8 a = fragL(Qh, PD, 16 * mf + fr, 32 * ks + 8 * fq);
#pragma unroll
        for (int p = 0; p < 2; ++p)
#pragma unroll
            for (int nf = 0; nf < 2; ++nf) { const bf16x8 b = frag8cvt(stf[ks][p][nf]); acc[2 * p + nf] = MFMA16(b, a, acc[2 * p + nf]); } }
    float ss = 0.f;
#pragma unroll
    for (int i = 0; i < 4; ++i) ss += (acc[i][0] * acc[i][0] + acc[i][1] * acc[i][1]) + (acc[i][2] * acc[i][2] + acc[i][3] * acc[i][3]);
    ss += __shfl_xor(ss, 16); ss += __shfl_xor(ss, 32);
    const int l = 16 * mf + fr;
    if (fq == 0) RED[nh * 64 + l] = ss;
    __syncthreads();
    const float rstd = rsqrtf((RED[l] + RED[64 + l]) * (1.f / 128.f) + EPS);
    const float* gn = F.in[I_HGRN_NORM] + h * 128;
#pragma unroll
    for (int p = 0; p < 2; ++p) {
        const int e = 64 * nh + 32 * p + 8 * fq; float ga[8], o[8];
        unpack8(gaw[p], ga);
#pragma unroll
        for (int j = 0; j < 4; ++j) { o[j] = acc[2 * p][j] * rstd * gn[e + j] * ga[j]; o[4 + j] = acc[2 * p + 1][j] * rstd * gn[e + 4 + j] * ga[4 + j]; }
        { u32x2 q8; q8.x = pk4_i8(o[0], o[1], o[2], o[3], SQ_YA); q8.y = pk4_i8(o[4], o[5], o[6], o[7], SQ_YA); *(u32x2*)(F.p<unsigned char>(O_YA) + (t0 + l) * 2048 + h * 128 + e) = q8; }
    }
    __syncthreads();
}

DI void mlstm_c_item(const Frame& F, int it, int lane, int w, int tid, const bool hasw, const WTile& wt, f32x4 (&wv)[16], f32x4 (&wg)[4]) {
    const int h = it & 3, bn = it >> 2, n = bn & 127; const size_t t0 = (size_t)bn * 64;
    LAS bf16* Qs = (LAS bf16*)F.lds; LAS bf16* Ks = Qs + 68 * PD; LAS bf16* TV = Ks + 68 * PD; LAS bf16* VT = TV + 64 * PV; LAS bf16* NST = VT + 272 * PK; LAS bf16* Pm = TV;
    LAS float* ROWV = (LAS float*)(F.lds + MISC_F); LAS float* COLV = ROWV + 64; LAS float* WST = COLV + 64; LAS float* EINV = WST + 64; LAS float* RED = EINV + 64;
    const bf16* Z = F.p<bf16>(O_Z); const float* GT = F.p<float>(O_GATES);
    {
        u32x4 rv[4], rq[3], rk[3];
#pragma unroll
        for (int j = 0; j < 4; ++j) { const int i = tid + 512 * j, row = i >> 5, c8 = i & 31; rv[j] = *(const u32x4*)(Z + (t0 + row) * NZ + ZVB + h * 256 + c8 * 8); }
        raw67_load(Z, t0, n, ZQK + h * 128, tid, rq);
        raw67_load(Z, t0, n, ZQK + 512 + h * 128, tid, rk);
        const float ip = GT[(t0 + lane) * 8 + h], fpre = GT[(t0 + lane) * 8 + 4 + h], mst = F.p<float>(O_MST)[it];
        if (hasw) wtile_load(wt, lane, wv, wg);
        {
            const float lf = log_sigmoid(fpre);
            const float fc = incl_scan_add(lf, lane);
            const float cv = ip - fc, aint = fc + mst, dmax = fc + incl_scan_max(cv, lane), mt = fmaxf(dmax, aint);
            if (w == 0) { ROWV[lane] = fc - mt; COLV[lane] = cv; WST[lane] = __expf(aint - mt); EINV[lane] = __expf(-mt); }
        }
        raw67_store(Qs, tid, rq); raw67_store(Ks, tid, rk);
#pragma unroll
        for (int j = 0; j < 4; ++j) { const int i = tid + 512 * j, row = i >> 5, c8 = i & 31; *(LAS u32x4*)(TV + row * PV + c8 * 8) = rv[j]; }
    }
    __syncthreads();
    const int d = tid & 127, seg = tid >> 7;
    {
        float qq[16], kk[16];
        conv16L(Qs, 16 * seg, d, h * 128 + d, F.in[I_CONV_W], F.in[I_CONV_B], qq);
        conv16L(Ks, 16 * seg, d, 512 + h * 128 + d, F.in[I_CONV_W], F.in[I_CONV_B], kk);
        const int ev = tid & 255, hv = tid >> 8; float v0[16], v1[16];
#pragma unroll
        for (int i = 0; i < 16; ++i) { v0[i] = bf2f(TV[(32 * hv + i) * PV + ev]); v1[i] = bf2f(TV[(32 * hv + 16 + i) * PV + ev]); }
        __syncthreads();
#pragma unroll
        for (int i = 0; i < 16; ++i) { const int l = 16 * seg + i; Qs[l * PD + d] = (bf16)f2bf(qq[i]); Ks[l * PD + d] = (bf16)f2bf(kk[i] * 0.08838834764831845f); }
        store16bf(VT + ev * PK + 32 * hv, v0); store16bf(VT + ev * PK + 32 * hv + 16, v1);
        for (int i = tid; i < 16 * 64; i += 512) VT[(256 + (i >> 6)) * PK + (i & 63)] = (bf16)((i >> 6) == 0 ? 0x3f80 : 0);
        const float* NLp = F.p<float>(O_NL) + (size_t)it * 128;
        for (int i = tid; i < 16 * 128; i += 512) NST[(i >> 7) * PD + (i & 127)] = (bf16)((i >> 7) == 0 ? f2bf(NLp[i & 127]) : 0u);
    }
    __syncthreads();
    const int fr = lane & 15, fq = lane >> 4, mf = w & 3, nh = w >> 2, l = 16 * mf + fr;
    {
        f32x4 sc[2] = {(f32x4){0.f, 0.f, 0.f, 0.f}, (f32x4){0.f, 0.f, 0.f, 0.f}};
#pragma unroll
        for (int ks = 0; ks < 4; ++ks) { const bf16x8 a = fragL(Qs, PD, l, 32 * ks + 8 * fq);
#pragma unroll
            for (int nf = 0; nf < 2; ++nf) { const bf16x8 b = fragL(Ks, PD, 32 * nh + prow(fr, nf), 32 * ks + 8 * fq); sc[nf] = MFMA16(b, a, sc[nf]); } }
        const int m0 = 32 * nh + 8 * fq; const float rv = ROWV[l]; float o[8];
#pragma unroll
        for (int j = 0; j < 4; ++j) { o[j] = (m0 + j <= l) ? sc[0][j] * __expf(rv + COLV[m0 + j]) : 0.f; o[4 + j] = (m0 + 4 + j <= l) ? sc[1][j] * __expf(rv + COLV[m0 + 4 + j]) : 0.f; }
        *(LAS u32x4*)(Pm + l * PK + m0) = pack8c(o);
    }
    __syncthreads();
    f32x4 a1[8], a2[8], d1 = (f32x4){0.f, 0.f, 0.f, 0.f}, d2 = (f32x4){0.f, 0.f, 0.f, 0.f};
#pragma unroll
    for (int i = 0; i < 8; ++i) { a1[i] = (f32x4){0.f, 0.f, 0.f, 0.f}; a2[i] = (f32x4){0.f, 0.f, 0.f, 0.f}; }
#pragma unroll
    for (int ks = 0; ks < 2; ++ks) { const bf16x8 a = fragL(Pm, PK, l, 32 * ks + 8 * fq);
#pragma unroll
        for (int p = 0; p < 4; ++p)
#pragma unroll
            for (int nf = 0; nf < 2; ++nf) { const bf16x8 b = fragL(VT, PK, 128 * nh + 32 * p + prow(fr, nf), 32 * ks + 8 * fq); a1[2 * p + nf] = MFMA16(b, a, a1[2 * p + nf]); }
        d1 = MFMA16(fragL(VT, PK, 256 + fr, 32 * ks + 8 * fq), a, d1); }
    const unsigned char* CS = F.p<unsigned char>(O_CT) + (size_t)it * 256 * 128;
#pragma unroll
    for (int ks = 0; ks < 4; ++ks) { const bf16x8 a = fragL(Qs, PD, l, 32 * ks + 8 * fq);
#pragma unroll
        for (int p = 0; p < 4; ++p)
#pragma unroll
            for (int nf = 0; nf < 2; ++nf) { const bf16x8 b = fragG8(CS, 128, 128 * nh + 32 * p + prow(fr, nf), 32 * ks + 8 * fq); a2[2 * p + nf] = MFMA16(b, a, a2[2 * p + nf]); }
        d2 = MFMA16(fragL(NST, PD, fr, 32 * ks + 8 * fq), a, d2); }
    const float ws = WST[l];
    float den = d1[0] + ws * d2[0];
    den = __shfl(den, fr);
    const float inv = 1.f / fmaxf(fabsf(den), EINV[l]);
    float ss = 0.f;
    const float wsc = ws * (1.f / SC_C);
#pragma unroll
    for (int i = 0; i < 8; ++i) { a1[i] = (a1[i] + wsc * a2[i]) * inv; ss += (a1[i][0] * a1[i][0] + a1[i][1] * a1[i][1]) + (a1[i][2] * a1[i][2] + a1[i][3] * a1[i][3]); }
    ss += __shfl_xor(ss, 16); ss += __shfl_xor(ss, 32);
    if (fq == 0) RED[nh * 64 + l] = ss;
    __syncthreads();
    const float rstd = rsqrtf((RED[l] + RED[64 + l]) * (1.f / 256.f) + EPS);
    const float* gn = F.in[I_MLSTM_NORM] + h * 256;
#pragma unroll
    for (int p = 0; p < 4; ++p) {
        const int e = 128 * nh + 32 * p + 8 * fq; float og[8], o[8];
        unpack8(*(const u32x4*)(Z + (t0 + l) * NZ + ZOB + h * 256 + e), og);
#pragma unroll
        for (int j = 0; j < 4; ++j) { o[j] = a1[2 * p][j] * rstd * gn[e + j] * og[j]; o[4 + j] = a1[2 * p + 1][j] * rstd * gn[e + 4 + j] * og[4 + j]; }
        { u32x2 q8; q8.x = pk4_i8(o[0], o[1], o[2], o[3], SQ_YB); q8.y = pk4_i8(o[4], o[5], o[6], o[7], SQ_YB); *(u32x2*)(F.p<unsigned char>(O_YA) + (t0 + l) * 2048 + 1024 + h * 256 + e) = q8; }
    }
    __syncthreads();
}

#define MIX_ITEM_WITH_TILE(fn, it, slot) do { const int l2 = lane_id(), t2 = w * 64 + l2;     \
        const int wti_ = (slot) * NGW + gw; const bool hasw_ = wti_ < NWT; f32x4 wv_[16], wg_[4]; \
        { const WTile wt_ = wtile_decode(F, hasw_ ? wti_ : 0); fn(F, it, l2, w, t2, hasw_, wt_, wv_, wg_); } \
        if (hasw_) { const WTile wt_ = wtile_decode(F, wti_); wtile_finish(wt_, l2, wv_, wg_, (LAS unsigned*)(F.lds + w * 4352)); } \
        __syncthreads(); } while (0)
DI void mix_a_phase(const Frame& F) {
    const int w = F.wave, gw = F.bid * 8 + w, NGW = F.G * 8;
    int slot = 0;
    for (int it = F.bid; it < NITEM_A; it += F.G) { MIX_ITEM_WITH_TILE(hgrn_a_item, it, slot); ++slot; }
    for (int it = F.bid; it < NITEM_B; it += F.G) { MIX_ITEM_WITH_TILE(mlstm_a_item, it, slot); ++slot; }
}
DI void mix_c_phase(const Frame& F) {
    const int w = F.wave, gw = F.bid * 8 + w, NGW = F.G * 8;
    int slot = (NITEM_A + F.G - 1) / F.G + (NITEM_B + F.G - 1) / F.G;
    for (int it = F.bid; it < NITEM_A; it += F.G) { MIX_ITEM_WITH_TILE(hgrn_c_item, it, slot); ++slot; }
    for (int it = F.bid; it < NITEM_B; it += F.G) { MIX_ITEM_WITH_TILE(mlstm_c_item, it, slot); ++slot; }
    for (int wti = slot * NGW + gw; wti < NWT; wti += NGW) { const int lane = lane_id(); const WTile wt = wtile_decode(F, wti); f32x4 wv[16], wg[4]; wtile_load(wt, lane, wv, wg); wtile_finish(wt, lane, wv, wg, (LAS unsigned*)(F.lds + w * 4352)); }
    __syncthreads();
}

enum { PH_PROLOGUE = 0, PH_INPROJ, PH_MIXA, PH_SCAN, PH_MIXC, PH_MIXPROJ, PH_WOUT, PH_ROUTE, PH_ROWS, PH_GU, PH_DN, PH_COMBINE, PH_GATE, PH_FINAL, PH_COUNT };

__global__ void __launch_bounds__(512, 2) fwd(Args args) {
    extern __shared__ __attribute__((aligned(16))) unsigned char lds_raw[];
    Frame F;
    F.lds = (LAS unsigned char*)lds_raw;
    F.wave = __builtin_amdgcn_readfirstlane((int)threadIdx.x >> 6); F.G = gridDim.x; F.bid = blockIdx.x;
    F.in = args.in; F.out = args.out; F.ws = args.ws;
    volatile LAS unsigned* misc = (volatile LAS unsigned*)(F.lds + LDS_MISC);
    if (threadIdx.x < 4) misc[threadIdx.x] = 0u;
    __syncthreads();
    const int lo = args.ph_lo, hi = args.ph_hi;
    const bool multi = (hi - lo) > 1;
    XcdBarrier bar; bar.bar = F.p<unsigned>(O_CTL) + CW_BAR; bar.x = 0; bar.st = misc;
    if (multi) bar = xcd_barrier_post(F.p<unsigned>(O_CTL) + CW_BAR, misc, threadIdx.x == 0);
#define IN(k) (lo <= (k) && (k) < hi)
#define REPS(k) for (int rep_ = 0; rep_ < 1 + ((k) == PROBE_PH ? PROBE_N : 0); ++rep_)
#define REPBAR(k) do { if ((k) == PROBE_PH && rep_ < PROBE_N) xcd_barrier(bar, F.wave == 0 && lane_id() == 0); } while (0)
#define SEAM(k) do { if (IN(k) && IN((k) + 1)) xcd_barrier(bar, F.wave == 0 && lane_id() == 0); } while (0)
    LAS unsigned char* ring = F.lds;

    if (IN(PH_PROLOGUE)) REPS(PH_PROLOGUE) { p0_prologue(F); REPBAR(PH_PROLOGUE); } SEAM(PH_PROLOGUE);

    if (IN(PH_INPROJ)) REPS(PH_INPROJ) {
        pg8::SchedPlain S; S.init(T, NZ, D, F.p<bf16>(O_WIN), F.G, F.bid);
        pg8::EpiWrap<EInproj, true> E{{F.p<bf16>(O_Z), F.p<bf16>(O_LF), F.p<float>(O_RS0), F.in[I_HGRN_LB]}};
        pg8::gemm_phase<2>(ring, F.wave, (const char*)F.p<bf16>(O_XB), D, S, E, STG_INPROJ); REPBAR(PH_INPROJ);
    } SEAM(PH_INPROJ);
#if PROBE_PH == 102 || PROBE_PH == 103
    if (IN(PH_INPROJ)) for (int rep_ = 0; rep_ < PROBE_N; ++rep_) {
        xcd_barrier(bar, F.wave == 0 && lane_id() == 0);
        if ((F.bid & 1) == 0) {
            pg8::SchedPlain S; S.init(T / 2, NZ, D, F.p<bf16>(O_WIN), F.G / 2, F.bid >> 1);
            pg8::EpiWrap<ENullProbe, true> E{{F.p<float>(O_MIXT), lo < 0 ? 1 : 0}};
            pg8::gemm_phase<2>(ring, F.wave, (const char*)F.p<bf16>(O_XB), D, S, E);
        }
#if PROBE_PH == 103
        else { const int lane = lane_id(); float acc = 0.f; const f32x4* xp = (const f32x4*)F.in[I_X];
            for (size_t i = (size_t)(F.bid >> 1) * 512 + F.wave * 64 + lane; i < (size_t)T * D / 4; i += (size_t)(F.G / 2) * 512) { const f32x4 v = xp[i]; acc += v.x + v.y + v.z + v.w; }
            if (acc == 123.456f) F.p<float>(O_MIXT)[lane] = acc; }
#endif
    }
#endif
#if PROBE_PH == 100
    if (IN(PH_INPROJ)) for (int rep_ = 0; rep_ < PROBE_N; ++rep_) {
        pg8::SchedPlain S; S.init(T, NZ, D, F.p<bf16>(O_WIN), F.G, F.bid);
        pg8::EpiWrap<ENullProbe> E{{F.p<float>(O_MIXT), lo < 0 ? 1 : 0}};
        pg8::gemm_phase<2>(ring, F.wave, (const char*)F.p<bf16>(O_XB), D, S, E);
        xcd_barrier(bar, F.wave == 0 && lane_id() == 0);
    }
#endif

    if (IN(PH_MIXA)) REPS(PH_MIXA) { mix_a_phase(F); REPBAR(PH_MIXA); } SEAM(PH_MIXA);
    if (IN(PH_SCAN)) { scan_phase(F); } SEAM(PH_SCAN);
    if (IN(PH_MIXC)) REPS(PH_MIXC) { mix_c_phase(F); REPBAR(PH_MIXC); } SEAM(PH_MIXC);

    if (IN(PH_MIXPROJ)) REPS(PH_MIXPROJ) {
        pg8::SchedPlain S; S.init(T, D, D, F.p<bf16>(O_WA), F.G, F.bid);
        pg8::EpiWrap<EMixF, true, true> E{{F.p<bf16>(O_Z), F.p<unsigned char>(O_MIX)}};
        MixHook H{F.p<bf16>(O_Z)};
        pg8::gemm_phase<2, pg8::EpiWrap<EMixF, true, true>, pg8::SchedPlain, MixHook>(ring, F.wave, (const char*)F.p<bf16>(O_YA), D, S, E, 0u, H);
        REPBAR(PH_MIXPROJ);
    } SEAM(PH_MIXPROJ);

    if (IN(PH_WOUT)) REPS(PH_WOUT) {
        pg8::SchedPlain S; S.init(T, D, D, F.p<bf16>(O_WOUT), F.G, F.bid);
        pg8::EpiWrap<EX1, true, true> E{{F.in[I_X], F.p<bf16>(O_X1), F.p<unsigned char>(O_X1B), F.p<float>(O_SS1)}};
        pg8::gemm_phase<2>(ring, F.wave, (const char*)F.p<unsigned char>(O_MIX), D, S, E); REPBAR(PH_WOUT);
    } SEAM(PH_WOUT);

    if (IN(PH_ROUTE)) REPS(PH_ROUTE) { p7_route(F); REPBAR(PH_ROUTE); } SEAM(PH_ROUTE);
    if (IN(PH_ROWS)) { p8_rows(F); } SEAM(PH_ROWS);

    if (IN(PH_GU)) REPS(PH_GU) {
        const int nblk = __builtin_amdgcn_readfirstlane(F.p<int>(O_BLKE)[NBMAX]);
        pg8::SchedMoE<true> S; S.init(nblk, 4096, D, F.p<unsigned char>(O_WGU), (size_t)4096 * D, F.p<int>(O_BLKE), F.p<int>(O_ROWTOK), F.G, F.bid);
        pg8::EpiWrap<ESwiglu, true> E{{F.p<unsigned char>(O_ACT), F.p<float>(O_ROWRS), F.in[I_B_GU]}};
        pg8::gemm_phase<2>(ring, F.wave, (const char*)F.p<unsigned char>(O_X1B), D, S, E, STG_GU); REPBAR(PH_GU);
    } SEAM(PH_GU);

    if (IN(PH_DN)) REPS(PH_DN) {
        const int nblk = __builtin_amdgcn_readfirstlane(F.p<int>(O_BLKE)[NBMAX]);
        pg8::SchedMoE<false> S; S.init(nblk, D, DFF, F.p<unsigned char>(O_WDN), (size_t)D * DFF, F.p<int>(O_BLKE), F.p<int>(O_ROWTOK), F.G, F.bid);
        pg8::EpiWrap<EDown, false, true> E{{F.p<unsigned char>(O_YBUF), F.p<float>(O_ROWG), F.in[I_B_DN]}};
        pg8::gemm_phase<1>(ring, F.wave, (const char*)F.p<unsigned char>(O_ACT), DFF, S, E, STG_DN);
        {
            pg8::SchedPlain S2; S2.init(T, D, 2 * PLE, F.p<bf16>(O_WPLE), F.G, F.bid);
            pg8::EpiWrap<EPw, false, true> E2{{F.p<bf16>(O_PW)}};
            pg8::gemm_phase<0>(ring, F.wave, (const char*)F.p<bf16>(O_PB), 2 * PLE, S2, E2);
        }
        REPBAR(PH_DN);
    } SEAM(PH_DN);

    if (IN(PH_COMBINE)) REPS(PH_COMBINE) {
        p11_combine(F); REPBAR(PH_COMBINE);
    } SEAM(PH_COMBINE);

    if (IN(PH_GATE)) REPS(PH_GATE) {
        pg8::SchedPlain S; S.init(T, D, D, F.p<unsigned char>(O_WPG), F.G, F.bid);
        pg8::EpiWrap<EGate, true, true> E{{F.p<bf16>(O_X2), F.p<bf16>(O_PW), F.p<float>(O_RS2), F.p<bf16>(O_X3), F.p<float>(O_SS3)}};
        pg8::gemm_phase<2>(ring, F.wave, (const char*)F.p<unsigned char>(O_X2B), D, S, E); REPBAR(PH_GATE);
    } SEAM(PH_GATE);

    if (IN(PH_FINAL)) { p13_final(F); }
#undef IN
#undef SEAM
}

static void launch_fwd(const Args& base, int lo, int hi, int grid, hipStream_t stream) {
    Args a = base; a.ph_lo = lo; a.ph_hi = hi;
    hipLaunchKernelGGL(fwd, dim3(grid), dim3(512), LDS_BYTES, stream, a);
}

extern "C" void kernel_launch(void* const* d_in, const int* in_sizes, int n_in, void* d_out, int out_size, void* d_ws, size_t ws_size, hipStream_t stream) {
    static int grid = 0;
    if (grid == 0) {
        if (n_in != 25 || out_size != T * D || ws_size < WS_END) { fprintf(stderr, "kernel_launch: unexpected shapes: n_in %d out %d ws %zu (need %zu)\n", n_in, out_size, ws_size, (size_t)WS_END); grid = -1; return; }
        int dev = 0, cus = 0;
        hipGetDevice(&dev); hipDeviceGetAttribute(&cus, hipDeviceAttributeMultiprocessorCount, dev);
        if (hipFuncSetAttribute((const void*)fwd, hipFuncAttributeMaxDynamicSharedMemorySize, LDS_BYTES) != hipSuccess) { fprintf(stderr, "kernel_launch: hipFuncSetAttribute failed\n"); grid = -1; return; }
        int per_cu = 0; (void)hipOccupancyMaxActiveBlocksPerMultiprocessor(&per_cu, (const void*)fwd, 512, LDS_BYTES); (void)hipGetLastError();
        if (per_cu < 1) fprintf(stderr, "kernel_launch: occupancy query says %d\n", per_cu);
        grid = cus;
    }
    if (grid < 0) return;
    hipMemsetAsync((char*)d_ws + O_CTL, 0, 1 * MiB, stream);
    Args a{};
    for (int i = 0; i < 25; ++i) a.in[i] = (const float*)d_in[i];
    a.out = (float*)d_out; a.ws = (unsigned char*)d_ws; a.ph_lo = 0; a.ph_hi = PH_COUNT;
#if ONE_LAUNCH
    launch_fwd(a, 0, PH_COUNT, grid, stream);
#else
    for (int ph = 0; ph < PH_COUNT; ++ph) launch_fwd(a, ph, ph + 1, grid, stream);
#endif
}
```

```cpp
#include <hip/hip_runtime.h>
#include <cstdio>
#include <cstdint>
#include <cstring>

#define DI __device__ __forceinline__
#define LAS __attribute__((address_space(3)))

typedef unsigned short bf16;
typedef short bf16x8 __attribute__((ext_vector_type(8)));
typedef float f32x4 __attribute__((ext_vector_type(4)));
typedef float f32x16 __attribute__((ext_vector_type(16)));
typedef unsigned u32x4 __attribute__((ext_vector_type(4)));
typedef unsigned u32x2 __attribute__((ext_vector_type(2)));

#ifndef NAIVE_GEMM_MASK
#define NAIVE_GEMM_MASK 0x0
#endif
#ifndef NAIVE_MIXERS
#define NAIVE_MIXERS 0
#endif
#ifndef ONE_LAUNCH
#define ONE_LAUNCH 1
#endif
#ifndef STG_INPROJ
#define STG_INPROJ 0u
#endif
#ifndef STG_MIX
#define STG_MIX 0u
#endif
#ifndef STG_GU
#define STG_GU 0u
#endif
#ifndef STG_DN
#define STG_DN 0u
#endif
#ifndef PROBE_PH
#define PROBE_PH -1
#endif
#ifndef PROBE_N
#define PROBE_N 0
#endif

constexpr int T = 32768, D = 2048, SEQ = 8192;
constexpr int NZ = 11264, INCOLS = 11272;
constexpr int ZQA = 0, ZKA = 1024, ZVA = 2048, ZGA = 3072, ZQK = 4096, ZVB = 5120, ZOB = 6144, ZRA = 7168, ZRB = 9216;
constexpr int NE = 32, DFF = 2048, PLE = 256;
constexpr int NRMAX = T * 4 + NE * 256;
constexpr int NBMAX = NRMAX / 256;
constexpr float EPS = 1e-6f;
constexpr float SC_X = 16.f, SC_WGU = 256.f, SC_ACT = 4.f, SC_WDN = 256.f;
constexpr float SQ_M = 127.f / 2.6f;
constexpr float SQ_YA = 127.f / 8.f, SQ_YB = 127.f / 5.5f, SQ_WAB = 127.f / (4.75f * 0.03125f);
constexpr float SC_C = 64.f;
constexpr float SC_U = 16.f;
constexpr float SC_Y = 64.f;
constexpr float SQ_W = 127.f / (4.75f * 0.02209709f), SQ_X = 127.f / 6.f;
constexpr int NCHUNK = 128;
constexpr int NITEM_A = 4 * NCHUNK * 8;
constexpr int NITEM_B = 4 * NCHUNK * 4;

constexpr size_t al4k(size_t x) { return (x + 4095) & ~(size_t)4095; }
constexpr size_t MiB = (size_t)1 << 20;
constexpr size_t O_CTL = 0;
constexpr size_t O_RS0 = 1 * MiB;
constexpr size_t O_RS1 = O_RS0 + al4k((size_t)T * 4);
constexpr size_t O_RS2 = O_RS1 + al4k((size_t)T * 4);
constexpr size_t O_GATES = O_RS2 + al4k((size_t)T * 4);
constexpr size_t O_RWG = O_GATES + al4k((size_t)T * 8 * 4);
constexpr size_t O_DEC = O_RWG + al4k((size_t)D * NE * 4);
constexpr size_t O_NL = O_DEC + al4k((size_t)NITEM_A * 128 * 4);
constexpr size_t O_MLOC = O_NL + al4k((size_t)NITEM_B * 128 * 4);
constexpr size_t O_GTOT = O_MLOC + al4k((size_t)NITEM_B * 4);
constexpr size_t O_MST = O_GTOT + al4k((size_t)NITEM_B * 4);
constexpr size_t O_TOPE = O_MST + al4k((size_t)NITEM_B * 4);
constexpr size_t O_TOPG = O_TOPE + al4k((size_t)T * 4 * 4);
constexpr size_t O_SLOT = O_TOPG + al4k((size_t)T * 4 * 4);
constexpr size_t O_HIST = O_SLOT + al4k((size_t)T * 4 * 4);
constexpr size_t O_ROWTOK = O_HIST + al4k((size_t)256 * 32 * 4);
constexpr size_t O_ROWG = O_ROWTOK + al4k((size_t)NRMAX * 4);
constexpr size_t O_ROWRS = O_ROWG + al4k((size_t)NRMAX * 4);
constexpr size_t O_BLKE = O_ROWRS + al4k((size_t)NRMAX * 4);
constexpr size_t O_SS1 = O_BLKE + al4k((size_t)(NBMAX + 16) * 4);
constexpr size_t O_SS3 = O_SS1 + al4k((size_t)T * 32 * 4);
constexpr size_t O_SMALL_END = O_SS3 + al4k((size_t)T * 32 * 4);
static_assert(O_SMALL_END <= 32 * MiB, "small region");
constexpr size_t O_WIN = 32 * MiB;
constexpr size_t O_WA = O_WIN + (size_t)NZ * D * 2;
constexpr size_t O_WB = O_WA + (size_t)D * 1024 * 2;
constexpr size_t O_WOUT = O_WB + (size_t)D * 1024 * 2;
constexpr size_t O_WPG = O_WOUT + (size_t)D * D * 2;
constexpr size_t O_WPLE = O_WPG + (size_t)D * D * 2;
constexpr size_t O_WGU = O_WPLE + (size_t)D * PLE * 2;
constexpr size_t O_WDN = O_WGU + (size_t)NE * 4096 * D * 2;
constexpr size_t O_XB = O_WDN + (size_t)NE * D * DFF * 2;
constexpr size_t O_PB = O_XB + (size_t)T * D * 2;
constexpr size_t O_Z = O_PB + (size_t)T * PLE * 2;
constexpr size_t O_M = O_Z + (size_t)T * NZ * 2;
constexpr size_t O_LF = O_M;
constexpr size_t O_UST = O_LF + (size_t)T * 1024 * 4;
constexpr size_t O_CT = O_UST + (size_t)NITEM_A * 128 * 128 * 2;
constexpr size_t O_YA = O_CT + (size_t)NITEM_B * 256 * 128 * 2;
constexpr size_t O_YB = O_YA + (size_t)T * 1024 * 2;
constexpr size_t O_MIX = O_YB + (size_t)T * 1024 * 2;
constexpr size_t O_M_END = O_MIX + (size_t)T * D * 2;
static_assert(O_M_END - O_M >= (size_t)NRMAX * D * 2, "YBUF alias");
static_assert((size_t)T * NZ * 2 >= (size_t)NRMAX * D * 2, "ACT alias");
constexpr size_t O_MIXT = O_M_END;
constexpr size_t O_X1 = O_MIXT + (size_t)T * D * 4;
constexpr size_t O_X1B = O_X1 + (size_t)T * D * 4;
constexpr size_t WS_END = O_X1B + (size_t)T * D * 2;
constexpr size_t O_ACT = O_Z, O_YBUF = O_M, O_X2 = O_MIXT, O_X2B = O_XB, O_PW = O_X1B, O_X3 = O_MIXT + (size_t)T * D * 2;

constexpr int CW_BAR = 4096;

DI int lane_id() { int l; asm volatile("v_mbcnt_lo_u32_b32 %0, -1, 0\n\tv_mbcnt_hi_u32_b32 %0, -1, %0" : "=v"(l)); return l; }
DI unsigned f2bf(float f) { unsigned u = __float_as_uint(f); return (u + 0x7fffu + ((u >> 16) & 1u)) >> 16; }
DI float bf2f(unsigned h) { return __uint_as_float(h << 16); }
DI unsigned pk2(float lo, float hi) { unsigned r; asm volatile("v_cvt_pk_bf16_f32 %0, %1, %2" : "=v"(r) : "v"(lo), "v"(hi)); return r; }
typedef float f32x2 __attribute__((ext_vector_type(2)));
typedef __bf16 bf16x2_t __attribute__((ext_vector_type(2)));
DI unsigned pk2c(float lo, float hi) { const f32x2 v = {lo, hi}; return __builtin_bit_cast(unsigned, __builtin_convertvector(v, bf16x2_t)); }
DI float sigm(float x) { return __builtin_amdgcn_rcpf(1.f + __expf(-x)); }
DI float wave_sum(float v) {
#pragma unroll
    for (int o = 1; o < 64; o <<= 1) v += __shfl_xor(v, o);
    return v;
}
DI float wave_max(float v) {
#pragma unroll
    for (int o = 1; o < 64; o <<= 1) v = fmaxf(v, __shfl_xor(v, o));
    return v;
}
DI void unpack8(const u32x4 w, float (&o)[8]) {
    o[0] = bf2f(w.x & 0xffffu); o[1] = bf2f(w.x >> 16); o[2] = bf2f(w.y & 0xffffu); o[3] = bf2f(w.y >> 16);
    o[4] = bf2f(w.z & 0xffffu); o[5] = bf2f(w.z >> 16); o[6] = bf2f(w.w & 0xffffu); o[7] = bf2f(w.w >> 16);
}
DI u32x4 pack8(const float (&v)[8]) { u32x4 w; w.x = pk2(v[0], v[1]); w.y = pk2(v[2], v[3]); w.z = pk2(v[4], v[5]); w.w = pk2(v[6], v[7]); return w; }
DI u32x4 pack8c(const float (&v)[8]) { u32x4 w; w.x = pk2c(v[0], v[1]); w.y = pk2c(v[2], v[3]); w.z = pk2c(v[4], v[5]); w.w = pk2c(v[6], v[7]); return w; }
DI unsigned pk4_fp8(float a, float b, float c, float d) { unsigned w = __builtin_amdgcn_cvt_pk_fp8_f32(a, b, 0u, false); return __builtin_amdgcn_cvt_pk_fp8_f32(c, d, w, true); }
DI float clamp8(float v) { return fminf(fmaxf(v, -440.f), 440.f); }
DI unsigned pk4_i8(float a, float b, float c, float d, float s) {
    typedef short s16x2 __attribute__((ext_vector_type(2)));
    const float k = s * (256.f / 32767.f), o = 128.f / 32767.f;
    const s16x2 lo = __builtin_amdgcn_cvt_pknorm_i16(fmaf(a, k, o), fmaf(b, k, o)), hi = __builtin_amdgcn_cvt_pknorm_i16(fmaf(c, k, o), fmaf(d, k, o));
    return __builtin_amdgcn_perm(__builtin_bit_cast(unsigned, hi), __builtin_bit_cast(unsigned, lo), 0x07050301u);
}
DI unsigned pk4_u8(float a, float b, float c, float d) {
    typedef unsigned short u16x2 __attribute__((ext_vector_type(2)));
    const float k = 255.f * 256.f / 65535.f, o = 128.f / 65535.f;
    const u16x2 lo = __builtin_amdgcn_cvt_pknorm_u16(fmaf(a, k, o), fmaf(b, k, o)), hi = __builtin_amdgcn_cvt_pknorm_u16(fmaf(c, k, o), fmaf(d, k, o));
    return __builtin_amdgcn_perm(__builtin_bit_cast(unsigned, hi), __builtin_bit_cast(unsigned, lo), 0x07050301u);
}
DI float ub(unsigned w, int i) { return (float)((w >> (8 * i)) & 0xffu); }
DI float log_sigmoid(float x) { return fminf(x, 0.f) - __logf(1.f + __expf(-fabsf(x))); }

#define XB_TMO      128
#define XB_XCNT(j)  (256  + 64 * (j))
#define XB_XSUB(j)  (1280 + 64 * (j))
#define XB_XGEN(j)  (2304 + 64 * (j))
#define XB_TOP      3328
#define XB_TOPGEN   3392
#define XCD_BAR_WORDS 3456
#define XB_SPIN_CAP (1u << 18)
__device__ __forceinline__ unsigned xb_ld(unsigned* p)              { return __hip_atomic_load(p, __ATOMIC_RELAXED, __HIP_MEMORY_SCOPE_AGENT); }
__device__ __forceinline__ unsigned xb_add(unsigned* p, unsigned v) { return __hip_atomic_fetch_add(p, v, __ATOMIC_RELAXED, __HIP_MEMORY_SCOPE_AGENT); }
__device__ __forceinline__ unsigned xb_xcc_id() { return (unsigned)__builtin_amdgcn_s_getreg((3 << 11) | 20) & 0xFu; }
#define XB_SPIN(cond, bar) do { unsigned _sp = 0; while (cond) { __builtin_amdgcn_s_sleep(1); \
    if ((++_sp & 255u) == 0u) { if (xb_ld(&(bar)[XB_TMO])) break; if (_sp > XB_SPIN_CAP) { atomicAdd(&(bar)[XB_TMO], 1u); break; } } } } while (0)
struct XcdBarrier { unsigned* bar; unsigned x; volatile LAS unsigned* st; };
__device__ __forceinline__ XcdBarrier xcd_barrier_post(unsigned* bar, volatile LAS unsigned* st, bool leader) {
    XcdBarrier b; b.bar = bar; b.x = xb_xcc_id(); b.st = st;
    if (leader) (void)xb_add(&bar[XB_XCNT(b.x)], 1u);
    return b;
}
__device__ __forceinline__ void xcd_barrier_complete(unsigned* bar, unsigned x, unsigned& nloc, unsigned& nx) {
    const unsigned G = gridDim.x * gridDim.y * gridDim.z;
    unsigned sum, cnt, mine, sp = 0u;
    for (;;) {
        sum = 0u; cnt = 0u; mine = 0u;
#pragma unroll
        for (unsigned j = 0; j < 16; ++j) { const unsigned c = xb_ld(&bar[XB_XCNT(j)]); sum += c; cnt += (c > 0u) ? 1u : 0u; mine = (j == x) ? c : mine; }
        if (sum == G) break;
        __builtin_amdgcn_s_sleep(1);
        if ((++sp & 255u) == 0u) { if (xb_ld(&bar[XB_TMO])) break; if (sp > XB_SPIN_CAP) { atomicAdd(&bar[XB_TMO], 1u); break; } }
    }
    nloc = mine > 0u ? mine : 1u; nx = cnt > 0u ? cnt : 1u;
}
__device__ __forceinline__ void xcd_barrier(const XcdBarrier& b, bool leader) {
    asm volatile("s_waitcnt vmcnt(0)" ::: "memory");
    __syncthreads();
    if (leader) {
        unsigned* bar = b.bar;
        __builtin_amdgcn_s_waitcnt(0);
        unsigned nloc = b.st[0], nx = b.st[1];
        if (nloc == 0u) { xcd_barrier_complete(bar, b.x, nloc, nx); b.st[0] = nloc; b.st[1] = nx; }
        const unsigned old = xb_add(&bar[XB_XSUB(b.x)], 1u);
        const unsigned gen = old / nloc;
        if (old + 1u == (gen + 1u) * nloc) {
            __builtin_amdgcn_fence(__ATOMIC_RELEASE, "agent");
            asm volatile("s_waitcnt vmcnt(0)" ::: "memory");
            const unsigned og = xb_add(&bar[XB_TOP], 1u);
            const unsigned tg = og / nx;
            if (og + 1u == (tg + 1u) * nx) xb_add(&bar[XB_TOPGEN], 1u);
            else XB_SPIN(xb_ld(&bar[XB_TOPGEN]) == tg, bar);
            __builtin_amdgcn_fence(__ATOMIC_ACQUIRE, "agent");
            xb_add(&bar[XB_XGEN(b.x)], 1u);
            asm volatile("s_waitcnt vmcnt(0)" ::: "memory");
        } else {
            XB_SPIN(xb_ld(&bar[XB_XGEN(b.x)]) == gen, bar);
            __builtin_amdgcn_fence(__ATOMIC_ACQUIRE, "agent");
            asm volatile("s_waitcnt vmcnt(0)" ::: "memory");
        }
    }
    __syncthreads();
}

namespace pg8 {
constexpr int BM = 256, BK = 64, HALF = 128, HTB = HALF * BK * 2, STAGE_BYTES = 8 * HTB, NXCD = 8, WGM = 8;
__host__ __device__ __forceinline__ int lds_byte(int r, int c) { const int st = (r >> 4) * 2 + (c >> 5), rr = r & 15, cc = c & 31, ob = rr * 64 + cc * 2; return st * 1024 + (ob ^ (((ob >> 9) & 1) << 5)); }
__host__ __device__ __forceinline__ void stage_rc(int b, int& R, int& C) { const int st = b / 1024, sb = b % 1024, swz = sb ^ (((sb >> 9) & 1) << 5); R = (st >> 1) * 16 + swz / 64; C = (st & 1) * 32 + (swz % 64) / 2; }
__host__ __device__ __forceinline__ int perm32(int rho) { const int n = rho >> 4, i = rho & 15; return 8 * (i >> 2) + 4 * n + (i & 3); }

struct Unit { int pm, pn, e; };

struct OrderBase {
    int nM, nN, nwg, G, c;
    DI void init_order(int nM_, int nN_, int G_, int c_) { nM = nM_; nN = nN_; nwg = nM * nN; G = G_; c = c_; }
    DI bool next_mn(int i, Unit& u) const {
        const long L = (long)i * G + c; if (L >= nwg) return false;
        int wgid = (int)L; { const int q = nwg / NXCD, r = nwg % NXCD, xcd = wgid % NXCD, off = wgid / NXCD; wgid = (xcd < r ? xcd * (q + 1) : r * (q + 1) + (xcd - r) * q) + off; }
        const int nig = WGM * nN, gid = wgid / nig, fm = gid * WGM, gsz = (nM - fm) < WGM ? (nM - fm) : WGM;
        u.pm = fm + ((wgid % nig) % gsz); u.pn = (wgid % nig) / gsz; return true;
    }
};
struct SchedPlain : OrderBase {
    static constexpr bool GATHER = false;
    const char* Bt; int K;
    DI void init(int M, int N, int K_, const void* Bt_, int G_, int c_) { init_order(M / BM, N / BM, G_, c_); Bt = (const char*)Bt_; K = K_; }
    DI bool next(int i, Unit& u) const { u.e = 0; return next_mn(i, u); }
    DI bool unit_of(int L, Unit& u) const { u.e = 0; u.pm = L / nN; u.pn = L % nN; return u.pm < nM; }
    DI unsigned a_row_off(const Unit& u, int r) const { return (unsigned)(u.pm * BM + r) * (unsigned)K; }
    DI const char* b_ptr(const Unit& u) const { return Bt + (size_t)u.pn * BM * K; }
};
template <bool GATHER_> struct SchedMoE : OrderBase {
    static constexpr bool GATHER = GATHER_;
    const char* Bt; int K; const int* blke; const int* rowtok; size_t estride;
    DI void init(int nblk, int N, int K_, const void* Bt_, size_t estride_, const int* blke_, const int* rowtok_, int G_, int c_) { init_order(nblk, N / BM, G_, c_); Bt = (const char*)Bt_; K = K_; blke = blke_; rowtok = rowtok_; estride = estride_; }
    DI bool next(int i, Unit& u) const { if (!next_mn(i, u)) return false; u.e = __builtin_amdgcn_readfirstlane(blke[u.pm]); return true; }
    DI bool unit_of(int L, Unit& u) const { u.pm = L / nN; u.pn = L % nN; if (u.pm >= nM) return false; u.e = blke[u.pm]; return true; }
    DI unsigned a_row_off(const Unit& u, int r) const { const int row = u.pm * BM + r; return (unsigned)(GATHER ? rowtok[row] : row) * (unsigned)K; }
    DI const char* b_ptr(const Unit& u) const { return Bt + (size_t)u.e * estride + (size_t)u.pn * BM * K; }
};

template <class E, bool INTACC = false, bool P16_ = false> struct EpiWrap {
    static constexpr bool PERM = true, AFTER_DRAIN = false, P16 = P16_;
    E e;
    DI void operator()(const f32x4 (&acc)[2][2][4][2], const Unit& u, int wr, int wc, int fr, int fq) const {
        const int lc = P16 ? wc * 64 + 16 * fq : wc * 32 + 8 * fq;
        typename E::Pre pre; e.begin(u, lc, pre);
#pragma unroll
        for (int ai = 0; ai < 2; ++ai) {
            typename E::Row rd[4];
#pragma unroll
            for (int m = 0; m < 4; ++m) e.load(u, u.pm * BM + ai * HALF + wr * 64 + m * 16 + fr, lc, rd[m]);
#pragma unroll
            for (int m = 0; m < 4; ++m) {
                const int row = u.pm * BM + ai * HALF + wr * 64 + m * 16 + fr;
                float v0[8], v1[8];
#pragma unroll
                for (int j = 0; j < 4; ++j) {
                    if constexpr (INTACC) { v0[j] = (float)__float_as_int(acc[ai][0][m][0][j]); v0[4 + j] = (float)__float_as_int(acc[ai][0][m][1][j]); v1[j] = (float)__float_as_int(acc[ai][1][m][0][j]); v1[4 + j] = (float)__float_as_int(acc[ai][1][m][1][j]); }
                    else { v0[j] = acc[ai][0][m][0][j]; v0[4 + j] = acc[ai][0][m][1][j]; v1[j] = acc[ai][1][m][0][j]; v1[4 + j] = acc[ai][1][m][1][j]; } }
                e.store(u, row, lc, v0, v1, pre, rd[m]);
            }
        }
    }
};

typedef int i32x4 __attribute__((ext_vector_type(4)));
typedef int i32x8 __attribute__((ext_vector_type(8)));
DI i32x8 cat8(const bf16x8 lo, const bf16x8 hi) { return __builtin_shufflevector(__builtin_bit_cast(i32x4, lo), __builtin_bit_cast(i32x4, hi), 0, 1, 2, 3, 4, 5, 6, 7); }
struct NoHook { static constexpr bool ENABLED = false; DI void apply(f32x4 (&)[2][2][4][2], const Unit&, int, int, int, int) const {} };
template <int MODE  , class Epi, class Sched, class Hook = NoHook, bool ALIGN_EPI = true, bool SP2 = true>
__device__ __forceinline__ void gemm_phase(LAS unsigned char* lds, const int wave_, const char* Abase, const int KB, const Sched& S, const Epi& E, const unsigned stagger_ticks = 0u, const Hook& H = Hook()) {
    if (stagger_ticks) { const unsigned long long t0 = __builtin_amdgcn_s_memrealtime(), dl = (unsigned long long)(xb_xcc_id() & 7u) * stagger_ticks; while (__builtin_amdgcn_s_memrealtime() - t0 < dl) __builtin_amdgcn_s_sleep(16); }
    constexpr bool FP8 = (MODE == 1);
    const int lane = lane_id(), wid = wave_, tid = wid * 64 + lane, wr = wid >> 2, wc = wid & 3, fr = lane & 15, fq = lane >> 4;
    const int nt = KB / 128;
    int Rr[2], Cc[2]; unsigned voffB[2], voffA[2];
#pragma unroll
    for (int i = 0; i < 2; ++i) { stage_rc(tid * 16 + i * 8192, Rr[i], Cc[i]); const int Rb = Epi::PERM ? (Epi::P16 ? (64 * (Rr[i] >> 5) + 16 * ((Rr[i] & 15) >> 2) + 4 * ((Rr[i] >> 4) & 1) + (Rr[i] & 3)) : ((Rr[i] & ~31) + perm32(Rr[i] & 31))) : Rr[i]; voffB[i] = (unsigned)(Rb * KB + Cc[i] * 2); voffA[i] = (unsigned)(Rr[i] * KB + Cc[i] * 2); }
    const size_t kstep = (size_t)(BK * 2);
    const size_t hstep = (size_t)HALF * KB;
    const size_t hstepB = Epi::P16 ? (size_t)8 * KB : hstep;
    const unsigned ldsw = (unsigned)wid * 1024u;
    const int aoff = lds_byte(wr * 64 + fr, fq * 8), boff = lds_byte(wc * 32 + fr, fq * 8);
#define PG8_SA(b, h) (((b) * 2 + (h)) * HTB)
#define PG8_SB(b, h) ((4 + (b) * 2 + (h)) * HTB)
#define PG8_STAGE(bufoff, gbase, v0_, v1_) do { \
        __builtin_amdgcn_global_load_lds((const unsigned*)((const char*)(gbase) + (v0_)), (LAS unsigned*)(lds + (bufoff) + ldsw), 16, 0, 0); \
        __builtin_amdgcn_global_load_lds((const unsigned*)((const char*)(gbase) + (v1_)), (LAS unsigned*)(lds + (bufoff) + ldsw + 8192), 16, 0, 0); } while (0)
#define PG8_STAGEB(bufoff, gbase) PG8_STAGE(bufoff, gbase, voffB[0], voffB[1])
#define PG8_STAGEA(bufoff, h, uptr, kb, useNext) do { if constexpr (Sched::GATHER) { const unsigned o0_ = (useNext) ? nvA[h][0] : vA[h][0], o1_ = (useNext) ? nvA[h][1] : vA[h][1]; PG8_STAGE(bufoff, Abase + (kb), o0_, o1_); } \
        else { PG8_STAGE(bufoff, (uptr) + (h) * hstep, voffA[0], voffA[1]); } } while (0)
#define PG8_LDA(dst, b, h) do { _Pragma("unroll") for (int m = 0; m < 4; ++m) { if constexpr (FP8) dst##8[m] = cat8(*(const LAS bf16x8*)(lds + PG8_SA(b, h) + aoff + m * 2048), *(const LAS bf16x8*)(lds + PG8_SA(b, h) + aoff + m * 2048 + 1024)); \
        else { _Pragma("unroll") for (int k = 0; k < 2; ++k) dst[m][k] = *(const LAS bf16x8*)(lds + PG8_SA(b, h) + aoff + m * 2048 + k * 1024); } } } while (0)
#define PG8_LDB(dst, b, h) do { _Pragma("unroll") for (int n = 0; n < 2; ++n) { if constexpr (FP8) dst##8[n] = cat8(*(const LAS bf16x8*)(lds + PG8_SB(b, h) + boff + n * 2048), *(const LAS bf16x8*)(lds + PG8_SB(b, h) + boff + n * 2048 + 1024)); \
        else { _Pragma("unroll") for (int k = 0; k < 2; ++k) dst[n][k] = *(const LAS bf16x8*)(lds + PG8_SB(b, h) + boff + n * 2048 + k * 1024); } } } while (0)
#define PG8_MMA(ai, bj, At, Bt) do { __builtin_amdgcn_s_setprio(1); _Pragma("unroll") for (int m = 0; m < 4; ++m) _Pragma("unroll") for (int n = 0; n < 2; ++n) { \
        if constexpr (FP8) asm volatile("v_mfma_f32_16x16x128_f8f6f4 %0, %1, %2, %0" : "+v"(acc[ai][bj][m][n]) : "v"(Bt##8[n]), "v"(At##8[m]));   \
        else if constexpr (MODE == 2) { _Pragma("unroll") for (int k = 0; k < 2; ++k) acc[ai][bj][m][n] = __builtin_bit_cast(f32x4, __builtin_amdgcn_mfma_i32_16x16x64_i8(__builtin_bit_cast(i32x4, Bt[n][k]), __builtin_bit_cast(i32x4, At[m][k]), __builtin_bit_cast(i32x4, acc[ai][bj][m][n]), 0, 0, 0)); }   \
        else { _Pragma("unroll") for (int k = 0; k < 2; ++k) acc[ai][bj][m][n] = __builtin_amdgcn_mfma_f32_16x16x32_bf16(Bt[n][k], At[m][k], acc[ai][bj][m][n], 0, 0, 0); } } \
        __builtin_amdgcn_s_setprio(0); } while (0)
#define PG8_WAIT_V(n) asm volatile("s_waitcnt vmcnt(" #n ")" ::: "memory")
#define PG8_WAIT_L(n) asm volatile("s_waitcnt lgkmcnt(" #n ")" ::: "memory")
#define PG8_BAR __builtin_amdgcn_s_barrier()
#define PG8_SCHED __builtin_amdgcn_sched_barrier(0)
    Unit cur, nxt; int ui = 0;
    if (!S.next(0, cur)) return;
    f32x4 acc[2][2][4][2];
#pragma unroll
    for (int a = 0; a < 2; ++a)
#pragma unroll
        for (int b = 0; b < 2; ++b)
#pragma unroll
            for (int m = 0; m < 4; ++m)
#pragma unroll
                for (int n = 0; n < 2; ++n) acc[a][b][m][n] = (f32x4){0.f, 0.f, 0.f, 0.f};
    bf16x8 At[4][2], B0[2][2], B1[2][2];
    i32x8 At8[4], B08[2], B18[2];
    unsigned vA[2][2] = {{0u, 0u}, {0u, 0u}}, nvA[2][2] = {{0u, 0u}, {0u, 0u}};
    const char* cA = Abase; const char* nA = Abase;
    if constexpr (Sched::GATHER) {
#pragma unroll
        for (int h = 0; h < 2; ++h)
#pragma unroll
            for (int i = 0; i < 2; ++i) vA[h][i] = S.a_row_off(cur, h * HALF + Rr[i]) + (unsigned)Cc[i] * 2u;
    } else cA = Abase + (size_t)S.a_row_off(cur, 0);
    const char* cB = S.b_ptr(cur);
    if constexpr (SP2) {
        PG8_STAGEB(PG8_SB(0, 0), cB); PG8_STAGEB(PG8_SB(0, 1), cB + hstepB); PG8_STAGEA(PG8_SA(0, 0), 0, cA, 0, false); PG8_STAGEA(PG8_SA(0, 1), 1, cA, 0, false);
        if (wr == 1) PG8_BAR;
        PG8_WAIT_V(2); PG8_BAR;
        PG8_STAGEB(PG8_SB(1, 0), cB + kstep); PG8_STAGEA(PG8_SA(1, 0), 0, cA + kstep, kstep, false); PG8_STAGEB(PG8_SB(1, 1), cB + hstepB + kstep);
        PG8_WAIT_V(6); PG8_BAR;
    } else {
        PG8_STAGEB(PG8_SB(0, 0), cB); PG8_STAGEA(PG8_SA(0, 0), 0, cA, 0, false); PG8_STAGEB(PG8_SB(0, 1), cB + hstepB); PG8_STAGEA(PG8_SA(0, 1), 1, cA, 0, false);
        if (wr == 1) PG8_BAR;
        PG8_WAIT_V(4); PG8_BAR;
        PG8_STAGEB(PG8_SB(1, 0), cB + kstep); PG8_STAGEA(PG8_SA(1, 0), 0, cA + kstep, kstep, false); PG8_STAGEB(PG8_SB(1, 1), cB + hstepB + kstep);
        PG8_WAIT_V(6); PG8_BAR;
    }
    for (;;) {
        const bool has_next = S.next(ui + 1, nxt);
        const char* nB = cB; nA = cA;
        if (has_next) {
            nB = S.b_ptr(nxt);
            if constexpr (Sched::GATHER) {
#pragma unroll
                for (int h = 0; h < 2; ++h)
#pragma unroll
                    for (int i = 0; i < 2; ++i) nvA[h][i] = S.a_row_off(nxt, h * HALF + Rr[i]) + (unsigned)Cc[i] * 2u;
            } else nA = Abase + (size_t)S.a_row_off(nxt, 0);
        } else if constexpr (Sched::GATHER) {
#pragma unroll
            for (int h = 0; h < 2; ++h)
#pragma unroll
                for (int i = 0; i < 2; ++i) nvA[h][i] = vA[h][i];
        }
#pragma unroll 1
        for (int t = 0; t < nt; t += 2) {
            const bool last = (t == nt - 2);
            if constexpr (Hook::ENABLED) { if (t == nt / 2) H.apply(acc, cur, wr, wc, fr, fq); }
            const char* a1 = cA + (size_t)(t + 1) * kstep; const size_t k1 = (size_t)(t + 1) * kstep;
            const char* a2 = last ? nA : cA + (size_t)(t + 2) * kstep; const char* b2 = last ? nB : cB + (size_t)(t + 2) * kstep; const size_t k2 = last ? (size_t)0 : (size_t)(t + 2) * kstep;
            const char* a3 = a2 + kstep; const char* b3 = b2 + kstep; const size_t k3 = k2 + kstep;
            if constexpr (SP2) {
            PG8_LDB(B0, 0, 0); PG8_LDB(B1, 0, 1); PG8_SCHED; PG8_LDA(At, 0, 0); PG8_STAGEA(PG8_SA(1, 1), 1, a1, k1, false);
            PG8_WAIT_V(8); PG8_WAIT_L(0); PG8_BAR; PG8_MMA(0, 0, At, B0); PG8_MMA(0, 1, At, B1); PG8_BAR; PG8_SCHED;
            PG8_LDA(At, 0, 1); PG8_STAGEB(PG8_SB(0, 0), b2); PG8_STAGEB(PG8_SB(0, 1), b2 + hstepB); PG8_STAGEA(PG8_SA(0, 0), 0, a2, k2, last);
            PG8_WAIT_V(8); PG8_WAIT_L(0); PG8_BAR; PG8_MMA(1, 0, At, B0); PG8_MMA(1, 1, At, B1); PG8_BAR; PG8_SCHED;
            PG8_LDB(B0, 1, 0); PG8_LDB(B1, 1, 1); PG8_SCHED; PG8_LDA(At, 1, 0); PG8_STAGEA(PG8_SA(0, 1), 1, a2, k2, last);
            PG8_WAIT_V(8); PG8_WAIT_L(0); PG8_BAR; PG8_MMA(0, 0, At, B0); PG8_MMA(0, 1, At, B1); PG8_BAR; PG8_SCHED;
            PG8_LDA(At, 1, 1); PG8_STAGEB(PG8_SB(1, 0), b3); PG8_STAGEB(PG8_SB(1, 1), b3 + hstepB); PG8_STAGEA(PG8_SA(1, 0), 0, a3, k3, last);
            PG8_WAIT_V(8); PG8_WAIT_L(0); PG8_BAR; PG8_MMA(1, 0, At, B0); PG8_MMA(1, 1, At, B1); PG8_BAR; PG8_SCHED;
            } else {
            PG8_LDB(B0, 0, 0); PG8_SCHED; PG8_LDA(At, 0, 0); PG8_STAGEA(PG8_SA(1, 1), 1, a1, k1, false);
            PG8_WAIT_L(8); PG8_BAR; PG8_WAIT_L(0); PG8_MMA(0, 0, At, B0); PG8_BAR; PG8_SCHED;
            PG8_LDB(B1, 0, 1); PG8_STAGEB(PG8_SB(0, 0), b2);
            PG8_BAR; PG8_WAIT_L(0); PG8_MMA(0, 1, At, B1); PG8_BAR;
            PG8_LDA(At, 0, 1); PG8_STAGEA(PG8_SA(0, 0), 0, a2, k2, last);
            PG8_BAR; PG8_WAIT_L(0); PG8_MMA(1, 0, At, B0); PG8_BAR; PG8_SCHED;
            PG8_STAGEB(PG8_SB(0, 1), b2 + hstepB);
            PG8_WAIT_V(6); PG8_BAR; PG8_MMA(1, 1, At, B1); PG8_BAR;
            PG8_LDB(B0, 1, 0); PG8_SCHED; PG8_LDA(At, 1, 0); PG8_STAGEA(PG8_SA(0, 1), 1, a2, k2, last);
            PG8_WAIT_L(8); PG8_BAR; PG8_WAIT_L(0); PG8_MMA(0, 0, At, B0); PG8_BAR; PG8_SCHED;
            PG8_LDB(B1, 1, 1); PG8_STAGEB(PG8_SB(1, 0), b3);
            PG8_BAR; PG8_WAIT_L(0); PG8_MMA(0, 1, At, B1); PG8_BAR;
            PG8_LDA(At, 1, 1); PG8_STAGEA(PG8_SA(1, 0), 0, a3, k3, last);
            PG8_BAR; PG8_WAIT_L(0); PG8_MMA(1, 0, At, B0); PG8_BAR; PG8_SCHED;
            PG8_STAGEB(PG8_SB(1, 1), b3 + hstepB);
            PG8_WAIT_V(6); PG8_BAR; PG8_MMA(1, 1, At, B1); PG8_BAR;
            }
        }
        if constexpr (FP8) asm volatile("s_nop 15\n\ts_nop 15" ::: "memory");
        if constexpr (ALIGN_EPI) { if (wr == 0) PG8_BAR; }
        E(acc, cur, wr, wc, fr, fq);
        if (!has_next) break;
#pragma unroll
        for (int a = 0; a < 2; ++a)
#pragma unroll
            for (int b = 0; b < 2; ++b)
#pragma unroll
                for (int m = 0; m < 4; ++m)
#pragma unroll
                    for (int n = 0; n < 2; ++n) acc[a][b][m][n] = (f32x4){0.f, 0.f, 0.f, 0.f};
        cur = nxt; cB = nB; cA = nA; ++ui;
        if constexpr (Sched::GATHER) {
#pragma unroll
            for (int h = 0; h < 2; ++h)
#pragma unroll
                for (int i = 0; i < 2; ++i) vA[h][i] = nvA[h][i];
        }
        if constexpr (ALIGN_EPI) { if (wr == 1) PG8_BAR; }
    }
    PG8_WAIT_V(0);
    if constexpr (!ALIGN_EPI) { if (wr == 0) PG8_BAR; }
    PG8_BAR;
#undef PG8_SA
#undef PG8_SB
#undef PG8_STAGE
#undef PG8_STAGEB
#undef PG8_STAGEA
#undef PG8_LDA
#undef PG8_LDB
#undef PG8_MMA
#undef PG8_WAIT_V
#undef PG8_WAIT_L
#undef PG8_BAR
#undef PG8_SCHED
}
}
using pg8::Unit;

struct EInproj {
    struct Row { float rs; }; DI void load(const Unit&, int row, int, Row& r) const { r.rs = rs0[row]; }
    struct Pre { float lb[2][8]; };
    DI void begin(const Unit& u, int lc, Pre& p) const {
        if ((u.pn >> 2) == 1) {
#pragma unroll
            for (int bj = 0; bj < 2; ++bj)
#pragma unroll
                for (int i = 0; i < 8; ++i) { const int c = u.pn * 256 + bj * 128 + lc - 1024 + i; p.lb[bj][i] = sigm(hlb[c] - hlb[1024 + c]); }
        }
    }
    bf16* Z; bf16* LF; const float* rs0; const float* hlb;
    DI void store(const Unit& u, int row, int lc, const float (&v0)[8], const float (&v1)[8], const Pre& pre, const Row& rd) const {
        const float rs = rd.rs * (1.f / SQ_W);
        const int kind = u.pn >> 2;
        if (u.pn >= 28) {
            const int g = (u.pn - 28) * 16 + (lc >> 3); float sa[8], sb[8];
#pragma unroll
            for (int i = 0; i < 8; ++i) {
                const float za = fminf(fmaxf(rs * v0[i], -30.f), 30.f), zb = fminf(fmaxf(rs * v1[i], -30.f), 30.f);
                const float ea = __expf(-za), eb = __expf(-zb);
                sa[i] = __builtin_amdgcn_rcpf(1.f + ea); sb[i] = fmaxf(__builtin_amdgcn_rcpf(1.f + eb), 1.f / 255.f);
            }
            u32x4 q; q.x = pk4_u8(sa[0], sa[1], sa[2], sa[3]); q.y = pk4_u8(sa[4], sa[5], sa[6], sa[7]); q.z = pk4_u8(sb[0], sb[1], sb[2], sb[3]); q.w = pk4_u8(sb[4], sb[5], sb[6], sb[7]);
            *(u32x4*)((unsigned char*)(Z + (size_t)row * NZ + ZRA) + 16 * g) = q;
            return;
        }
#pragma unroll
        for (int bj = 0; bj < 2; ++bj) {
            const int col = u.pn * 256 + bj * 128 + lc;
            float o[8];
            if (kind == 2 || kind == 4 || kind == 5) {
#pragma unroll
                for (int i = 0; i < 8; ++i) o[i] = rs * (bj ? v1[i] : v0[i]);
            } else if (kind == 1) {
                const int c = col - 1024;
                float lf[8];
#pragma unroll
                for (int i = 0; i < 8; ++i) {
                    const float lbv = pre.lb[bj][i];
                    float z = rs * (bj ? v1[i] : v0[i]); z = fminf(fmaxf(z, -80.f), 80.f);
                    const float e = __expf(-z), s = __builtin_amdgcn_rcpf(1.f + e), sn = e * s;
                    lf[i] = __logf(lbv + (1.f - lbv) * s);
                    o[i] = (1.f - lbv) * sn;
                }
                *(u32x4*)(LF + (size_t)row * 1024 + c) = pack8(lf);
            } else {
                const bool silu = (kind == 0 || kind == 3);
#pragma unroll
                for (int i = 0; i < 8; ++i) { const float z = rs * (bj ? v1[i] : v0[i]); const float s = sigm(z); o[i] = silu ? z * s : s; }
            }
            *(u32x4*)(Z + (size_t)row * NZ + col) = pack8(o);
        }
    }
};
struct ENullProbe {
    struct Row {}; DI void load(const Unit&, int, int, Row&) const {}
    struct Pre {}; DI void begin(const Unit&, int, Pre&) const {}
    float* sink; int flag;
    DI void store(const Unit& u, int row, int lc, const float (&v0)[8], const float (&v1)[8], const Pre& pre, const Row& rd) const {
        if (flag) { float a = 0.f;
#pragma unroll
            for (int i = 0; i < 8; ++i) a += v0[i] + v1[i];
            sink[(size_t)row * 256 + lc] = a; }
    }
};
struct MixHook {
    static constexpr bool ENABLED = true;
    const bf16* Z;
    DI void apply(f32x4 (&acc)[2][2][4][2], const Unit& u, int wr, int wc, int fr, int fq) const {
        int frl = fr; asm volatile("" : "+v"(frl));
        const unsigned char* base = (const unsigned char*)(Z + (size_t)(u.pm * 256 + wr * 64 + frl) * NZ + ZRA) + 16 * (u.pn * 32 + wc * 8 + 2 * fq);
#pragma unroll
        for (int ai = 0; ai < 2; ++ai) {
            u32x4 rr[4][2];
#pragma unroll
            for (int m = 0; m < 4; ++m)
#pragma unroll
                for (int bj = 0; bj < 2; ++bj) rr[m][bj] = *(const u32x4*)(base + (size_t)(ai * 128 + m * 16) * NZ * 2 + bj * 16);
#pragma unroll
            for (int m = 0; m < 4; ++m)
#pragma unroll
                for (int bj = 0; bj < 2; ++bj) { float a[8];
#pragma unroll
                    for (int j = 0; j < 4; ++j) { a[j] = ub(rr[m][bj].x, j) * __builtin_amdgcn_rcpf(ub(rr[m][bj].z, j)); a[4 + j] = ub(rr[m][bj].y, j) * __builtin_amdgcn_rcpf(ub(rr[m][bj].w, j)); }
#pragma unroll
                    for (int j = 0; j < 4; ++j) {
                        acc[ai][bj][m][0][j] = __int_as_float(__float2int_rn((float)__float_as_int(acc[ai][bj][m][0][j]) * (a[j] * (SQ_YB / SQ_YA))));
                        acc[ai][bj][m][1][j] = __int_as_float(__float2int_rn((float)__float_as_int(acc[ai][bj][m][1][j]) * (a[4 + j] * (SQ_YB / SQ_YA)))); } }
        }
    }
};
struct EMixF {
    struct Row { u32x2 g[2]; }; DI void load(const Unit& u, int row, int lc, Row& r) const { const unsigned char* p = (const unsigned char*)(Z + (size_t)row * NZ + ZRA) + 2 * (u.pn * 256 + lc) + 8; r.g[0] = *(const u32x2*)p; r.g[1] = *(const u32x2*)(p + 16); }
    struct Pre {}; DI void begin(const Unit&, int, Pre&) const {}
    const bf16* Z; unsigned char* MIX;
    DI void store(const Unit& u, int row, int lc, const float (&v0)[8], const float (&v1)[8], const Pre& pre, const Row& rd) const {
        u32x4 q16;
#pragma unroll
        for (int bj = 0; bj < 2; ++bj) {
            float g[8], o[8];
#pragma unroll
            for (int i = 0; i < 4; ++i) { g[i] = ub(rd.g[bj].x, i); g[4 + i] = ub(rd.g[bj].y, i); }
#pragma unroll
            for (int i = 0; i < 8; ++i) o[i] = g[i] * (bj ? v1[i] : v0[i]) * (1.f / (255.f * SQ_YB * SQ_WAB));
            if (bj == 0) { q16.x = pk4_i8(o[0], o[1], o[2], o[3], SQ_M); q16.y = pk4_i8(o[4], o[5], o[6], o[7], SQ_M); } else { q16.z = pk4_i8(o[0], o[1], o[2], o[3], SQ_M); q16.w = pk4_i8(o[4], o[5], o[6], o[7], SQ_M); }
        }
        *(u32x4*)(MIX + (size_t)row * D + u.pn * 256 + lc) = q16;
    }
};
struct EMixA {
    struct Row {}; DI void load(const Unit&, int, int, Row&) const {}
    struct Pre {}; DI void begin(const Unit&, int, Pre&) const {}
    float* MIXT; const bf16* Z;
    DI void store(const Unit& u, int row, int lc, const float (&v0)[8], const float (&v1)[8], const Pre& pre, const Row& rd) const {
#pragma unroll
        for (int bj = 0; bj < 2; ++bj) {
            const int col = u.pn * 256 + bj * 128 + lc; float g[8];
            unpack8(*(const u32x4*)(Z + (size_t)row * NZ + ZRA + col), g);
            float* p = MIXT + (size_t)row * D + col;
            f32x4 a, b;
#pragma unroll
            for (int i = 0; i < 4; ++i) { a[i] = g[i] * (bj ? v1[i] : v0[i]); b[i] = g[4 + i] * (bj ? v1[4 + i] : v0[4 + i]); }
            *(f32x4*)p = a; *(f32x4*)(p + 4) = b;
        }
    }
};
struct EMixB {
    struct Row {}; DI void load(const Unit&, int, int, Row&) const {}
    struct Pre {}; DI void begin(const Unit&, int, Pre&) const {}
    const float* MIXT; const bf16* Z; bf16* MIX;
    DI void store(const Unit& u, int row, int lc, const float (&v0)[8], const float (&v1)[8], const Pre& pre, const Row& rd) const {
#pragma unroll
        for (int bj = 0; bj < 2; ++bj) {
            const int col = u.pn * 256 + bj * 128 + lc; float g[8], o[8];
            unpack8(*(const u32x4*)(Z + (size_t)row * NZ + ZRB + col), g);
            const float* p = MIXT + (size_t)row * D + col;
            const f32x4 a = *(const f32x4*)p, b = *(const f32x4*)(p + 4);
#pragma unroll
            for (int i = 0; i < 4; ++i) { o[i] = a[i] + g[i] * (bj ? v1[i] : v0[i]); o[4 + i] = b[i] + g[4 + i] * (bj ? v1[4 + i] : v0[4 + i]); }
            *(u32x4*)(MIX + (size_t)row * D + col) = pack8(o);
        }
    }
};
struct EX1 {
    struct Row { f32x4 x[4]; }; DI void load(const Unit& u, int row, int lc, Row& r) const { const float* p = x + (size_t)row * D + u.pn * 256 + lc; r.x[0] = *(const f32x4*)p; r.x[1] = *(const f32x4*)(p + 4); r.x[2] = *(const f32x4*)(p + 8); r.x[3] = *(const f32x4*)(p + 12); }
    struct Pre {}; DI void begin(const Unit&, int, Pre&) const {}
    const float* x; bf16* X1; unsigned char* X18; float* SS1;
    DI void store(const Unit& u, int row, int lc, const float (&v0)[8], const float (&v1)[8], const Pre& pre, const Row& rd) const {
        u32x4 q16;
#pragma unroll
        for (int bj = 0; bj < 2; ++bj) {
            const int col = u.pn * 256 + bj * 8 + lc; float o[8];
            const f32x4 a = rd.x[2 * bj], b = rd.x[2 * bj + 1];
#pragma unroll
            for (int i = 0; i < 4; ++i) { o[i] = a[i] + (bj ? v1[i] : v0[i]) * (1.f / (SQ_M * SQ_W)); o[4 + i] = b[i] + (bj ? v1[4 + i] : v0[4 + i]) * (1.f / (SQ_M * SQ_W)); }
            *(u32x4*)(X1 + (size_t)row * D + col) = pack8(o);
            if (bj == 0) { q16.x = pk4_i8(o[0], o[1], o[2], o[3], SQ_X); q16.y = pk4_i8(o[4], o[5], o[6], o[7], SQ_X); } else { q16.z = pk4_i8(o[0], o[1], o[2], o[3], SQ_X); q16.w = pk4_i8(o[4], o[5], o[6], o[7], SQ_X); }
        }
        *(u32x4*)(X18 + (size_t)row * D + u.pn * 256 + lc) = q16;
    }
};
struct ESwiglu {
    struct Row { float rs; }; DI void load(const Unit&, int row, int, Row& r) const { r.rs = rowrs[row]; }
    typedef float f2 __attribute__((ext_vector_type(2)));
    struct Pre { f2 ba[4], bu[4]; };
    DI void begin(const Unit& u, int lc, Pre& p) const {
        const float* b = bgu + (size_t)u.e * 4096 + u.pn * 128 + lc;
#pragma unroll
        for (int i = 0; i < 4; ++i) { p.ba[i] = (f2){b[2 * i], b[2 * i + 1]}; p.bu[i] = (f2){b[2048 + 2 * i], b[2048 + 2 * i + 1]}; }
    }
    unsigned char* ACT; const float* rowrs; const float* bgu;
    DI void store(const Unit& u, int row, int lc, const float (&v0)[8], const float (&v1)[8], const Pre& pre, const Row& rd) const {
        const float rs = rd.rs * (1.f / (SQ_X * SQ_W));
        const int j = u.pn * 128 + lc; float o[8];
#pragma unroll
        for (int i = 0; i < 4; ++i) {
            f2 a = (f2){v0[2 * i], v0[2 * i + 1]} * rs + pre.ba[i], uu = (f2){v1[2 * i], v1[2 * i + 1]} * rs + pre.bu[i];
            a.x = fminf(a.x, 7.f); a.y = fminf(a.y, 7.f); uu.x = __builtin_amdgcn_fmed3f(uu.x, -7.f, 7.f); uu.y = __builtin_amdgcn_fmed3f(uu.y, -7.f, 7.f);
            const f2 z = a * (-1.702f * 1.44269504f);
            f2 e; e.x = __builtin_amdgcn_exp2f(z.x); e.y = __builtin_amdgcn_exp2f(z.y);
            const f2 d = e * (1.f / SC_ACT) + (1.f / SC_ACT);
            f2 r; r.x = __builtin_amdgcn_rcpf(d.x); r.y = __builtin_amdgcn_rcpf(d.y);
            const f2 at = a * r, ov = uu * at + at;
            o[2 * i] = ov.x; o[2 * i + 1] = ov.y;
        }
        u32x2 q8; q8.x = pk4_fp8(o[0], o[1], o[2], o[3]); q8.y = pk4_fp8(o[4], o[5], o[6], o[7]);
        *(u32x2*)(ACT + (size_t)row * DFF + j) = q8;
    }
};
template <bool P16> struct EDownT {
    struct Row { float g; }; DI void load(const Unit&, int row, int, Row& r) const { r.g = rowg[row]; }
    struct Pre { float b[2][8]; };
    DI void begin(const Unit& u, int lc, Pre& p) const {
#pragma unroll
        for (int bj = 0; bj < 2; ++bj)
#pragma unroll
            for (int i = 0; i < 8; ++i) p.b[bj][i] = bdn[(size_t)u.e * D + u.pn * 256 + bj * (P16 ? 8 : 128) + lc + i];
    }
    unsigned char* YB; const float* rowg; const float* bdn;
    DI void store(const Unit& u, int row, int lc, const float (&v0)[8], const float (&v1)[8], const Pre& pre, const Row& rd) const {
        const float g = rd.g * SC_Y;
        u32x4 q16;
#pragma unroll
        for (int bj = 0; bj < 2; ++bj) {
            const int col = u.pn * 256 + bj * 128 + lc; float o[8];
#pragma unroll
            for (int i = 0; i < 8; ++i) o[i] = clamp8(((bj ? v1[i] : v0[i]) * (1.f / (SC_ACT * SC_WDN)) + pre.b[bj][i]) * g);
            u32x2 q8; q8.x = pk4_fp8(o[0], o[1], o[2], o[3]); q8.y = pk4_fp8(o[4], o[5], o[6], o[7]);
            if constexpr (P16) { if (bj == 0) { q16.x = q8.x; q16.y = q8.y; } else { q16.z = q8.x; q16.w = q8.y; } }
            else *(u32x2*)(YB + (size_t)row * D + col) = q8;
        }
        if constexpr (P16) *(u32x4*)(YB + (size_t)row * D + u.pn * 256 + lc) = q16;
    }
};
typedef EDownT<true> EDown;
struct EPw {
    struct Row {}; DI void load(const Unit&, int, int, Row&) const {}
    struct Pre {}; DI void begin(const Unit&, int, Pre&) const {}
    bf16* PW;
    DI void store(const Unit& u, int row, int lc, const float (&v0)[8], const float (&v1)[8], const Pre& pre, const Row& rd) const {
        *(u32x4*)(PW + (size_t)row * D + u.pn * 256 + lc) = pack8(v0);
        *(u32x4*)(PW + (size_t)row * D + u.pn * 256 + 8 + lc) = pack8(v1);
    }
};
struct EGate {
    struct Row { float rs; u32x4 x2[2], pw[2]; }; DI void load(const Unit& u, int row, int lc, Row& r) const { r.rs = rs2[row]; const size_t o = (size_t)row * D + u.pn * 256 + lc; r.x2[0] = *(const u32x4*)(X2 + o); r.x2[1] = *(const u32x4*)(X2 + o + 8); r.pw[0] = *(const u32x4*)(PW + o); r.pw[1] = *(const u32x4*)(PW + o + 8); }
    struct Pre {}; DI void begin(const Unit&, int, Pre&) const {}
    const bf16* X2; const bf16* PW; const float* rs2; bf16* X3; float* SS3;
    DI void store(const Unit& u, int row, int lc, const float (&v0)[8], const float (&v1)[8], const Pre& pre, const Row& rd) const {
        const float rs = rd.rs * (1.f / (SQ_X * SQ_W));
#pragma unroll
        for (int bj = 0; bj < 2; ++bj) {
            const int col = u.pn * 256 + bj * 8 + lc; float pw[8], o[8];
            unpack8(rd.pw[bj], pw);
            float xv[8]; unpack8(rd.x2[bj], xv);
#pragma unroll
            for (int i = 0; i < 8; ++i) o[i] = xv[i] + pw[i] * sigm(rs * (bj ? v1[i] : v0[i]));
            *(u32x4*)(X3 + (size_t)row * D + col) = pack8(o);
        }
    }
};

struct Args {
    const float* in[25]; float* out; unsigned char* ws; int ph_lo, ph_hi;
};
enum { I_X = 0, I_P, I_NORM_MIX, I_W_IN, I_HGRN_LB, I_HGRN_NORM, I_CONV_W, I_CONV_B, I_B_I, I_B_F, I_MLSTM_NORM, I_W_BRA, I_W_BRB, I_W_OUT, I_NORM_MOE,
       I_ROUTER_W, I_ROUTER_B, I_W_GU, I_B_GU, I_W_DN, I_B_DN, I_NORM_PLE, I_W_PLE, I_W_PLE_GATE, I_NORM_FINAL };

struct Frame {
    LAS unsigned char* lds; int wave, G, bid;
    const float* const* in; float* out; unsigned char* ws;
    template <class Tp> DI Tp* p(size_t off) const { return (Tp*)(ws + off); }
};

constexpr int LDS_BYTES = 147456;
constexpr int LDS_MISC = 131072;

DI void tr_tile(const float* __restrict__ W, size_t ldw, int k0, int sc0, const float* __restrict__ kscale, bf16* __restrict__ dst, size_t drow0, int ldd, LAS unsigned* scr, int lane, int kd0 = -1) {
    if (kd0 < 0) kd0 = k0;
    const int a = lane & 15, b = lane >> 4;
    f32x4 v[16];
#pragma unroll
    for (int i = 0; i < 8; ++i) {
        const int k = k0 + 8 * i + 2 * b;
        v[2 * i] = *(const f32x4*)(W + (size_t)k * ldw + sc0 + 4 * a);
        v[2 * i + 1] = *(const f32x4*)(W + (size_t)(k + 1) * ldw + sc0 + 4 * a);
    }
#pragma unroll
    for (int i = 0; i < 8; ++i) {
        const int k = k0 + 8 * i + 2 * b;
        float s0 = 1.f, s1 = 1.f; if (kscale) { s0 = kscale[k]; s1 = kscale[k + 1]; }
#pragma unroll
        for (int c = 0; c < 4; ++c) scr[(4 * a + c) * 33 + 4 * i + b] = pk2(v[2 * i][c] * s0, v[2 * i + 1][c] * s1);
    }
    asm volatile("s_waitcnt lgkmcnt(0)" ::: "memory");
#pragma unroll
    for (int j = 0; j < 8; ++j) {
        const int n = (lane >> 3) + 8 * j, kc = lane & 7;
        u32x4 o; o.x = scr[n * 33 + 4 * kc]; o.y = scr[n * 33 + 4 * kc + 1]; o.z = scr[n * 33 + 4 * kc + 2]; o.w = scr[n * 33 + 4 * kc + 3];
        *(u32x4*)(dst + (drow0 + n) * (size_t)ldd + kd0 + 8 * kc) = o;
    }
    asm volatile("s_waitcnt lgkmcnt(0)" ::: "memory");
}

template <bool I8> DI void tr_tile8(const float* __restrict__ W, size_t ldw, int k0, int sc0, const float* __restrict__ kscale, float wscale, unsigned char* __restrict__ dst, size_t drow0, int ldd, LAS unsigned* scr, int lane) {
    const int a = lane & 15, b = lane >> 4;
    f32x4 v[16];
#pragma unroll
    for (int i = 0; i < 4; ++i)
#pragma unroll
        for (int r = 0; r < 4; ++r) v[4 * i + r] = *(const f32x4*)(W + (size_t)(k0 + 16 * i + 4 * b + r) * ldw + sc0 + 4 * a);
#pragma unroll
    for (int i = 0; i < 4; ++i) {
        const int k = k0 + 16 * i + 4 * b;
        float s0 = wscale, s1 = wscale, s2 = wscale, s3 = wscale; if (kscale) { s0 *= kscale[k]; s1 *= kscale[k + 1]; s2 *= kscale[k + 2]; s3 *= kscale[k + 3]; }
#pragma unroll
        for (int c = 0; c < 4; ++c) scr[(4 * a + c) * 17 + 4 * i + b] = I8 ? pk4_i8(v[4 * i][c] * s0, v[4 * i + 1][c] * s1, v[4 * i + 2][c] * s2, v[4 * i + 3][c] * s3, 1.f) : pk4_fp8(v[4 * i][c] * s0, v[4 * i + 1][c] * s1, v[4 * i + 2][c] * s2, v[4 * i + 3][c] * s3);
    }
    asm volatile("s_waitcnt lgkmcnt(0)" ::: "memory");
#pragma unroll
    for (int j = 0; j < 4; ++j) {
        const int n = (lane >> 2) + 16 * j, kc = lane & 3;
        u32x4 o; o.x = scr[n * 17 + 4 * kc]; o.y = scr[n * 17 + 4 * kc + 1]; o.z = scr[n * 17 + 4 * kc + 2]; o.w = scr[n * 17 + 4 * kc + 3];
        *(u32x4*)(dst + (drow0 + n) * (size_t)ldd + k0 + 16 * kc) = o;
    }
    asm volatile("s_waitcnt lgkmcnt(0)" ::: "memory");
}

DI void p0_prologue(const Frame& F) {
    const int lane = lane_id(), wave = F.wave, tid = wave * 64 + lane;
    const int gw = F.bid * 8 + wave, NGW = F.G * 8;
    float w8w[32], w8g[32];
#pragma unroll
    for (int i = 0; i < 32; ++i) { const int idx = tid + 512 * i, k = idx >> 3, j = idx & 7; w8w[i] = F.in[I_W_IN][(size_t)k * INCOLS + 6144 + j]; w8g[i] = F.in[I_NORM_MIX][k]; }
    {
        LAS unsigned* scr = (LAS unsigned*)(F.lds + wave * 8704);
        constexpr int TI_WIN = 32 * 176, TI_WA = 16 * 32, TI_WB = 16 * 32, TI_WOUT = 32 * 32, TI_WPG = 32 * 32, TI_WPLE = 4 * 32, TI_WGU = 32 * 2048, TI_WDN = 32 * 1024;
        constexpr int NTI = TI_WIN + TI_WA + TI_WB + TI_WOUT + TI_WPG + TI_WPLE;
        for (int it = gw; it < NTI; it += NGW) {
            int r = it;
            if (r < TI_WIN) { const int kb = r / 176, nb = r % 176, n0 = 64 * nb; int sc0 = n0 < 6144 ? n0 : n0 + 8;
                if (n0 >= 7168) { const int q = n0 - 7168, within = q & 255; sc0 = ((within >> 7) ? 9224 : 7176) + (q >> 8) * 128 + (within & 127); }
                tr_tile8<true>(F.in[I_W_IN], INCOLS, 64 * kb, sc0, F.in[I_NORM_MIX], SQ_W, F.p<unsigned char>(O_WIN), n0, D, scr, lane); continue; } r -= TI_WIN;
            if (r < TI_WA) { const int kb = r / 32, nb = r % 32; tr_tile8<true>(F.in[I_W_BRA], D, 64 * kb, 64 * nb, F.in[I_HGRN_NORM], SQ_WAB, F.p<unsigned char>(O_WA), 64 * nb, 2048, scr, lane); continue; } r -= TI_WA;
            if (r < TI_WB) { const int kb = r / 32, nb = r % 32; tr_tile8<true>(F.in[I_W_BRB], D, 64 * kb, 64 * nb, F.in[I_MLSTM_NORM], SQ_WAB, F.p<unsigned char>(O_WA) + 1024, 64 * nb, 2048, scr, lane); continue; } r -= TI_WB;
            if (r < TI_WOUT) { const int kb = r / 32, nb = r % 32; tr_tile8<true>(F.in[I_W_OUT], D, 64 * kb, 64 * nb, nullptr, SQ_W, F.p<unsigned char>(O_WOUT), 64 * nb, D, scr, lane); continue; } r -= TI_WOUT;
            if (r < TI_WPG) { const int kb = r / 32, nb = r % 32; tr_tile8<true>(F.in[I_W_PLE_GATE], D, 64 * kb, 64 * nb, F.in[I_NORM_PLE], SQ_W, F.p<unsigned char>(O_WPG), 64 * nb, D, scr, lane); continue; } r -= TI_WPG;
            { const int kb = r / 32, nb = r % 32; tr_tile(F.in[I_W_PLE], D, 64 * kb, 64 * nb, nullptr, F.p<bf16>(O_WPLE), 64 * nb, PLE, scr, lane); }
            (void)r;
        }
    }
    __syncthreads();
    LAS float* W8 = (LAS float*)F.lds;
#pragma unroll
    for (int i = 0; i < 32; ++i) { const int idx = tid + 512 * i, k = idx >> 3, j = idx & 7; W8[j * D + k] = w8w[i] * w8g[i]; }
    __syncthreads();
    {
        const float* x = F.in[I_X]; bf16* XB = F.p<bf16>(O_XB); float* RS0 = F.p<float>(O_RS0); float* GT = F.p<float>(O_GATES);
        typedef float f2 __attribute__((ext_vector_type(2)));
        for (int m = gw; m < T; m += 2 * NGW) {
            const bool has1 = m + NGW < T; const int m1 = has1 ? m + NGW : m;
            const f32x4* xr0 = (const f32x4*)(x + (size_t)m * D) + lane; const f32x4* xr1 = (const f32x4*)(x + (size_t)m1 * D) + lane;
            f32x4 v0[8], v1[8]; float ss0 = 0.f, am0 = 0.f, ss1 = 0.f, am1 = 0.f;
#pragma unroll
            for (int j = 0; j < 8; ++j) v0[j] = xr0[64 * j];
#pragma unroll
            for (int j = 0; j < 8; ++j) v1[j] = xr1[64 * j];
#pragma unroll
            for (int j = 0; j < 8; ++j) { ss0 += (v0[j].x * v0[j].x + v0[j].y * v0[j].y) + (v0[j].z * v0[j].z + v0[j].w * v0[j].w);
                am0 = fmaxf(am0, fmaxf(fmaxf(fabsf(v0[j].x), fabsf(v0[j].y)), fmaxf(fabsf(v0[j].z), fabsf(v0[j].w)))); }
#pragma unroll
            for (int j = 0; j < 8; ++j) { ss1 += (v1[j].x * v1[j].x + v1[j].y * v1[j].y) + (v1[j].z * v1[j].z + v1[j].w * v1[j].w);
                am1 = fmaxf(am1, fmaxf(fmaxf(fabsf(v1[j].x), fabsf(v1[j].y)), fmaxf(fabsf(v1[j].z), fabsf(v1[j].w)))); }
            ss0 = wave_sum(ss0); am0 = wave_max(am0); ss1 = wave_sum(ss1); am1 = wave_max(am1);
            const float rstd0 = rsqrtf(ss0 * (1.f / D) + EPS), rstd1 = rsqrtf(ss1 * (1.f / D) + EPS);
            const float sx0 = am0 > 0.f ? 127.f / am0 : 1.f, sx1 = am1 > 0.f ? 127.f / am1 : 1.f;
            unsigned* o0 = (unsigned*)((unsigned char*)XB + (size_t)m * D) + lane; unsigned* o1 = (unsigned*)((unsigned char*)XB + (size_t)m1 * D) + lane;
#pragma unroll
            for (int j = 0; j < 8; ++j) o0[64 * j] = pk4_i8(v0[j].x, v0[j].y, v0[j].z, v0[j].w, sx0);
            if (has1) {
#pragma unroll
                for (int j = 0; j < 8; ++j) o1[64 * j] = pk4_i8(v1[j].x, v1[j].y, v1[j].z, v1[j].w, sx1); }
            float g0[8], g1[8];
            int lw = lane; asm volatile("" : "+v"(lw));
#pragma unroll
            for (int jj = 0; jj < 8; ++jj) { f2 a0 = {0.f, 0.f}, a1 = {0.f, 0.f};
#pragma unroll
                for (int j = 0; j < 8; ++j) { const f32x4 w = *(const LAS f32x4*)(W8 + jj * D + 4 * (lw + 64 * j)); const f2 wl = {w.x, w.y}, wh = {w.z, w.w};
                    a0 += (f2){v0[j].x, v0[j].y} * wl; a0 += (f2){v0[j].z, v0[j].w} * wh; a1 += (f2){v1[j].x, v1[j].y} * wl; a1 += (f2){v1[j].z, v1[j].w} * wh; }
                g0[jj] = wave_sum(a0.x + a0.y); g1[jj] = wave_sum(a1.x + a1.y); }
            if (lane == 0) { RS0[m] = rstd0 / sx0;
#pragma unroll
                for (int jj = 0; jj < 8; ++jj) GT[(size_t)m * 8 + jj] = rstd0 * g0[jj] + (jj < 4 ? F.in[I_B_I][jj] : F.in[I_B_F][jj - 4]);
                if (has1) { RS0[m1] = rstd1 / sx1;
#pragma unroll
                    for (int jj = 0; jj < 8; ++jj) GT[(size_t)m1 * 8 + jj] = rstd1 * g1[jj] + (jj < 4 ? F.in[I_B_I][jj] : F.in[I_B_F][jj - 4]); } }
        }
    }
    {
        const f32x4* p4 = (const f32x4*)F.in[I_P]; u32x2* o = (u32x2*)F.p<bf16>(O_PB);
        const size_t n4 = (size_t)T * PLE / 4, st = (size_t)F.G * 512;
        for (size_t i = (size_t)F.bid * 512 + tid; i < n4; i += 8 * st) {
            f32x4 v[8];
#pragma unroll
            for (int k = 0; k < 8; ++k) { const size_t ik = i + k * st; v[k] = p4[ik < n4 ? ik : i]; }
#pragma unroll
            for (int k = 0; k < 8; ++k) { const size_t ik = i + k * st; if (ik < n4) { u32x2 w; w.x = pk2(v[k].x, v[k].y); w.y = pk2(v[k].z, v[k].w); o[ik] = w; } }
        }
    }
    {
        float* RWG = F.p<float>(O_RWG);
        for (int i = F.bid * 512 + tid; i < D * NE; i += F.G * 512) RWG[i] = F.in[I_ROUTER_W][i] * F.in[I_NORM_MOE][i >> 5];
    }
    __syncthreads();
}

DI void p7_route(const Frame& F) {
    constexpr int XP = 68;
    LAS float* XS = (LAS float*)F.lds;
    LAS float* LG = (LAS float*)(F.lds + 2 * 128 * XP * 4);
    LAS float* RSL = LG + 2 * 128 * 33;
    LAS int* HL = (LAS int*)(RSL + 128);
    const bf16* X1 = F.p<bf16>(O_X1); const float* RWG = F.p<float>(O_RWG);
    float* RS1 = F.p<float>(O_RS1); int* TOPE = F.p<int>(O_TOPE); float* TOPG = F.p<float>(O_TOPG); int* HIST = F.p<int>(O_HIST);
    const int lane = lane_id(), w = F.wave, tid = w * 64 + lane;
    for (int tg = F.bid; tg < T / 128; tg += F.G) {
        const int t0 = tg * 128;
        if (tid < 32) HL[tid] = 0;
        float ssr[2] = {0.f, 0.f};
        {
            const int g = w & 3, kh = w >> 2, m = lane & 31, hh = lane >> 5;
            const bf16* gsrc = X1 + (size_t)(t0 + (tid >> 3)) * D + 8 * (tid & 7);
            const int lofs = (tid >> 3) * XP + 8 * (tid & 7);
            u32x4 ra[2], rb[2], rc[2];
#define P7_LOAD(r, c) do { _Pragma("unroll") for (int j = 0; j < 2; ++j) r[j] = *(const u32x4*)(gsrc + (size_t)(64 * j) * D + 64 * (c)); } while (0)
#define P7_PARK(r, buf) do { _Pragma("unroll") for (int j = 0; j < 2; ++j) { float lv_[8]; unpack8(r[j], lv_); LAS float* d_ = XS + (buf) * 128 * XP + lofs + 64 * j * XP; \
                ssr[j] += ((lv_[0] * lv_[0] + lv_[1] * lv_[1]) + (lv_[2] * lv_[2] + lv_[3] * lv_[3])) + ((lv_[4] * lv_[4] + lv_[5] * lv_[5]) + (lv_[6] * lv_[6] + lv_[7] * lv_[7])); \
                *(LAS f32x4*)d_ = (f32x4){lv_[0], lv_[1], lv_[2], lv_[3]}; *(LAS f32x4*)(d_ + 4) = (f32x4){lv_[4], lv_[5], lv_[6], lv_[7]}; } } while (0)
            P7_LOAD(ra, 0); P7_LOAD(rb, 1); P7_LOAD(rc, 2);
            P7_PARK(ra, 0);
            __syncthreads();
            f32x16 acc;
#pragma unroll
            for (int i = 0; i < 16; ++i) acc[i] = 0.f;
            const LAS float* arow = XS + (32 * g + m) * XP + 32 * kh + 4 * hh;
            const float* brow = RWG + (size_t)(32 * kh + 4 * hh) * 32 + m;
            float bqn[16];
#pragma unroll
            for (int q = 0; q < 16; ++q) bqn[q] = brow[(8 * (q >> 2) + (q & 3)) * 32];
#pragma unroll 1
            for (int c = 0; c < 32; c += 3) {
#define P7_STEP(cc, rcur_next, rload) do { if ((cc) < 32) { \
                    const LAS float* ar = arow + ((cc) & 1) * 128 * XP; const float* br = brow + (size_t)(64 * ((cc) + 1 < 32 ? (cc) + 1 : (cc))) * 32; \
                    float bq[16]; _Pragma("unroll") for (int q = 0; q < 16; ++q) bq[q] = bqn[q]; \
                    _Pragma("unroll") for (int q = 0; q < 16; ++q) bqn[q] = br[(8 * (q >> 2) + (q & 3)) * 32];     \
                    if ((cc) + 3 < 32) P7_LOAD(rload, (cc) + 3); \
                    if ((cc) + 1 < 32) P7_PARK(rcur_next, ((cc) + 1) & 1); \
                    _Pragma("unroll") for (int jj = 0; jj < 4; ++jj) { const f32x4 a = *(const LAS f32x4*)(ar + 8 * jj); \
                        acc = __builtin_amdgcn_mfma_f32_32x32x2f32(a.x, bq[4 * jj + 0], acc, 0, 0, 0); acc = __builtin_amdgcn_mfma_f32_32x32x2f32(a.y, bq[4 * jj + 1], acc, 0, 0, 0); \
                        acc = __builtin_amdgcn_mfma_f32_32x32x2f32(a.z, bq[4 * jj + 2], acc, 0, 0, 0); acc = __builtin_amdgcn_mfma_f32_32x32x2f32(a.w, bq[4 * jj + 3], acc, 0, 0, 0); } \
                    __syncthreads(); } } while (0)
                P7_STEP(c, rb, ra); P7_STEP(c + 1, rc, rb); P7_STEP(c + 2, ra, rc);
            }
#undef P7_STEP
#undef P7_LOAD
#undef P7_PARK
#pragma unroll
            for (int i = 0; i < 16; ++i) { const int tok = 32 * g + (i & 3) + 8 * (i >> 2) + 4 * hh; LG[(kh * 128 + tok) * 33 + m] = acc[i]; }
#pragma unroll
            for (int j = 0; j < 2; ++j) { float a = ssr[j]; a += __shfl_xor(a, 1); a += __shfl_xor(a, 2); a += __shfl_xor(a, 4);
                if ((tid & 7) == 0) { const float rs = rsqrtf(a * (1.f / D) + EPS); RSL[64 * j + (tid >> 3)] = rs; RS1[t0 + 64 * j + (tid >> 3)] = rs; } }
        }
        __syncthreads();
        if (tid < 128) {
            const int tt = tid; const float rs = RSL[tt];
            LAS float* l0 = LG + tt * 33; const LAS float* l1 = LG + (128 + tt) * 33;
            for (int e = 0; e < 32; ++e) l0[e] = rs * (l0[e] + l1[e]) + F.in[I_ROUTER_B][e];
            float tv[4]; int te[4];
#pragma unroll
            for (int k = 0; k < 4; ++k) { float bv = -3.0e38f; int be = 0;
                for (int e = 0; e < 32; ++e) { const float v = l0[e]; if (v > bv) { bv = v; be = e; } }
                tv[k] = bv; te[k] = be; l0[be] = -3.3e38f; }
            float ex[4], sum = 0.f;
#pragma unroll
            for (int k = 0; k < 4; ++k) { ex[k] = __expf(tv[k] - tv[0]); sum += ex[k]; }
            const float inv = 1.f / sum;
#pragma unroll
            for (int k = 0; k < 4; ++k) { TOPE[(size_t)(t0 + tt) * 4 + k] = te[k]; TOPG[(size_t)(t0 + tt) * 4 + k] = ex[k] * inv; __hip_atomic_fetch_add(&HL[te[k]], 1, __ATOMIC_RELAXED, __HIP_MEMORY_SCOPE_WORKGROUP); }
        }
        __syncthreads();
        if (tid < 32) HIST[tg * 32 + tid] = HL[tid];
        __syncthreads();
    }
}

DI void p8_rows(const Frame& F) {
    LAS int* PT = (LAS int*)F.lds;
    LAS int* PB = PT + 512;
    LAS int* TOT = PB + 512;
    LAS int* BASE = TOT + 32;
    LAS int* PST = BASE + 32;
    LAS int* WCNT = PST + 40;
    const int* HIST = F.p<int>(O_HIST); const int* TOPE = F.p<int>(O_TOPE); const float* TOPG = F.p<float>(O_TOPG); const float* RS1 = F.p<float>(O_RS1);
    int* ROWTOK = F.p<int>(O_ROWTOK); float* ROWG = F.p<float>(O_ROWG); float* ROWRS = F.p<float>(O_ROWRS); int* SLOT = F.p<int>(O_SLOT); int* BLKE = F.p<int>(O_BLKE);
    const int lane = lane_id(), w = F.wave, tid = w * 64 + lane;
    for (int tg = F.bid; tg < T / 128; tg += F.G) {
        const int t0 = tg * 128;
        { const int e = tid & 31, part = tid >> 5; int pt = 0, pb = 0;
          for (int ww = part * 16; ww < part * 16 + 16; ++ww) { const int h = HIST[ww * 32 + e]; pt += h; if (ww < tg) pb += h; }
          PT[part * 32 + e] = pt; PB[part * 32 + e] = pb; }
        __syncthreads();
        if (tid < 32) { int a = 0, b = 0; for (int q = 0; q < 16; ++q) { a += PT[q * 32 + tid]; b += PB[q * 32 + tid]; } TOT[tid] = a; BASE[tid] = b; }
        __syncthreads();
        if (tid == 0) { int s = 0; for (int e = 0; e < 32; ++e) { PST[e] = s; s += (TOT[e] + 255) & ~255; } PST[32] = s; }
        __syncthreads();
        const int i = tid, t = t0 + (i >> 2), k = i & 3;
        const int ei = TOPE[(size_t)t * 4 + k];
        int lrank = 0, mycnt = 0;
        for (int e = 0; e < 32; ++e) { const unsigned long long mk = __ballot(ei == e); if (ei == e) lrank = __popcll(mk & ((1ull << lane) - 1ull)); if (lane == e) mycnt = __popcll(mk); }
        if (lane < 32) WCNT[w * 32 + lane] = mycnt;
        __syncthreads();
        int woff = 0; for (int ww = 0; ww < w; ++ww) woff += WCNT[ww * 32 + ei];
        const int row = PST[ei] + BASE[ei] + woff + lrank;
        ROWTOK[row] = t; ROWG[row] = TOPG[(size_t)t * 4 + k]; ROWRS[row] = RS1[t]; SLOT[(size_t)t * 4 + k] = row;
        if (tg < 32) { const int e = tg, padded = (TOT[e] + 255) & ~255; for (int r = TOT[e] + tid; r < padded; r += 512) { ROWTOK[PST[e] + r] = 0; ROWG[PST[e] + r] = 0.f; ROWRS[PST[e] + r] = 0.f; } }
        if (tg == 0) { for (int j = tid; j < NBMAX; j += 512) { int e = 31; for (int q = 0; q < 32; ++q) if (j * 256 >= PST[q] && j * 256 < PST[q + 1]) e = q; BLKE[j] = e; }
            if (tid == 0) BLKE[NBMAX] = PST[32] >> 8; }
        __syncthreads();
    }
}

DI void p11_token(const bf16* X1, const unsigned char* YB, bf16* X2, unsigned char* X28, float* RS2, int t, int r0, int r1, int r2, int r3, int lane) {
    const u32x2* xr = (const u32x2*)(X1 + (size_t)t * D) + lane;
    const unsigned* y0 = (const unsigned*)(YB + (size_t)r0 * D) + lane; const unsigned* y1 = (const unsigned*)(YB + (size_t)r1 * D) + lane;
    const unsigned* y2 = (const unsigned*)(YB + (size_t)r2 * D) + lane; const unsigned* y3 = (const unsigned*)(YB + (size_t)r3 * D) + lane;
    u32x2* xo = (u32x2*)(X2 + (size_t)t * D) + lane; unsigned* bo = (unsigned*)(X28 + (size_t)t * D) + lane;
    u32x2 xv[8]; unsigned ya[8], yb[8], yc[8], yd[8];
#pragma unroll
    for (int j = 0; j < 8; ++j) { xv[j] = xr[64 * j]; ya[j] = y0[64 * j]; yb[j] = y1[64 * j]; yc[j] = y2[64 * j]; yd[j] = y3[64 * j]; }
    float ss = 0.f;
#pragma unroll
    for (int j = 0; j < 8; ++j) {
        f32x4 v; v.x = bf2f(xv[j].x & 0xffffu); v.y = bf2f(xv[j].x >> 16); v.z = bf2f(xv[j].y & 0xffffu); v.w = bf2f(xv[j].y >> 16);
        const unsigned a = ya[j], b = yb[j], c = yc[j], d = yd[j];
        typedef float f2 __attribute__((ext_vector_type(2)));
        const f2 a0 = __builtin_amdgcn_cvt_pk_f32_fp8(a, false), a1 = __builtin_amdgcn_cvt_pk_f32_fp8(a, true), b0 = __builtin_amdgcn_cvt_pk_f32_fp8(b, false), b1 = __builtin_amdgcn_cvt_pk_f32_fp8(b, true);
        const f2 c0 = __builtin_amdgcn_cvt_pk_f32_fp8(c, false), c1 = __builtin_amdgcn_cvt_pk_f32_fp8(c, true), d0 = __builtin_amdgcn_cvt_pk_f32_fp8(d, false), d1 = __builtin_amdgcn_cvt_pk_f32_fp8(d, true);
        f32x4 sm;
        sm.x = ((a0.x + b0.x) + c0.x) + d0.x; sm.y = ((a0.y + b0.y) + c0.y) + d0.y; sm.z = ((a1.x + b1.x) + c1.x) + d1.x; sm.w = ((a1.y + b1.y) + c1.y) + d1.y;
        v = v + sm * (1.f / SC_Y);
        ss += (v.x * v.x + v.y * v.y) + (v.z * v.z + v.w * v.w);
        { u32x2 xw; xw.x = pk2(v.x, v.y); xw.y = pk2(v.z, v.w); xo[64 * j] = xw; } bo[64 * j] = pk4_i8(v.x, v.y, v.z, v.w, SQ_X);
    }
    ss = wave_sum(ss);
    if (lane == 0) RS2[t] = rsqrtf(ss * (1.f / D) + EPS);
}
DI void p11_combine(const Frame& F) {
    const bf16* X1 = F.p<bf16>(O_X1); const unsigned char* YB = F.p<unsigned char>(O_YBUF); const int* SLOT = F.p<int>(O_SLOT);
    bf16* X2 = F.p<bf16>(O_X2); unsigned char* X28 = F.p<unsigned char>(O_X2B); float* RS2 = F.p<float>(O_RS2);
    const int lane = lane_id(), gw = F.bid * 8 + F.wave, NGW = F.G * 8;
    for (int tb = gw; tb < T; tb += 16 * NGW) {
        const int tl = tb + (lane >> 2) * NGW;
        const int myslot = tl < T ? SLOT[(size_t)tl * 4 + (lane & 3)] : 0;
#pragma unroll 2
        for (int q = 0; q < 16; ++q) {
            const int t = tb + q * NGW;
            const int r0 = __shfl(myslot, 4 * q), r1 = __shfl(myslot, 4 * q + 1), r2 = __shfl(myslot, 4 * q + 2), r3 = __shfl(myslot, 4 * q + 3);
            if (t < T) p11_token(X1, YB, X2, X28, RS2, t, r0, r1, r2, r3, lane);
        }
    }
}

DI void p13_final(const Frame& F) {
    const float* g = F.in[I_NORM_FINAL]; const bf16* X3 = F.p<bf16>(O_X3);
    const int lane = lane_id(), gw = F.bid * 8 + F.wave, NGW = F.G * 8;
    f32x4 gg[8];
#pragma unroll
    for (int j = 0; j < 8; ++j) gg[j] = ((const f32x4*)g + lane)[64 * j];
    u32x2 xa[8], xn[8];
    if (gw < T) {
#pragma unroll
        for (int j = 0; j < 8; ++j) xa[j] = ((const u32x2*)(X3 + (size_t)gw * D) + lane)[64 * j];
    }
#pragma unroll 1
    for (int t = gw; t < T; t += NGW) {
        const int tn = t + NGW < T ? t + NGW : t;
#pragma unroll
        for (int j = 0; j < 8; ++j) xn[j] = ((const u32x2*)(X3 + (size_t)tn * D) + lane)[64 * j];
        f32x4* o = (f32x4*)(F.out + (size_t)t * D) + lane;
        float a = 0.f;
#pragma unroll
        for (int j = 0; j < 8; ++j) { const float v0 = bf2f(xa[j].x & 0xffffu), v1 = bf2f(xa[j].x >> 16), v2 = bf2f(xa[j].y & 0xffffu), v3 = bf2f(xa[j].y >> 16); a += (v0 * v0 + v1 * v1) + (v2 * v2 + v3 * v3); }
        a = wave_sum(a);
        const float rstd = rsqrtf(a * (1.f / D) + EPS);
#pragma unroll
        for (int j = 0; j < 8; ++j) { const u32x2 xw = xa[j]; f32x4 v;
            v.x = bf2f(xw.x & 0xffffu) * rstd * gg[j].x; v.y = bf2f(xw.x >> 16) * rstd * gg[j].y; v.z = bf2f(xw.y & 0xffffu) * rstd * gg[j].z; v.w = bf2f(xw.y >> 16) * rstd * gg[j].w; o[64 * j] = v; }
#pragma unroll
        for (int j = 0; j < 8; ++j) xa[j] = xn[j];
    }
}

DI bf16x8 fragL(const LAS bf16* base, int pitch, int row, int k) { return *(const LAS bf16x8*)(base + row * pitch + k); }
DI bf16x8 fragG(const bf16* base, int pitch, int row, int k) { return *(const bf16x8*)(base + (size_t)row * pitch + k); }
DI bf16x8 frag8cvt(const u32x2 w) {
    typedef float f2 __attribute__((ext_vector_type(2)));
    const f2 a = __builtin_amdgcn_cvt_pk_f32_fp8(w.x, false), b = __builtin_amdgcn_cvt_pk_f32_fp8(w.x, true), c = __builtin_amdgcn_cvt_pk_f32_fp8(w.y, false), d = __builtin_amdgcn_cvt_pk_f32_fp8(w.y, true);
    u32x4 o; o.x = pk2c(a.x, a.y); o.y = pk2c(b.x, b.y); o.z = pk2c(c.x, c.y); o.w = pk2c(d.x, d.y);
    return __builtin_bit_cast(bf16x8, o);
}
DI bf16x8 fragG8(const unsigned char* base, int pitch, int row, int k) {
    typedef float f2 __attribute__((ext_vector_type(2)));
    const u32x2 w = *(const u32x2*)(base + (size_t)row * pitch + k);
    const f2 a = __builtin_amdgcn_cvt_pk_f32_fp8(w.x, false), b = __builtin_amdgcn_cvt_pk_f32_fp8(w.x, true), c = __builtin_amdgcn_cvt_pk_f32_fp8(w.y, false), d = __builtin_amdgcn_cvt_pk_f32_fp8(w.y, true);
    u32x4 o; o.x = pk2c(a.x, a.y); o.y = pk2c(b.x, b.y); o.z = pk2c(c.x, c.y); o.w = pk2c(d.x, d.y);
    return __builtin_bit_cast(bf16x8, o);
}
DI int prow(int i, int nf) { return 8 * (i >> 2) + 4 * nf + (i & 3); }
#define MFMA16(b, a, c) __builtin_amdgcn_mfma_f32_16x16x32_bf16((b), (a), (c), 0, 0, 0)
DI float incl_scan_add(float v, int lane) {
#pragma unroll
    for (int o = 1; o < 64; o <<= 1) { const float t = __shfl_up(v, o); if (lane >= o) v += t; }
    return v;
}
DI float incl_scan_max(float v, int lane) {
#pragma unroll
    for (int o = 1; o < 64; o <<= 1) { const float t = __shfl_up(v, o); if (lane >= o) v = fmaxf(v, t); }
    return v;
}
DI void store16bf(LAS bf16* p, const float (&v)[16]) {
    u32x4 a, b; a.x = pk2c(v[0], v[1]); a.y = pk2c(v[2], v[3]); a.z = pk2c(v[4], v[5]); a.w = pk2c(v[6], v[7]);
    b.x = pk2c(v[8], v[9]); b.y = pk2c(v[10], v[11]); b.z = pk2c(v[12], v[13]); b.w = pk2c(v[14], v[15]);
    *(LAS u32x4*)p = a; *(LAS u32x4*)(p + 8) = b;
}
constexpr int PK = 72, PD = 136;

struct WTile { const float* W; size_t ldw; int k0, sc0; const float* ks; float wsc; unsigned char* dst; size_t drow0; int ldd; int q8; };
constexpr int NWT_GU = NE * 2048, NWT_DN = NE * 1024, NWT = NWT_GU + NWT_DN;
DI WTile wtile_decode(const Frame& F, int r) {
    WTile t;
    if (r < NWT_GU) { const int e = r / 2048, rr = r % 2048, kb = rr / 64, nb = rr % 64, c0 = 64 * nb, j0 = c0 & 2047, part = c0 >> 11;
        t.W = F.in[I_W_GU] + (size_t)e * D * 4096; t.ldw = 4096; t.k0 = 64 * kb; t.sc0 = c0; t.ks = F.in[I_NORM_MOE]; t.wsc = SQ_W; t.q8 = 1; t.dst = F.p<unsigned char>(O_WGU); t.drow0 = (size_t)e * 4096 + (j0 >> 7) * 256 + part * 128 + (j0 & 127); t.ldd = D; }
    else { r -= NWT_GU; const int e = r / 1024, rr = r % 1024, kb = rr / 32, nb = rr % 32;
        t.W = F.in[I_W_DN] + (size_t)e * DFF * D; t.ldw = D; t.k0 = 64 * kb; t.sc0 = 64 * nb; t.ks = nullptr; t.wsc = SC_WDN; t.q8 = 0; t.dst = F.p<unsigned char>(O_WDN); t.drow0 = (size_t)e * D + 64 * nb; t.ldd = DFF; }
    return t;
}
DI void wtile_load(const WTile& t, int lane, f32x4 (&v)[16], f32x4 (&g)[4]) {
    const int a = lane & 15, b = lane >> 4;
#pragma unroll
    for (int i = 0; i < 4; ++i) g[i] = t.ks ? *(const f32x4*)(t.ks + t.k0 + 16 * i + 4 * b) : (f32x4){1.f, 1.f, 1.f, 1.f};
#pragma unroll
    for (int i = 0; i < 4; ++i)
#pragma unroll
        for (int r = 0; r < 4; ++r) v[4 * i + r] = *(const f32x4*)(t.W + (size_t)(t.k0 + 16 * i + 4 * b + r) * t.ldw + t.sc0 + 4 * a);
}
DI void wtile_finish(const WTile& t, int lane, const f32x4 (&v)[16], const f32x4 (&g)[4], LAS unsigned* scr) {
    const int a = lane & 15, b = lane >> 4;
#pragma unroll
    for (int i = 0; i < 4; ++i) {
        const float s0 = t.wsc * g[i].x, s1 = t.wsc * g[i].y, s2 = t.wsc * g[i].z, s3 = t.wsc * g[i].w;
#pragma unroll
        for (int c = 0; c < 4; ++c) scr[(4 * a + c) * 17 + 4 * i + b] = t.q8 ? pk4_i8(v[4 * i][c] * s0, v[4 * i + 1][c] * s1, v[4 * i + 2][c] * s2, v[4 * i + 3][c] * s3, 1.f) : pk4_fp8(v[4 * i][c] * s0, v[4 * i + 1][c] * s1, v[4 * i + 2][c] * s2, v[4 * i + 3][c] * s3);
    }
    asm volatile("s_waitcnt lgkmcnt(0)" ::: "memory");
#pragma unroll
    for (int j = 0; j < 4; ++j) {
        const int n = (lane >> 2) + 16 * j, kc = lane & 3;
        u32x4 o; o.x = scr[n * 17 + 4 * kc]; o.y = scr[n * 17 + 4 * kc + 1]; o.z = scr[n * 17 + 4 * kc + 2]; o.w = scr[n * 17 + 4 * kc + 3];
        *(u32x4*)(t.dst + (t.drow0 + n) * (size_t)t.ldd + t.k0 + 16 * kc) = o;
    }
    asm volatile("s_waitcnt lgkmcnt(0)" ::: "memory");
}
constexpr int PL = 132;
constexpr int PV = 264;
constexpr int MISC_F = LDS_MISC + 256;
DI void hgrn_a_item(const Frame& F, int it, int lane, int w, int tid, const bool hasw, const WTile& wt, f32x4 (&wv)[16], f32x4 (&wg)[4]) {
    const int h = it & 7; const size_t t0 = (size_t)(it >> 3) * 64;
    LAS bf16* TK = (LAS bf16*)F.lds; LAS bf16* TV = TK + 64 * PD; LAS float* TL = (LAS float*)(TV + 64 * PD); LAS bf16* KT = (LAS bf16*)(TL + 64 * PL); LAS bf16* VT = KT + 128 * PK;
    LAS float* SEGT = (LAS float*)(F.lds + MISC_F);
    const bf16* Z = F.p<bf16>(O_Z); const bf16* LF = F.p<bf16>(O_LF);
    {
        u32x4 rk[2], rv[2]; u32x4 rl[2];
#pragma unroll
        for (int j = 0; j < 2; ++j) { const int i = tid + 512 * j, row = i >> 4, c8 = i & 15; const bf16* g = Z + (t0 + row) * NZ + h * 128 + c8 * 8; rk[j] = *(const u32x4*)(g + ZKA); rv[j] = *(const u32x4*)(g + ZVA); }
#pragma unroll
        for (int j = 0; j < 2; ++j) { const int i = tid + 512 * j, row = i >> 4, c8 = i & 15; rl[j] = *(const u32x4*)(LF + (t0 + row) * 1024 + h * 128 + c8 * 8); }
        if (hasw) wtile_load(wt, lane, wv, wg);
#pragma unroll
        for (int j = 0; j < 2; ++j) { const int i = tid + 512 * j, row = i >> 4, c8 = i & 15; *(LAS u32x4*)(TK + row * PD + c8 * 8) = rk[j]; *(LAS u32x4*)(TV + row * PD + c8 * 8) = rv[j]; }
#pragma unroll
        for (int j = 0; j < 2; ++j) { const int i = tid + 512 * j, row = i >> 4, c8 = i & 15; float lv[8]; unpack8(rl[j], lv); *(LAS f32x4*)(TL + row * PL + c8 * 8) = (f32x4){lv[0], lv[1], lv[2], lv[3]}; *(LAS f32x4*)(TL + row * PL + c8 * 8 + 4) = (f32x4){lv[4], lv[5], lv[6], lv[7]}; }
    }
    __syncthreads();
    const int c = tid & 127, seg = tid >> 7;
    float cs[16]; float run = 0.f;
#pragma unroll
    for (int i = 0; i < 16; ++i) { run += TL[(16 * seg + i) * PL + c]; cs[i] = run; }
    SEGT[seg * 128 + c] = run;
    float kk[16], vv[16];
#pragma unroll
    for (int i = 0; i < 16; ++i) { kk[i] = bf2f(TK[(16 * seg + i) * PD + c]); vv[i] = bf2f(TV[(16 * seg + i) * PD + c]); }
    __syncthreads();
    float pre = 0.f, tot = 0.f;
#pragma unroll
    for (int q = 0; q < 4; ++q) { const float v = SEGT[q * 128 + c]; tot += v; if (q < seg) pre += v; }
#pragma unroll
    for (int i = 0; i < 16; ++i) kk[i] *= __expf(tot - (pre + cs[i]));
    store16bf(KT + c * PK + 16 * seg, kk); store16bf(VT + c * PK + 16 * seg, vv);
    if (seg == 0) F.p<float>(O_DEC)[(size_t)it * 128 + c] = __expf(tot);
    __syncthreads();
    const int fr = lane & 15, fq = lane >> 4, e0 = 16 * w;
    f32x4 acc[8];
#pragma unroll
    for (int i = 0; i < 8; ++i) acc[i] = (f32x4){0.f, 0.f, 0.f, 0.f};
#pragma unroll
    for (int ks = 0; ks < 2; ++ks) {
        const bf16x8 a = fragL(VT, PK, e0 + fr, 32 * ks + 8 * fq);
#pragma unroll
        for (int p = 0; p < 4; ++p)
#pragma unroll
            for (int nf = 0; nf < 2; ++nf) { const bf16x8 b = fragL(KT, PK, 32 * p + prow(fr, nf), 32 * ks + 8 * fq); acc[2 * p + nf] = MFMA16(b, a, acc[2 * p + nf]); }
    }
    unsigned char* U = F.p<unsigned char>(O_UST) + ((size_t)it * 128 + e0 + fr) * 128 + 8 * fq;
#pragma unroll
    for (int p = 0; p < 4; ++p) { u32x2 q8;
        q8.x = pk4_fp8(clamp8(acc[2 * p][0] * SC_U), clamp8(acc[2 * p][1] * SC_U), clamp8(acc[2 * p][2] * SC_U), clamp8(acc[2 * p][3] * SC_U));
        q8.y = pk4_fp8(clamp8(acc[2 * p + 1][0] * SC_U), clamp8(acc[2 * p + 1][1] * SC_U), clamp8(acc[2 * p + 1][2] * SC_U), clamp8(acc[2 * p + 1][3] * SC_U));
        *(u32x2*)(U + 32 * p) = q8; }
    __syncthreads();
}

DI void raw67_load(const bf16* Z, size_t t0, int n, int col0, int tid, u32x4 (&r)[3]) {
#pragma unroll
    for (int j = 0; j < 3; ++j) { const int i = tid + 512 * j, row = i >> 4, c8 = i & 15; r[j] = (u32x4){0u, 0u, 0u, 0u};
        if (i < 67 * 16 && (n > 0 || row >= 3)) r[j] = *(const u32x4*)(Z + (t0 + row - 3) * NZ + col0 + c8 * 8); }
}
DI void raw67_store(LAS bf16* dst, int tid, const u32x4 (&r)[3]) {
#pragma unroll
    for (int j = 0; j < 3; ++j) { const int i = tid + 512 * j, row = i >> 4, c8 = i & 15; if (i < 67 * 16) *(LAS u32x4*)(dst + row * PD + c8 * 8) = r[j]; }
}
struct ConvW { float w0, w1, w2, w3, b; };
DI ConvW convw_load(const float* cw, const float* cb, int ch) { ConvW c; c.w0 = cw[ch]; c.w1 = cw[1024 + ch]; c.w2 = cw[2048 + ch]; c.w3 = cw[3072 + ch]; c.b = cb[ch]; return c; }
DI void conv16L(const LAS bf16* raw, int l0, int d, const ConvW& cwv, float (&o)[16]) {
    const float w0 = cwv.w0, w1 = cwv.w1, w2 = cwv.w2, w3 = cwv.w3, b = cwv.b;
    float u0 = bf2f(raw[(l0) * PD + d]), u1 = bf2f(raw[(l0 + 1) * PD + d]), u2 = bf2f(raw[(l0 + 2) * PD + d]);
#pragma unroll
    for (int i = 0; i < 16; ++i) { const float u3 = bf2f(raw[(l0 + 3 + i) * PD + d]); const float cv = b + u0 * w0 + u1 * w1 + u2 * w2 + u3 * w3; o[i] = cv * sigm(cv); u0 = u1; u1 = u2; u2 = u3; }
}
DI void conv16(const bf16* Z, size_t t0, int s0  , int ch, const float* cw, const float* cb, float (&o)[16]) {
    const float w0 = cw[ch], w1 = cw[1024 + ch], w2 = cw[2048 + ch], w3 = cw[3072 + ch], b = cb[ch];
    float u0 = s0 >= 3 ? bf2f(Z[(t0 - 3) * NZ + ZQK + ch]) : 0.f, u1 = s0 >= 2 ? bf2f(Z[(t0 - 2) * NZ + ZQK + ch]) : 0.f, u2 = s0 >= 1 ? bf2f(Z[(t0 - 1) * NZ + ZQK + ch]) : 0.f;
#pragma unroll
    for (int i = 0; i < 16; ++i) { const float u3 = bf2f(Z[(t0 + i) * NZ + ZQK + ch]); const float cv = b + u0 * w0 + u1 * w1 + u2 * w2 + u3 * w3; o[i] = cv * sigm(cv); u0 = u1; u1 = u2; u2 = u3; }
}

DI void mlstm_a_item(const Frame& F, int it, int lane, int w, int tid, const bool hasw, const WTile& wt, f32x4 (&wv)[16], f32x4 (&wg)[4]) {
    const int h = it & 3, bn = it >> 2, n = bn & 127; const size_t t0 = (size_t)bn * 64;
    LAS bf16* TR = (LAS bf16*)F.lds; LAS bf16* TV = TR + 68 * PD; LAS bf16* KT = TV + 64 * PV; LAS bf16* VT = KT + 128 * PK;
    LAS float* NP = (LAS float*)(F.lds + MISC_F); LAS float* WE = NP + 512;
    const bf16* Z = F.p<bf16>(O_Z); const float* GT = F.p<float>(O_GATES);
    ConvW cwk;
    {
        u32x4 rv[4], rr[3];
#pragma unroll
        for (int j = 0; j < 4; ++j) { const int i = tid + 512 * j, row = i >> 5, c8 = i & 31; rv[j] = *(const u32x4*)(Z + (t0 + row) * NZ + ZVB + h * 256 + c8 * 8); }
        raw67_load(Z, t0, n, ZQK + 512 + h * 128, tid, rr);
        const float ip = GT[(t0 + lane) * 8 + h], fpre = GT[(t0 + lane) * 8 + 4 + h];
        cwk = convw_load(F.in[I_CONV_W], F.in[I_CONV_B], 512 + h * 128 + (tid & 127));
        if (hasw) wtile_load(wt, lane, wv, wg);
        {
            const float lf = log_sigmoid(fpre);
            const float fc = incl_scan_add(lf, lane), gt = __shfl(fc, 63);
            const float ae = gt - fc + ip, ml = wave_max(ae);
            if (w == 0) { WE[lane] = __expf(ae - ml); if (lane == 0) { F.p<float>(O_MLOC)[it] = ml; F.p<float>(O_GTOT)[it] = gt; } }
        }
        raw67_store(TR, tid, rr);
#pragma unroll
        for (int j = 0; j < 4; ++j) { const int i = tid + 512 * j, row = i >> 5, c8 = i & 31; *(LAS u32x4*)(TV + row * PV + c8 * 8) = rv[j]; }
    }
    __syncthreads();
    const int d = tid & 127, seg = tid >> 7;
    float kk[16];
    conv16L(TR, 16 * seg, d, cwk, kk);
    float np = 0.f;
#pragma unroll
    for (int i = 0; i < 16; ++i) { kk[i] *= 0.08838834764831845f * WE[16 * seg + i]; np += kk[i]; }
    NP[seg * 128 + d] = np;
    store16bf(KT + d * PK + 16 * seg, kk);
    {
        const int ev = tid & 255, hv = tid >> 8; float v0[16], v1[16];
#pragma unroll
        for (int i = 0; i < 16; ++i) { v0[i] = bf2f(TV[(32 * hv + i) * PV + ev]); v1[i] = bf2f(TV[(32 * hv + 16 + i) * PV + ev]); }
        store16bf(VT + ev * PK + 32 * hv, v0); store16bf(VT + ev * PK + 32 * hv + 16, v1);
    }
    __syncthreads();
    if (tid < 128) F.p<float>(O_NL)[(size_t)it * 128 + tid] = (NP[tid] + NP[128 + tid]) + (NP[256 + tid] + NP[384 + tid]);
    const int fr = lane & 15, fq = lane >> 4;
    f32x4 acc[2][8];
#pragma unroll
    for (int m = 0; m < 2; ++m)
#pragma unroll
        for (int i = 0; i < 8; ++i) acc[m][i] = (f32x4){0.f, 0.f, 0.f, 0.f};
#pragma unroll
    for (int ks = 0; ks < 2; ++ks) {
        const bf16x8 a0 = fragL(VT, PK, 32 * w + fr, 32 * ks + 8 * fq), a1 = fragL(VT, PK, 32 * w + 16 + fr, 32 * ks + 8 * fq);
#pragma unroll
        for (int p = 0; p < 4; ++p)
#pragma unroll
            for (int nf = 0; nf < 2; ++nf) { const bf16x8 b = fragL(KT, PK, 32 * p + prow(fr, nf), 32 * ks + 8 * fq); acc[0][2 * p + nf] = MFMA16(b, a0, acc[0][2 * p + nf]); acc[1][2 * p + nf] = MFMA16(b, a1, acc[1][2 * p + nf]); }
    }
#pragma unroll
    for (int m = 0; m < 2; ++m) {
        unsigned char* Cp = F.p<unsigned char>(O_CT) + ((size_t)it * 256 + 32 * w + 16 * m + fr) * 128 + 8 * fq;
#pragma unroll
        for (int p = 0; p < 4; ++p) { u32x2 q8;
            q8.x = pk4_fp8(clamp8(acc[m][2 * p][0] * SC_C), clamp8(acc[m][2 * p][1] * SC_C), clamp8(acc[m][2 * p][2] * SC_C), clamp8(acc[m][2 * p][3] * SC_C));
            q8.y = pk4_fp8(clamp8(acc[m][2 * p + 1][0] * SC_C), clamp8(acc[m][2 * p + 1][1] * SC_C), clamp8(acc[m][2 * p + 1][2] * SC_C), clamp8(acc[m][2 * p + 1][3] * SC_C));
            *(u32x2*)(Cp + 32 * p) = q8; }
    }
    __syncthreads();
}

DI void scan_phase(const Frame& F) {
    const int lane = lane_id(), tid = F.wave * 64 + lane;
    typedef float f2 __attribute__((ext_vector_type(2)));
    for (int g = F.bid * 512 + tid; g < 131072; g += F.G * 512) {
        const int c4 = g & 31, eh = (g >> 5) & 127, bhh = g >> 12, bH = bhh >> 3, hH = bhh & 7;
        const int d4 = g & 31, em = (g >> 5) & 255, bhm = g >> 13, bM = bhm >> 2, hM = bhm & 3;
        float S0 = 0.f, S1 = 0.f, S2 = 0.f, S3 = 0.f;
        float C0 = 0.f, C1 = 0.f, C2 = 0.f, C3 = 0.f, mrun = -1e30f; f32x4 nn = (f32x4){0.f, 0.f, 0.f, 0.f};
        unsigned char* U = F.p<unsigned char>(O_UST); const float* DC = F.p<float>(O_DEC);
        unsigned char* CT = F.p<unsigned char>(O_CT); float* NL = F.p<float>(O_NL); const float* GTOT = F.p<float>(O_GTOT); const float* MLOC = F.p<float>(O_MLOC); float* MST = F.p<float>(O_MST);
        unsigned uu[16]; f32x4 dc[16]; unsigned cl[16]; float gt[16], ml[16];
#define SCAN_LH(n0_) do { _Pragma("unroll") for (int j = 0; j < 16; ++j) { const size_t it = (size_t)(bH * 128 + (n0_) + j) * 8 + hH; uu[j] = *(const unsigned*)(U + (it * 128 + eh) * 128 + c4 * 4); dc[j] = *(const f32x4*)(DC + it * 128 + c4 * 4); } } while (0)
#define SCAN_LM(n0_) do { _Pragma("unroll") for (int j = 0; j < 16; ++j) { const size_t it = (size_t)(bM * 128 + (n0_) + j) * 4 + hM; cl[j] = *(const unsigned*)(CT + (it * 256 + em) * 128 + d4 * 4); gt[j] = GTOT[it]; ml[j] = MLOC[it]; } } while (0)
        SCAN_LH(0); SCAN_LM(0);
#pragma unroll 1
        for (int n0 = 0; n0 < 128; n0 += 16) {
            const int nn0 = n0 + 16 < 128 ? n0 + 16 : n0;
#pragma unroll
            for (int j = 0; j < 16; ++j) { const size_t it = (size_t)(bH * 128 + n0 + j) * 8 + hH;
                *(unsigned*)(U + (it * 128 + eh) * 128 + c4 * 4) = pk4_fp8(clamp8(S0), clamp8(S1), clamp8(S2), clamp8(S3));
                const f2 lo = __builtin_amdgcn_cvt_pk_f32_fp8(uu[j], false), hi = __builtin_amdgcn_cvt_pk_f32_fp8(uu[j], true);
                S0 = dc[j].x * S0 + lo.x; S1 = dc[j].y * S1 + lo.y; S2 = dc[j].z * S2 + hi.x; S3 = dc[j].w * S3 + hi.y; }
            SCAN_LH(nn0);
#pragma unroll
            for (int j = 0; j < 16; ++j) { const size_t it = (size_t)(bM * 128 + n0 + j) * 4 + hM;
                const float mnew = fmaxf(gt[j] + mrun, ml[j]), sp = __expf(gt[j] + mrun - mnew), sl = __expf(ml[j] - mnew);
                *(unsigned*)(CT + (it * 256 + em) * 128 + d4 * 4) = pk4_fp8(clamp8(C0), clamp8(C1), clamp8(C2), clamp8(C3));
                const f2 lo = __builtin_amdgcn_cvt_pk_f32_fp8(cl[j], false), hi = __builtin_amdgcn_cvt_pk_f32_fp8(cl[j], true);
                C0 = sp * C0 + sl * lo.x; C1 = sp * C1 + sl * lo.y; C2 = sp * C2 + sl * hi.x; C3 = sp * C3 + sl * hi.y;
                if (em == 0) { f32x4* q = (f32x4*)(NL + it * 128 + d4 * 4); const f32x4 nl = *q; *q = nn; nn = sp * nn + sl * nl; if (d4 == 0) MST[it] = mrun; }
                mrun = mnew; }
            SCAN_LM(nn0);
        }
#undef SCAN_LH
#undef SCAN_LM
    }
}

DI void hgrn_c_item(const Frame& F, int it, int lane, int w, int tid, const bool hasw, const WTile& wt, f32x4 (&wv)[16], f32x4 (&wg)[4]) {
    const int h = it & 7; const size_t t0 = (size_t)(it >> 3) * 64;
    LAS bf16* Qs = (LAS bf16*)F.lds; LAS bf16* Ks = Qs + 64 * PD; LAS bf16* Qh = Ks + 64 * PD; LAS bf16* TV = Qh + 64 * PD; LAS bf16* VT = TV + 64 * PD;
    LAS float* TL = (LAS float*)(VT + 128 * PK); LAS bf16* Pm = (LAS bf16*)TL;
    LAS float* SEGT = (LAS float*)(F.lds + MISC_F); LAS float* BREF = SEGT + 512; LAS float* RED = BREF + 128;
    const bf16* Z = F.p<bf16>(O_Z); const bf16* LF = F.p<bf16>(O_LF);
    u32x2 stf[4][2][2]; u32x4 gaw[2];
    {
        u32x4 rq[2], rk[2], rv[2]; u32x4 rl[2];
#pragma unroll
        for (int j = 0; j < 2; ++j) { const int i = tid + 512 * j, row = i >> 4, c8 = i & 15; const bf16* g = Z + (t0 + row) * NZ + h * 128 + c8 * 8; rq[j] = *(const u32x4*)(g + ZQA); rk[j] = *(const u32x4*)(g + ZKA); rv[j] = *(const u32x4*)(g + ZVA); }
#pragma unroll
        for (int j = 0; j < 2; ++j) { const int i = tid + 512 * j, row = i >> 4, c8 = i & 15; rl[j] = *(const u32x4*)(LF + (t0 + row) * 1024 + h * 128 + c8 * 8); }
        {
            const int fr_ = lane & 15, fq_ = lane >> 4, nh_ = w >> 2, mf_ = w & 3;
            const unsigned char* STp = F.p<unsigned char>(O_UST) + (size_t)it * 128 * 128;
#pragma unroll
            for (int ks = 0; ks < 4; ++ks)
#pragma unroll
                for (int p = 0; p < 2; ++p)
#pragma unroll
                    for (int nf = 0; nf < 2; ++nf) stf[ks][p][nf] = *(const u32x2*)(STp + (size_t)(64 * nh_ + 32 * p + prow(fr_, nf)) * 128 + 32 * ks + 8 * fq_);
#pragma unroll
            for (int p = 0; p < 2; ++p) gaw[p] = *(const u32x4*)(Z + (t0 + 16 * mf_ + fr_) * NZ + ZGA + h * 128 + 64 * nh_ + 32 * p + 8 * fq_);
        }
        if (hasw) wtile_load(wt, lane, wv, wg);
#pragma unroll
        for (int j = 0; j < 2; ++j) { const int i = tid + 512 * j, row = i >> 4, c8 = i & 15; *(LAS u32x4*)(Qs + row * PD + c8 * 8) = rq[j]; *(LAS u32x4*)(Ks + row * PD + c8 * 8) = rk[j]; *(LAS u32x4*)(TV + row * PD + c8 * 8) = rv[j]; }
#pragma unroll
        for (int j = 0; j < 2; ++j) { const int i = tid + 512 * j, row = i >> 4, c8 = i & 15; float lv[8]; unpack8(rl[j], lv); *(LAS f32x4*)(TL + row * PL + c8 * 8) = (f32x4){lv[0], lv[1], lv[2], lv[3]}; *(LAS f32x4*)(TL + row * PL + c8 * 8 + 4) = (f32x4){lv[4], lv[5], lv[6], lv[7]}; }
    }
    __syncthreads();
    const int c = tid & 127, seg = tid >> 7;
    float cs[16]; float run = 0.f;
#pragma unroll
    for (int i = 0; i < 16; ++i) { run += TL[(16 * seg + i) * PL + c]; cs[i] = run; }
    SEGT[seg * 128 + c] = run;
    float qq[16], kk[16], vv[16];
#pragma unroll
    for (int i = 0; i < 16; ++i) { const int o = (16 * seg + i) * PD + c; qq[i] = bf2f(Qs[o]); kk[i] = bf2f(Ks[o]); vv[i] = bf2f(TV[o]); }
    __syncthreads();
    float pre = 0.f, sg[4];
#pragma unroll
    for (int q = 0; q < 4; ++q) { sg[q] = SEGT[q * 128 + c]; if (q < seg) pre += sg[q]; }
    const float bref = ((0.f + sg[0]) + sg[1]) + (0.f + TL[32 * PL + c]);
#pragma unroll
    for (int i = 0; i < 16; ++i) {
        const float bc = pre + cs[i]; const int o = (16 * seg + i) * PD + c;
        Qs[o] = (bf16)f2bf(qq[i] * __expf(bc - bref)); Ks[o] = (bf16)f2bf(kk[i] * __expf(bref - bc)); Qh[o] = (bf16)f2bf(qq[i] * __expf(bc) * (1.f / SC_U));
    }
    store16bf(VT + c * PK + 16 * seg, vv);
    __syncthreads();
    const int fr = lane & 15, fq = lane >> 4, mf = w & 3, nh = w >> 2;
    {
        f32x4 sc[2] = {(f32x4){0.f, 0.f, 0.f, 0.f}, (f32x4){0.f, 0.f, 0.f, 0.f}};
#pragma unroll
        for (int ks = 0; ks < 4; ++ks) { const bf16x8 a = fragL(Qs, PD, 16 * mf + fr, 32 * ks + 8 * fq);
#pragma unroll
            for (int nf = 0; nf < 2; ++nf) { const bf16x8 b = fragL(Ks, PD, 32 * nh + prow(fr, nf), 32 * ks + 8 * fq); sc[nf] = MFMA16(b, a, sc[nf]); } }
        const int l = 16 * mf + fr, m0 = 32 * nh + 8 * fq; float o[8];
#pragma unroll
        for (int j = 0; j < 4; ++j) { o[j] = (m0 + j <= l) ? sc[0][j] : 0.f; o[4 + j] = (m0 + 4 + j <= l) ? sc[1][j] : 0.f; }
        *(LAS u32x4*)(Pm + l * PK + m0) = pack8c(o);
    }
    __syncthreads();
    f32x4 acc[4];
#pragma unroll
    for (int i = 0; i < 4; ++i) acc[i] = (f32x4){0.f, 0.f, 0.f, 0.f};
#pragma unroll
    for (int ks = 0; ks < 2; ++ks) { const bf16x8 a = fragL(Pm, PK, 16 * mf + fr, 32 * ks + 8 * fq);
#pragma unroll
        for (int p = 0; p < 2; ++p)
#pragma unroll
            for (int nf = 0; nf < 2; ++nf) { const bf16x8 b = fragL(VT, PK, 64 * nh + 32 * p + prow(fr, nf), 32 * ks + 8 * fq); acc[2 * p + nf] = MFMA16(b, a, acc[2 * p + nf]); } }
#pragma unroll
    for (int ks = 0; ks < 4; ++ks) { const bf16x8 a = fragL(Qh, PD, 16 * mf + fr, 32 * ks + 8 * fq);
#pragma unroll
        for (int p = 0; p < 2; ++p)
#pragma unroll
            for (int nf = 0; nf < 2; ++nf) { const bf16x8 b = frag8cvt(stf[ks][p][nf]); acc[2 * p + nf] = MFMA16(b, a, acc[2 * p + nf]); } }
    float ss = 0.f;
#pragma unroll
    for (int i = 0; i < 4; ++i) ss += (acc[i][0] * acc[i][0] + acc[i][1] * acc[i][1]) + (acc[i][2] * acc[i][2] + acc[i][3] * acc[i][3]);
    ss += __shfl_xor(ss, 16); ss += __shfl_xor(ss, 32);
    const int l = 16 * mf + fr;
    if (fq == 0) RED[nh * 64 + l] = ss;
    __syncthreads();
    const float rstd = rsqrtf((RED[l] + RED[64 + l]) * (1.f / 128.f) + EPS);
#pragma unroll
    for (int p = 0; p < 2; ++p) {
        const int e = 64 * nh + 32 * p + 8 * fq; float ga[8], o[8];
        unpack8(gaw[p], ga);
#pragma unroll
        for (int j = 0; j < 4; ++j) { o[j] = acc[2 * p][j] * rstd * ga[j]; o[4 + j] = acc[2 * p + 1][j] * rstd * ga[4 + j]; }
        { u32x2 q8; q8.x = pk4_i8(o[0], o[1], o[2], o[3], SQ_YA); q8.y = pk4_i8(o[4], o[5], o[6], o[7], SQ_YA); *(u32x2*)(F.p<unsigned char>(O_YA) + (t0 + l) * 2048 + h * 128 + e) = q8; }
    }
    __syncthreads();
}

DI void mlstm_c_item(const Frame& F, int it, int lane, int w, int tid, const bool hasw, const WTile& wt, f32x4 (&wv)[16], f32x4 (&wg)[4]) {
    const int h = it & 3, bn = it >> 2, n = bn & 127; const size_t t0 = (size_t)bn * 64;
    LAS bf16* Qs = (LAS bf16*)F.lds; LAS bf16* Ks = Qs + 68 * PD; LAS bf16* TV = Ks + 68 * PD; LAS bf16* VT = TV + 64 * PV; LAS bf16* NST = VT + 272 * PK; LAS bf16* Pm = TV;
    LAS float* ROWV = (LAS float*)(F.lds + MISC_F); LAS float* COLV = ROWV + 64; LAS float* WST = COLV + 64; LAS float* EINV = WST + 64; LAS float* RED = EINV + 64;
    const bf16* Z = F.p<bf16>(O_Z); const float* GT = F.p<float>(O_GATES);
    ConvW cwq, cwk; float nlv = 0.f;
    {
        u32x4 rv[4], rq[3], rk[3];
#pragma unroll
        for (int j = 0; j < 4; ++j) { const int i = tid + 512 * j, row = i >> 5, c8 = i & 31; rv[j] = *(const u32x4*)(Z + (t0 + row) * NZ + ZVB + h * 256 + c8 * 8); }
        raw67_load(Z, t0, n, ZQK + h * 128, tid, rq);
        raw67_load(Z, t0, n, ZQK + 512 + h * 128, tid, rk);
        const float ip = GT[(t0 + lane) * 8 + h], fpre = GT[(t0 + lane) * 8 + 4 + h], mst = F.p<float>(O_MST)[it];
        cwq = convw_load(F.in[I_CONV_W], F.in[I_CONV_B], h * 128 + (tid & 127)); cwk = convw_load(F.in[I_CONV_W], F.in[I_CONV_B], 512 + h * 128 + (tid & 127));
        if (tid < 128) nlv = F.p<float>(O_NL)[(size_t)it * 128 + tid];
        if (hasw) wtile_load(wt, lane, wv, wg);
        {
            const float lf = log_sigmoid(fpre);
            const float fc = incl_scan_add(lf, lane);
            const float cv = ip - fc, aint = fc + mst, dmax = fc + incl_scan_max(cv, lane), mt = fmaxf(dmax, aint);
            if (w == 0) { ROWV[lane] = fc - mt; COLV[lane] = cv; WST[lane] = __expf(aint - mt); EINV[lane] = __expf(-mt); }
        }
        raw67_store(Qs, tid, rq); raw67_store(Ks, tid, rk);
#pragma unroll
        for (int j = 0; j < 4; ++j) { const int i = tid + 512 * j, row = i >> 5, c8 = i & 31; *(LAS u32x4*)(TV + row * PV + c8 * 8) = rv[j]; }
    }
    __syncthreads();
    const int d = tid & 127, seg = tid >> 7;
    {
        float qq[16], kk[16];
        conv16L(Qs, 16 * seg, d, cwq, qq);
        conv16L(Ks, 16 * seg, d, cwk, kk);
        const int ev = tid & 255, hv = tid >> 8; float v0[16], v1[16];
#pragma unroll
        for (int i = 0; i < 16; ++i) { v0[i] = bf2f(TV[(32 * hv + i) * PV + ev]); v1[i] = bf2f(TV[(32 * hv + 16 + i) * PV + ev]); }
        __syncthreads();
#pragma unroll
        for (int i = 0; i < 16; ++i) { const int l = 16 * seg + i; Qs[l * PD + d] = (bf16)f2bf(qq[i]); Ks[l * PD + d] = (bf16)f2bf(kk[i] * 0.08838834764831845f); }
        store16bf(VT + ev * PK + 32 * hv, v0); store16bf(VT + ev * PK + 32 * hv + 16, v1);
        for (int i = tid; i < 16 * 64; i += 512) VT[(256 + (i >> 6)) * PK + (i & 63)] = (bf16)((i >> 6) == 0 ? 0x3f80 : 0);
        for (int i = tid; i < 16 * 128; i += 512) NST[(i >> 7) * PD + (i & 127)] = (bf16)((i >> 7) == 0 ? f2bf(nlv) : 0u);
    }
    __syncthreads();
    const int fr = lane & 15, fq = lane >> 4, mf = w & 3, nh = w >> 2, l = 16 * mf + fr;
    {
        f32x4 sc[2] = {(f32x4){0.f, 0.f, 0.f, 0.f}, (f32x4){0.f, 0.f, 0.f, 0.f}};
#pragma unroll
        for (int ks = 0; ks < 4; ++ks) { const bf16x8 a = fragL(Qs, PD, l, 32 * ks + 8 * fq);
#pragma unroll
            for (int nf = 0; nf < 2; ++nf) { const bf16x8 b = fragL(Ks, PD, 32 * nh + prow(fr, nf), 32 * ks + 8 * fq); sc[nf] = MFMA16(b, a, sc[nf]); } }
        const int m0 = 32 * nh + 8 * fq; const float rv = ROWV[l]; float o[8];
#pragma unroll
        for (int j = 0; j < 4; ++j) { o[j] = (m0 + j <= l) ? sc[0][j] * __expf(rv + COLV[m0 + j]) : 0.f; o[4 + j] = (m0 + 4 + j <= l) ? sc[1][j] * __expf(rv + COLV[m0 + 4 + j]) : 0.f; }
        *(LAS u32x4*)(Pm + l * PK + m0) = pack8c(o);
    }
    __syncthreads();
    f32x4 a1[8], a2[8], d1 = (f32x4){0.f, 0.f, 0.f, 0.f}, d2 = (f32x4){0.f, 0.f, 0.f, 0.f};
#pragma unroll
    for (int i = 0; i < 8; ++i) { a1[i] = (f32x4){0.f, 0.f, 0.f, 0.f}; a2[i] = (f32x4){0.f, 0.f, 0.f, 0.f}; }
    const unsigned char* CS = F.p<unsigned char>(O_CT) + (size_t)it * 256 * 128;
    u32x2 csf0[8];
#pragma unroll
    for (int p = 0; p < 4; ++p)
#pragma unroll
        for (int nf = 0; nf < 2; ++nf) csf0[2 * p + nf] = *(const u32x2*)(CS + (size_t)(128 * nh + 32 * p + prow(fr, nf)) * 128 + 8 * fq);
    u32x4 ogw[4];
#pragma unroll
    for (int p = 0; p < 4; ++p) ogw[p] = *(const u32x4*)(Z + (t0 + l) * NZ + ZOB + h * 256 + 128 * nh + 32 * p + 8 * fq);
#pragma unroll
    for (int ks = 0; ks < 2; ++ks) { const bf16x8 a = fragL(Pm, PK, l, 32 * ks + 8 * fq);
#pragma unroll
        for (int p = 0; p < 4; ++p)
#pragma unroll
            for (int nf = 0; nf < 2; ++nf) { const bf16x8 b = fragL(VT, PK, 128 * nh + 32 * p + prow(fr, nf), 32 * ks + 8 * fq); a1[2 * p + nf] = MFMA16(b, a, a1[2 * p + nf]); }
        d1 = MFMA16(fragL(VT, PK, 256 + fr, 32 * ks + 8 * fq), a, d1); }
#pragma unroll
    for (int ks = 0; ks < 4; ++ks) { const bf16x8 a = fragL(Qs, PD, l, 32 * ks + 8 * fq);
#pragma unroll
        for (int p = 0; p < 4; ++p)
#pragma unroll
            for (int nf = 0; nf < 2; ++nf) { const bf16x8 b = ks == 0 ? frag8cvt(csf0[2 * p + nf]) : fragG8(CS, 128, 128 * nh + 32 * p + prow(fr, nf), 32 * ks + 8 * fq); a2[2 * p + nf] = MFMA16(b, a, a2[2 * p + nf]); }
        d2 = MFMA16(fragL(NST, PD, fr, 32 * ks + 8 * fq), a, d2); }
    const float ws = WST[l];
    float den = d1[0] + ws * d2[0];
    den = __shfl(den, fr);
    const float inv = 1.f / fmaxf(fabsf(den), EINV[l]);
    float ss = 0.f;
    const float wsc = ws * (1.f / SC_C);
#pragma unroll
    for (int i = 0; i < 8; ++i) { a1[i] = (a1[i] + wsc * a2[i]) * inv; ss += (a1[i][0] * a1[i][0] + a1[i][1] * a1[i][1]) + (a1[i][2] * a1[i][2] + a1[i][3] * a1[i][3]); }
    ss += __shfl_xor(ss, 16); ss += __shfl_xor(ss, 32);
    if (fq == 0) RED[nh * 64 + l] = ss;
    __syncthreads();
    const float rstd = rsqrtf((RED[l] + RED[64 + l]) * (1.f / 256.f) + EPS);
#pragma unroll
    for (int p = 0; p < 4; ++p) {
        const int e = 128 * nh + 32 * p + 8 * fq; float og[8], o[8];
        unpack8(ogw[p], og);
#pragma unroll
        for (int j = 0; j < 4; ++j) { o[j] = a1[2 * p][j] * rstd * og[j]; o[4 + j] = a1[2 * p + 1][j] * rstd * og[4 + j]; }
        { u32x2 q8; q8.x = pk4_i8(o[0], o[1], o[2], o[3], SQ_YB); q8.y = pk4_i8(o[4], o[5], o[6], o[7], SQ_YB); *(u32x2*)(F.p<unsigned char>(O_YA) + (t0 + l) * 2048 + 1024 + h * 256 + e) = q8; }
    }
    __syncthreads();
}

#define MIX_ITEM_WITH_TILE(fn, it, slot) do { const int l2 = lane_id(), t2 = w * 64 + l2;     \
        const int wti_ = (slot) * NGW + gw; const bool hasw_ = wti_ < NWT; f32x4 wv_[16], wg_[4]; \
        { const WTile wt_ = wtile_decode(F, hasw_ ? wti_ : 0); fn(F, it, l2, w, t2, hasw_, wt_, wv_, wg_); } \
        if (hasw_) { const WTile wt_ = wtile_decode(F, wti_); wtile_finish(wt_, l2, wv_, wg_, (LAS unsigned*)(F.lds + w * 4352)); } \
        __syncthreads(); } while (0)
DI void mix_a_phase(const Frame& F) {
    const int w = F.wave, gw = F.bid * 8 + w, NGW = F.G * 8;
    int slot = 0;
    for (int it = F.bid; it < NITEM_A; it += F.G) { MIX_ITEM_WITH_TILE(hgrn_a_item, it, slot); ++slot; }
    for (int it = F.bid; it < NITEM_B; it += F.G) { MIX_ITEM_WITH_TILE(mlstm_a_item, it, slot); ++slot; }
}
DI void mix_c_phase(const Frame& F) {
    const int w = F.wave, gw = F.bid * 8 + w, NGW = F.G * 8;
    int slot = (NITEM_A + F.G - 1) / F.G + (NITEM_B + F.G - 1) / F.G;
    for (int it = F.bid; it < NITEM_A; it += F.G) { MIX_ITEM_WITH_TILE(hgrn_c_item, it, slot); ++slot; }
    for (int it = F.bid; it < NITEM_B; it += F.G) { MIX_ITEM_WITH_TILE(mlstm_c_item, it, slot); ++slot; }
    for (int wti = slot * NGW + gw; wti < NWT; wti += NGW) { const int lane = lane_id(); const WTile wt = wtile_decode(F, wti); f32x4 wv[16], wg[4]; wtile_load(wt, lane, wv, wg); wtile_finish(wt, lane, wv, wg, (LAS unsigned*)(F.lds + w * 4352)); }
    __syncthreads();
}

enum { PH_PROLOGUE = 0, PH_INPROJ, PH_MIXA, PH_SCAN, PH_MIXC, PH_MIXPROJ, PH_WOUT, PH_ROUTE, PH_ROWS, PH_GU, PH_DN, PH_COMBINE, PH_GATE, PH_FINAL, PH_COUNT };

__global__ void __launch_bounds__(512, 2) fwd(Args args) {
    extern __shared__ __attribute__((aligned(16))) unsigned char lds_raw[];
    Frame F;
    F.lds = (LAS unsigned char*)lds_raw;
    F.wave = __builtin_amdgcn_readfirstlane((int)threadIdx.x >> 6); F.G = gridDim.x; F.bid = blockIdx.x;
    F.in = args.in; F.out = args.out; F.ws = args.ws;
    volatile LAS unsigned* misc = (volatile LAS unsigned*)(F.lds + LDS_MISC);
    if (threadIdx.x < 4) misc[threadIdx.x] = 0u;
    __syncthreads();
    const int lo = args.ph_lo, hi = args.ph_hi;
    const bool multi = (hi - lo) > 1;
    XcdBarrier bar; bar.bar = F.p<unsigned>(O_CTL) + CW_BAR; bar.x = 0; bar.st = misc;
    if (multi) bar = xcd_barrier_post(F.p<unsigned>(O_CTL) + CW_BAR, misc, threadIdx.x == 0);
#define IN(k) (lo <= (k) && (k) < hi)
#define REPS(k) for (int rep_ = 0; rep_ < 1 + ((k) == PROBE_PH ? PROBE_N : 0); ++rep_)
#define REPBAR(k) do { if ((k) == PROBE_PH && rep_ < PROBE_N) xcd_barrier(bar, F.wave == 0 && lane_id() == 0); } while (0)
#define SEAM(k) do { if (IN(k) && IN((k) + 1)) xcd_barrier(bar, F.wave == 0 && lane_id() == 0); } while (0)
    LAS unsigned char* ring = F.lds;

    if (IN(PH_PROLOGUE)) REPS(PH_PROLOGUE) { p0_prologue(F); REPBAR(PH_PROLOGUE); } SEAM(PH_PROLOGUE);

    if (IN(PH_INPROJ)) REPS(PH_INPROJ) {
        pg8::SchedPlain S; S.init(T, NZ, D, F.p<bf16>(O_WIN), F.G, F.bid);
        pg8::EpiWrap<EInproj, true> E{{F.p<bf16>(O_Z), F.p<bf16>(O_LF), F.p<float>(O_RS0), F.in[I_HGRN_LB]}};
        pg8::gemm_phase<2>(ring, F.wave, (const char*)F.p<bf16>(O_XB), D, S, E, STG_INPROJ); REPBAR(PH_INPROJ);
    } SEAM(PH_INPROJ);
#if PROBE_PH == 102 || PROBE_PH == 103
    if (IN(PH_INPROJ)) for (int rep_ = 0; rep_ < PROBE_N; ++rep_) {
        xcd_barrier(bar, F.wave == 0 && lane_id() == 0);
        if ((F.bid & 1) == 0) {
            pg8::SchedPlain S; S.init(T / 2, NZ, D, F.p<bf16>(O_WIN), F.G / 2, F.bid >> 1);
            pg8::EpiWrap<ENullProbe, true> E{{F.p<float>(O_MIXT), lo < 0 ? 1 : 0}};
            pg8::gemm_phase<2>(ring, F.wave, (const char*)F.p<bf16>(O_XB), D, S, E);
        }
#if PROBE_PH == 103
        else { const int lane = lane_id(); float acc = 0.f; const f32x4* xp = (const f32x4*)F.in[I_X];
            for (size_t i = (size_t)(F.bid >> 1) * 512 + F.wave * 64 + lane; i < (size_t)T * D / 4; i += (size_t)(F.G / 2) * 512) { const f32x4 v = xp[i]; acc += v.x + v.y + v.z + v.w; }
            if (acc == 123.456f) F.p<float>(O_MIXT)[lane] = acc; }
#endif
    }
#endif
#if PROBE_PH == 100
    if (IN(PH_INPROJ)) for (int rep_ = 0; rep_ < PROBE_N; ++rep_) {
        pg8::SchedPlain S; S.init(T, NZ, D, F.p<bf16>(O_WIN), F.G, F.bid);
        pg8::EpiWrap<ENullProbe> E{{F.p<float>(O_MIXT), lo < 0 ? 1 : 0}};
        pg8::gemm_phase<2>(ring, F.wave, (const char*)F.p<bf16>(O_XB), D, S, E);
        xcd_barrier(bar, F.wave == 0 && lane_id() == 0);
    }
#endif

    if (IN(PH_MIXA)) REPS(PH_MIXA) { mix_a_phase(F); REPBAR(PH_MIXA); } SEAM(PH_MIXA);
    if (IN(PH_SCAN)) { scan_phase(F); } SEAM(PH_SCAN);
    if (IN(PH_MIXC)) REPS(PH_MIXC) { mix_c_phase(F); REPBAR(PH_MIXC); } SEAM(PH_MIXC);

    if (IN(PH_MIXPROJ)) REPS(PH_MIXPROJ) {
        pg8::SchedPlain S; S.init(T, D, D, F.p<bf16>(O_WA), F.G, F.bid);
        pg8::EpiWrap<EMixF, true, true> E{{F.p<bf16>(O_Z), F.p<unsigned char>(O_MIX)}};
        MixHook H{F.p<bf16>(O_Z)};
        pg8::gemm_phase<2, pg8::EpiWrap<EMixF, true, true>, pg8::SchedPlain, MixHook>(ring, F.wave, (const char*)F.p<bf16>(O_YA), D, S, E, 0u, H);
        REPBAR(PH_MIXPROJ);
    } SEAM(PH_MIXPROJ);

    if (IN(PH_WOUT)) REPS(PH_WOUT) {
        pg8::SchedPlain S; S.init(T, D, D, F.p<bf16>(O_WOUT), F.G, F.bid);
        pg8::EpiWrap<EX1, true, true> E{{F.in[I_X], F.p<bf16>(O_X1), F.p<unsigned char>(O_X1B), F.p<float>(O_SS1)}};
        pg8::gemm_phase<2>(ring, F.wave, (const char*)F.p<unsigned char>(O_MIX), D, S, E); REPBAR(PH_WOUT);
    } SEAM(PH_WOUT);

    if (IN(PH_ROUTE)) REPS(PH_ROUTE) { p7_route(F); REPBAR(PH_ROUTE); } SEAM(PH_ROUTE);
    if (IN(PH_ROWS)) { p8_rows(F); } SEAM(PH_ROWS);

    if (IN(PH_GU)) REPS(PH_GU) {
        const int nblk = __builtin_amdgcn_readfirstlane(F.p<int>(O_BLKE)[NBMAX]);
        pg8::SchedMoE<true> S; S.init(nblk, 4096, D, F.p<unsigned char>(O_WGU), (size_t)4096 * D, F.p<int>(O_BLKE), F.p<int>(O_ROWTOK), F.G, F.bid);
        pg8::EpiWrap<ESwiglu, true> E{{F.p<unsigned char>(O_ACT), F.p<float>(O_ROWRS), F.in[I_B_GU]}};
        pg8::gemm_phase<2>(ring, F.wave, (const char*)F.p<unsigned char>(O_X1B), D, S, E, STG_GU); REPBAR(PH_GU);
    } SEAM(PH_GU);

    if (IN(PH_DN)) REPS(PH_DN) {
        const int nblk = __builtin_amdgcn_readfirstlane(F.p<int>(O_BLKE)[NBMAX]);
        pg8::SchedMoE<false> S; S.init(nblk, D, DFF, F.p<unsigned char>(O_WDN), (size_t)D * DFF, F.p<int>(O_BLKE), F.p<int>(O_ROWTOK), F.G, F.bid);
        pg8::EpiWrap<EDown, false, true> E{{F.p<unsigned char>(O_YBUF), F.p<float>(O_ROWG), F.in[I_B_DN]}};
        pg8::gemm_phase<1>(ring, F.wave, (const char*)F.p<unsigned char>(O_ACT), DFF, S, E, STG_DN);
        {
            pg8::SchedPlain S2; S2.init(T, D, 2 * PLE, F.p<bf16>(O_WPLE), F.G, F.bid);
            pg8::EpiWrap<EPw, false, true> E2{{F.p<bf16>(O_PW)}};
            pg8::gemm_phase<0>(ring, F.wave, (const char*)F.p<bf16>(O_PB), 2 * PLE, S2, E2);
        }
        REPBAR(PH_DN);
    } SEAM(PH_DN);

    if (IN(PH_COMBINE)) REPS(PH_COMBINE) {
        p11_combine(F); REPBAR(PH_COMBINE);
    } SEAM(PH_COMBINE);

    if (IN(PH_GATE)) REPS(PH_GATE) {
        pg8::SchedPlain S; S.init(T, D, D, F.p<unsigned char>(O_WPG), F.G, F.bid);
        pg8::EpiWrap<EGate, true, true> E{{F.p<bf16>(O_X2), F.p<bf16>(O_PW), F.p<float>(O_RS2), F.p<bf16>(O_X3), F.p<float>(O_SS3)}};
        pg8::gemm_phase<2>(ring, F.wave, (const char*)F.p<unsigned char>(O_X2B), D, S, E); REPBAR(PH_GATE);
    } SEAM(PH_GATE);

    if (IN(PH_FINAL)) { p13_final(F); }
#undef IN
#undef SEAM
}

static void launch_fwd(const Args& base, int lo, int hi, int grid, hipStream_t stream) {
    Args a = base; a.ph_lo = lo; a.ph_hi = hi;
    hipLaunchKernelGGL(fwd, dim3(grid), dim3(512), LDS_BYTES, stream, a);
}

extern "C" void kernel_launch(void* const* d_in, const int* in_sizes, int n_in, void* d_out, int out_size, void* d_ws, size_t ws_size, hipStream_t stream) {
    static int grid = 0;
    if (grid == 0) {
        if (n_in != 25 || out_size != T * D || ws_size < WS_END) { fprintf(stderr, "kernel_launch: unexpected shapes: n_in %d out %d ws %zu (need %zu)\n", n_in, out_size, ws_size, (size_t)WS_END); grid = -1; return; }
        int dev = 0, cus = 0;
        hipGetDevice(&dev); hipDeviceGetAttribute(&cus, hipDeviceAttributeMultiprocessorCount, dev);
        if (hipFuncSetAttribute((const void*)fwd, hipFuncAttributeMaxDynamicSharedMemorySize, LDS_BYTES) != hipSuccess) { fprintf(stderr, "kernel_launch: hipFuncSetAttribute failed\n"); grid = -1; return; }
        int per_cu = 0; (void)hipOccupancyMaxActiveBlocksPerMultiprocessor(&per_cu, (const void*)fwd, 512, LDS_BYTES); (void)hipGetLastError();
        if (per_cu < 1) fprintf(stderr, "kernel_launch: occupancy query says %d\n", per_cu);
        grid = cus;
    }
    if (grid < 0) return;
    hipMemsetAsync((char*)d_ws + O_CTL, 0, 1 * MiB, stream);
    Args a{};
    for (int i = 0; i < 25; ++i) a.in[i] = (const float*)d_in[i];
    a.out = (float*)d_out; a.ws = (unsigned char*)d_ws; a.ph_lo = 0; a.ph_hi = PH_COUNT;
#if ONE_LAUNCH
    launch_fwd(a, 0, PH_COUNT, grid, stream);
#else
    for (int ph = 0; ph < PH_COUNT; ++ph) launch_fwd(a, ph, ph + 1, grid, stream);
#endif
}
```
